# Optimizing an MI355X kernel written in HIP

```python
import jax, jax.numpy as jnp
from jax import lax
import numpy as np

D_MODEL = 2048
BATCH = 8
SEQ = 2048
DEPTH = 2

MEM_LEN = 256
N_GROUPS = 4
GROUP_WIDTH = D_MODEL // N_GROUPS
HEAD_DIM = 128
N_HEADS = GROUP_WIDTH // HEAD_DIM
ATTN_Q_BLOCK = 128
MLA_Q_RANK = 512
MLA_KV_RANK = 256
MLA_NOPE_DIM = 128
MLA_ROPE_DIM = 64
MLA_V_DIM = 128
ROPE_THETA = 10000.0
GMLP_CHUNK = 128
GMLP_GROUPS = 4
GMLP_GROUP_CH = GROUP_WIDTH // GMLP_GROUPS
MOBA_BLOCK = 256
MOBA_TOPK = 3
MOBA_Q_CHUNK = 32
X_HEADS = 4
X_HEAD_DIM = 128
X_WIDTH = X_HEADS * X_HEAD_DIM
D_FF = -(-(8 * D_MODEL) // (3 * 256)) * 256
EPS = 1e-6
NEG = -1e30

IN_SPLITS = (GROUP_WIDTH, GROUP_WIDTH, GROUP_WIDTH, N_HEADS,
             MLA_Q_RANK, MLA_KV_RANK, MLA_ROPE_DIM,
             GROUP_WIDTH, GROUP_WIDTH,
             GROUP_WIDTH, GROUP_WIDTH, GROUP_WIDTH)
IN_COLS = sum(IN_SPLITS)

kernel_name = 'hybrid_parallel_heads_fox_mla_gmlp_moba'


def rmsnorm(x, g):
    xf = x.astype(jnp.float32)
    y = xf * lax.rsqrt(jnp.mean(xf * xf, axis=-1, keepdims=True) + EPS)
    return (y * g.astype(jnp.float32)).astype(x.dtype)


def layernorm(x, g, b):
    xf = x.astype(jnp.float32)
    mu = jnp.mean(xf, axis=-1, keepdims=True)
    var = jnp.mean(jnp.square(xf - mu), axis=-1, keepdims=True)
    y = (xf - mu) * lax.rsqrt(var + EPS)
    return (y * g.astype(jnp.float32) + b.astype(jnp.float32)).astype(x.dtype)


def split_heads(t, h):
    b, s, _ = t.shape
    return t.reshape(b, s, h, -1).transpose(0, 2, 1, 3)


def merge_heads(t):
    b, h, s, d = t.shape
    return t.transpose(0, 2, 1, 3).reshape(b, s, h * d)


def causal_block_attention(q, k, v, decay=None):
    b, h, s, dq = q.shape
    nblk = s // ATTN_Q_BLOCK
    scale = dq ** -0.5
    kpos = jnp.arange(s)
    qb = q.reshape(b, h, nblk, ATTN_Q_BLOCK, dq).transpose(2, 0, 1, 3, 4)
    xs = (jnp.arange(nblk), qb)
    if decay is not None:
        xs = xs + (decay.reshape(b, h, nblk, ATTN_Q_BLOCK).transpose(2, 0, 1, 3),)

    def step(args):
        i, q_i = args[0], args[1]
        sc = jnp.einsum('bhqd,bhkd->bhqk', q_i, k).astype(jnp.float32) * scale
        if decay is not None:
            sc = sc + args[2][..., :, None] - decay[:, :, None, :]
        qpos = i * ATTN_Q_BLOCK + jnp.arange(ATTN_Q_BLOCK)
        sc = jnp.where(kpos[None, :] <= qpos[:, None], sc, NEG)
        p = jax.nn.softmax(sc, axis=-1).astype(v.dtype)
        return jnp.einsum('bhqk,bhkd->bhqd', p, v)

    o = lax.map(step, xs)
    return o.transpose(1, 2, 0, 3, 4).reshape(b, h, s, v.shape[-1])


def fox_mixer(q, k, v, f_logit, b_f, q_g, k_g):
    q = rmsnorm(split_heads(q, N_HEADS), q_g)
    k = rmsnorm(split_heads(k, N_HEADS), k_g)
    v = split_heads(v, N_HEADS)
    log_f = jax.nn.log_sigmoid(f_logit.astype(jnp.float32) + b_f.astype(jnp.float32))
    decay = jnp.cumsum(log_f, axis=1).transpose(0, 2, 1)
    return merge_heads(causal_block_attention(q, k, v, decay))


def apply_rope(x, cos, sin):
    half = x.shape[-1] // 2
    x1, x2 = x[..., :half], x[..., half:]
    return jnp.concatenate([x1 * cos - x2 * sin, x1 * sin + x2 * cos], axis=-1).astype(x.dtype)


def mla_mixer(c_q, c_kv, k_rope, q_lora_g, w_uq, kv_lora_g, w_ukv, q_g, k_g):
    b, s, _ = c_q.shape
    q = split_heads(rmsnorm(c_q, q_lora_g) @ w_uq, N_HEADS)
    kv = split_heads(rmsnorm(c_kv, kv_lora_g) @ w_ukv, N_HEADS)
    q_nope = rmsnorm(q[..., :MLA_NOPE_DIM], q_g[:MLA_NOPE_DIM])
    q_pe = rmsnorm(q[..., MLA_NOPE_DIM:], q_g[MLA_NOPE_DIM:])
    k_nope = rmsnorm(kv[..., :MLA_NOPE_DIM], k_g[:MLA_NOPE_DIM])
    v = kv[..., MLA_NOPE_DIM:]
    k_pe = rmsnorm(k_rope, k_g[MLA_NOPE_DIM:])[:, None]
    pos = jnp.arange(s, dtype=jnp.float32)
    inv_freq = ROPE_THETA ** (-jnp.arange(0, MLA_ROPE_DIM, 2, dtype=jnp.float32) / MLA_ROPE_DIM)
    ang = pos[:, None] * inv_freq[None, :]
    cos, sin = jnp.cos(ang), jnp.sin(ang)
    q_pe = apply_rope(q_pe, cos, sin)
    k_pe = apply_rope(k_pe, cos, sin)
    q = jnp.concatenate([q_nope, q_pe], axis=-1)
    k = jnp.concatenate([k_nope, jnp.broadcast_to(k_pe, (b, N_HEADS, s, MLA_ROPE_DIM))], axis=-1)
    return merge_heads(causal_block_attention(q, k, v))


def gmlp_mixer(u, v, ln_g, ln_b, w_s, b_s):
    b, s, _ = v.shape
    u = jax.nn.gelu(u)
    v = layernorm(jax.nn.gelu(v), ln_g, ln_b)
    vc = v.reshape(b, s // GMLP_CHUNK, GMLP_CHUNK, GMLP_GROUPS, GMLP_GROUP_CH)
    w_causal = w_s * jnp.tril(jnp.ones((GMLP_CHUNK, GMLP_CHUNK), w_s.dtype))
    mixed = jnp.einsum('gts,bnsgc->bntgc', w_causal, vc) + b_s.T[None, None, :, :, None]
    return u * mixed.reshape(b, s, GROUP_WIDTH)


def moba_mixer(q, k, v, q_g, k_g):
    b, s, _ = q.shape
    q = rmsnorm(split_heads(q, N_HEADS), q_g)
    k = rmsnorm(split_heads(k, N_HEADS), k_g)
    v = split_heads(v, N_HEADS)
    nb = -(-s // MOBA_BLOCK)
    s_pad = nb * MOBA_BLOCK
    pad = ((0, 0), (0, 0), (0, s_pad - s), (0, 0))
    q, k, v = jnp.pad(q, pad), jnp.pad(k, pad), jnp.pad(v, pad)
    kb = k.reshape(b, N_HEADS, nb, MOBA_BLOCK, HEAD_DIM)
    vb = v.reshape(b, N_HEADS, nb, MOBA_BLOCK, HEAD_DIM)
    k_mean = jnp.mean(kb, axis=3)
    gate = jnp.einsum('bhsd,bhnd->bhsn', q, k_mean).astype(jnp.float32)
    q_block = jnp.arange(s_pad) // MOBA_BLOCK
    gate = jnp.where(jnp.arange(nb)[None, :] < q_block[:, None], gate, NEG)
    top = min(MOBA_TOPK, nb)
    _, sel = lax.top_k(gate, top)
    sel_ok = jnp.arange(top)[None, :] < q_block[:, None]
    nqc = s_pad // MOBA_Q_CHUNK
    scale = HEAD_DIM ** -0.5
    gather = jax.vmap(jax.vmap(lambda blocks, idx: blocks[idx]))

    def step(args):
        i, q_i, sel_i, ok_i = args
        k_sel = gather(kb, sel_i)
        v_sel = gather(vb, sel_i)
        s_sel = jnp.einsum('bhqd,bhqjkd->bhqjk', q_i, k_sel).astype(jnp.float32) * scale
        s_sel = jnp.where(ok_i[None, None, :, :, None], s_sel, NEG)
        blk = (i * MOBA_Q_CHUNK) // MOBA_BLOCK
        k_own = lax.dynamic_index_in_dim(kb, blk, axis=2, keepdims=False)
        v_own = lax.dynamic_index_in_dim(vb, blk, axis=2, keepdims=False)
        s_own = jnp.einsum('bhqd,bhkd->bhqk', q_i, k_own).astype(jnp.float32) * scale
        qpos = i * MOBA_Q_CHUNK + jnp.arange(MOBA_Q_CHUNK)
        kpos = blk * MOBA_BLOCK + jnp.arange(MOBA_BLOCK)
        s_own = jnp.where(kpos[None, :] <= qpos[:, None], s_own, NEG)
        s_all = jnp.concatenate([s_sel.reshape(b, N_HEADS, MOBA_Q_CHUNK, top * MOBA_BLOCK), s_own], axis=-1)
        p = jax.nn.softmax(s_all, axis=-1).astype(v.dtype)
        p_sel = p[..., :top * MOBA_BLOCK].reshape(b, N_HEADS, MOBA_Q_CHUNK, top, MOBA_BLOCK)
        p_own = p[..., top * MOBA_BLOCK:]
        return (jnp.einsum('bhqjk,bhqjkd->bhqd', p_sel, v_sel)
                + jnp.einsum('bhqk,bhkd->bhqd', p_own, v_own))

    xs = (jnp.arange(nqc),
          q.reshape(b, N_HEADS, nqc, MOBA_Q_CHUNK, HEAD_DIM).transpose(2, 0, 1, 3, 4),
          sel.reshape(b, N_HEADS, nqc, MOBA_Q_CHUNK, top).transpose(2, 0, 1, 3, 4),
          sel_ok.reshape(nqc, MOBA_Q_CHUNK, top))
    o = lax.map(step, xs)
    o = o.transpose(1, 2, 0, 3, 4).reshape(b, N_HEADS, s_pad, HEAD_DIM)[:, :, :s]
    return merge_heads(o)


def memory_cross_attention(h, mem, mem_g, w_xq, w_xkv, q_g, k_g, w_xo):
    q = rmsnorm(split_heads(h @ w_xq, X_HEADS), q_g)
    kv = rmsnorm(mem, mem_g) @ w_xkv
    k = rmsnorm(split_heads(kv[..., :X_WIDTH], X_HEADS), k_g)
    v = split_heads(kv[..., X_WIDTH:], X_HEADS)
    sc = jnp.einsum('bhqd,bhmd->bhqm', q, k).astype(jnp.float32) * (X_HEAD_DIM ** -0.5)
    p = jax.nn.softmax(sc, axis=-1).astype(v.dtype)
    return merge_heads(jnp.einsum('bhqm,bhmd->bhqd', p, v)) @ w_xo


def swiglu(h, w_gate_up, w_down):
    gu = h @ w_gate_up
    return (jax.nn.silu(gu[..., :D_FF]) * gu[..., D_FF:]) @ w_down


def setup_inputs(seed: int = 0) -> dict:
    key = jax.random.key(seed)
    ks = iter(jax.random.split(key, 40))
    L = DEPTH
    f32 = jnp.float32

    def w(shape, fan_in):
        return jax.random.normal(next(ks), shape, f32) * fan_in ** -0.5

    def gain(shape):
        return 1.0 + 0.02 * jax.random.normal(next(ks), shape, f32)

    def small(shape):
        return 0.02 * jax.random.normal(next(ks), shape, f32)

    mla_qk = MLA_NOPE_DIM + MLA_ROPE_DIM
    return {
        'x': jax.random.normal(next(ks), (BATCH, SEQ, D_MODEL), f32),
        'mem': jax.random.normal(next(ks), (BATCH, MEM_LEN, D_MODEL), f32),
        'mix_norm': gain((L, D_MODEL)),
        'w_in': w((L, D_MODEL, IN_COLS), D_MODEL),
        'fox_b_f': small((L, N_HEADS)),
        'fox_q_norm': gain((L, HEAD_DIM)),
        'fox_k_norm': gain((L, HEAD_DIM)),
        'mla_q_lora_norm': gain((L, MLA_Q_RANK)),
        'mla_w_uq': w((L, MLA_Q_RANK, N_HEADS * mla_qk), MLA_Q_RANK),
        'mla_kv_lora_norm': gain((L, MLA_KV_RANK)),
        'mla_w_ukv': w((L, MLA_KV_RANK, N_HEADS * (MLA_NOPE_DIM + MLA_V_DIM)), MLA_KV_RANK),
        'mla_q_norm': gain((L, mla_qk)),
        'mla_k_norm': gain((L, mla_qk)),
        'gmlp_ln_g': gain((L, GROUP_WIDTH)),
        'gmlp_ln_b': small((L, GROUP_WIDTH)),
        'gmlp_w_s': w((L, GMLP_GROUPS, GMLP_CHUNK, GMLP_CHUNK), GMLP_CHUNK),
        'gmlp_b_s': gain((L, GMLP_GROUPS, GMLP_CHUNK)),
        'moba_q_norm': gain((L, HEAD_DIM)),
        'moba_k_norm': gain((L, HEAD_DIM)),
        'group_norm': gain((L, N_GROUPS, GROUP_WIDTH)),
        'w_out': w((L, N_GROUPS * GROUP_WIDTH, D_MODEL), N_GROUPS * GROUP_WIDTH),
        'xattn_norm': gain((L, D_MODEL)),
        'mem_norm': gain((L, D_MODEL)),
        'w_xq': w((L, D_MODEL, X_WIDTH), D_MODEL),
        'w_xkv': w((L, D_MODEL, 2 * X_WIDTH), D_MODEL),
        'xattn_q_norm': gain((L, X_HEAD_DIM)),
        'xattn_k_norm': gain((L, X_HEAD_DIM)),
        'w_xo': w((L, X_WIDTH, D_MODEL), X_WIDTH),
        'ffn_norm': gain((L, D_MODEL)),
        'w_gate_up': w((L, D_MODEL, 2 * D_FF), D_MODEL),
        'w_down': w((L, D_FF, D_MODEL), D_FF),
    }


def reference(x, mem, mix_norm, w_in, fox_b_f, fox_q_norm, fox_k_norm,
              mla_q_lora_norm, mla_w_uq, mla_kv_lora_norm, mla_w_ukv, mla_q_norm, mla_k_norm,
              gmlp_ln_g, gmlp_ln_b, gmlp_w_s, gmlp_b_s, moba_q_norm, moba_k_norm,
              group_norm, w_out, xattn_norm, mem_norm, w_xq, w_xkv, xattn_q_norm, xattn_k_norm,
              w_xo, ffn_norm, w_gate_up, w_down):
    split_idx = np.cumsum(IN_SPLITS)[:-1].tolist()
    for l in range(DEPTH):
        proj = rmsnorm(x, mix_norm[l]) @ w_in[l]
        (fq, fk, fv, ff, mcq, mckv, mkr, gu, gv, bq, bk, bv) = jnp.split(proj, split_idx, axis=-1)
        o_a = fox_mixer(fq, fk, fv, ff, fox_b_f[l], fox_q_norm[l], fox_k_norm[l])
        o_b = mla_mixer(mcq, mckv, mkr, mla_q_lora_norm[l], mla_w_uq[l], mla_kv_lora_norm[l],
                        mla_w_ukv[l], mla_q_norm[l], mla_k_norm[l])
        o_c = gmlp_mixer(gu, gv, gmlp_ln_g[l], gmlp_ln_b[l], gmlp_w_s[l], gmlp_b_s[l])
        o_d = moba_mixer(bq, bk, bv, moba_q_norm[l], moba_k_norm[l])
        mixed = jnp.concatenate([rmsnorm(o_a, group_norm[l, 0]), rmsnorm(o_b, group_norm[l, 1]),
                                 rmsnorm(o_c, group_norm[l, 2]), rmsnorm(o_d, group_norm[l, 3])], axis=-1)
        x = x + mixed @ w_out[l]
        x = x + memory_cross_attention(rmsnorm(x, xattn_norm[l]), mem, mem_norm[l], w_xq[l], w_xkv[l],
                                       xattn_q_norm[l], xattn_k_norm[l], w_xo[l])
        x = x + swiglu(rmsnorm(x, ffn_norm[l]), w_gate_up[l], w_down[l])
    return x
```

```cpp
#include <hip/hip_runtime.h>
#include <cstdio>
#include <cstdint>
__device__ __forceinline__ int otid() { int t = threadIdx.x; asm volatile("" : "+v"(t)); return t; }
#define ATTN_NAIVE 1
#define N_LAUNCH_MODE 0
namespace pg8 {
#define PG8_LAS __attribute__((address_space(3)))
typedef unsigned short bf16_t;
typedef short bf16x8 __attribute__((ext_vector_type(8)));
typedef float f32x4 __attribute__((ext_vector_type(4)));
typedef unsigned u32x4 __attribute__((ext_vector_type(4)));
constexpr int BM = 256, BK = 64, HALF = 128, HTB = HALF * BK * 2  , STAGE_BYTES = 8 * HTB, NXCD = 8, WGM = 8;

__host__ __device__ __forceinline__ int lds_byte(int r, int c) { const int st = (r >> 4) * 2 + (c >> 5), rr = r & 15, cc = c & 31, ob = rr * 64 + cc * 2; return st * 1024 + (ob ^ (((ob >> 9) & 1) << 5)); }
__host__ __device__ __forceinline__ void stage_rc(int b, int& R, int& C) { const int st = b / 1024, sb = b % 1024, swz = sb ^ (((sb >> 9) & 1) << 5); R = (st >> 1) * 16 + swz / 64; C = (st & 1) * 32 + (swz % 64) / 2; }
__host__ __device__ __forceinline__ int perm32(int rho) { const int n = rho >> 4, i = rho & 15; return 8 * (i >> 2) + 4 * n + (i & 3); }

struct Unit { int pm, pn; };
struct Gemm { const bf16_t* A; const bf16_t* Bt; int M, N, K; };

struct StaticOrder {
    int nM, nN, nwg, G, c;
    __host__ __device__ void init(int M, int N, int G_, int c_) { nM = M / BM; nN = N / BM; nwg = nM * nN; G = G_; c = c_; }
    __host__ __device__ bool next(int i, Unit& u) const {
        const long L = (long)i * G + c; if (L >= nwg) return false;
        int wgid = (int)L; { const int q = nwg / NXCD, r = nwg % NXCD, xcd = wgid % NXCD, off = wgid / NXCD; wgid = (xcd < r ? xcd * (q + 1) : r * (q + 1) + (xcd - r) * q) + off; }
        const int nig = WGM * nN, gid = wgid / nig, fm = gid * WGM, gsz = (nM - fm) < WGM ? (nM - fm) : WGM;
        u.pm = fm + ((wgid % nig) % gsz); u.pn = (wgid % nig) / gsz; return true;
    }
    __device__ __forceinline__ void a_ready(const Unit&) const {}
    __device__ __forceinline__ void done(const Unit&) const {}
};

__device__ __forceinline__ unsigned cvt_pk_bf16(float lo, float hi) { unsigned r; asm volatile("v_cvt_pk_bf16_f32 %0, %1, %2" : "=v"(r) : "v"(lo), "v"(hi)); return r; }
typedef float f32x2 __attribute__((ext_vector_type(2)));
template <class Epi, class Sched, bool ALIGN_EPI = false, bool SP2 = false>
__device__ __forceinline__ void gemm_phase(PG8_LAS unsigned char* lds, const Gemm g, const Sched& S, const Epi& E) {
    const int tid = otid(), wid = __builtin_amdgcn_readfirstlane(tid >> 6), lane = tid & 63, wr = wid >> 2, wc = wid & 3, fr = lane & 15, fq = lane >> 4;
    const int K = g.K, nt = K / BK;
    unsigned voffA[2], voffB[2];
#pragma unroll
    for (int i = 0; i < 2; ++i) { int R, C; stage_rc(tid * 16 + i * 8192, R, C); const int Rb = Epi::PERM ? ((R & ~31) + perm32(R & 31)) : R;
        voffA[i] = (unsigned)(R * K + C) * 2u; voffB[i] = (unsigned)(Rb * K + C) * 2u; }
    const size_t kstep = (size_t)(BK * 2);
    const size_t hstep = (size_t)HALF * K * 2;
    const size_t tstep = 2 * hstep;
    const unsigned ldsw = (unsigned)wid * 1024u;
    const int aoff = lds_byte(wr * 64 + fr, fq * 8), boff = lds_byte(wc * 32 + fr, fq * 8);
#define PG8_SA(b, h) (((b) * 2 + (h)) * HTB)
#define PG8_SB(b, h) ((4 + (b) * 2 + (h)) * HTB)
#define PG8_STAGE(bufoff, gbase, voff) do { _Pragma("unroll") for (int _i = 0; _i < 2; ++_i) \
        __builtin_amdgcn_global_load_lds((const unsigned*)((const char*)(gbase) + (voff)[_i]), (PG8_LAS unsigned*)(lds + (bufoff) + ldsw + _i * 8192), 16, 0, 0); } while (0)
#define PG8_LDA(dst, b, h) do { _Pragma("unroll") for (int m = 0; m < 4; ++m) _Pragma("unroll") for (int k = 0; k < 2; ++k) dst[m][k] = *(const PG8_LAS bf16x8*)(lds + PG8_SA(b, h) + aoff + m * 2048 + k * 1024); } while (0)
#define PG8_LDB(dst, b, h) do { _Pragma("unroll") for (int n = 0; n < 2; ++n) _Pragma("unroll") for (int k = 0; k < 2; ++k) dst[n][k] = *(const PG8_LAS bf16x8*)(lds + PG8_SB(b, h) + boff + n * 2048 + k * 1024); } while (0)
#define PG8_MMA(ai, bj, At, Bt) do { __builtin_amdgcn_s_setprio(1); _Pragma("unroll") for (int m = 0; m < 4; ++m) _Pragma("unroll") for (int n = 0; n < 2; ++n) _Pragma("unroll") for (int k = 0; k < 2; ++k) \
        acc[ai][bj][m][n] = __builtin_amdgcn_mfma_f32_16x16x32_bf16(Bt[n][k], At[m][k], acc[ai][bj][m][n], 0, 0, 0); __builtin_amdgcn_s_setprio(0); } while (0)
#define PG8_WAIT_V(n) asm volatile("s_waitcnt vmcnt(" #n ")" ::: "memory")
#define PG8_WAIT_L(n) asm volatile("s_waitcnt lgkmcnt(" #n ")" ::: "memory")
#define PG8_BAR __builtin_amdgcn_s_barrier()
#define PG8_SCHED __builtin_amdgcn_sched_barrier(0)
    Unit cur, nxt; int ui = 0;
    if (!S.next(0, cur)) return;
    f32x4 acc[2][2][4][2];
#pragma unroll
    for (int a = 0; a < 2; ++a)
#pragma unroll
        for (int b = 0; b < 2; ++b)
#pragma unroll
            for (int m = 0; m < 4; ++m)
#pragma unroll
                for (int n = 0; n < 2; ++n) acc[a][b][m][n] = (f32x4){0.f, 0.f, 0.f, 0.f};
    bf16x8 At[4][2], B0[2][2], B1[2][2];
    const char* cA = (const char*)g.A + (size_t)cur.pm * tstep; const char* cB = (const char*)g.Bt + (size_t)cur.pn * tstep;
    S.a_ready(cur);
    if constexpr (SP2) {
        PG8_STAGE(PG8_SB(0, 0), cB, voffB); PG8_STAGE(PG8_SB(0, 1), cB + hstep, voffB); PG8_STAGE(PG8_SA(0, 0), cA, voffA); PG8_STAGE(PG8_SA(0, 1), cA + hstep, voffA);
        if (wr == 1) PG8_BAR;
        PG8_WAIT_V(2); PG8_BAR;
        PG8_STAGE(PG8_SB(1, 0), cB + kstep, voffB); PG8_STAGE(PG8_SA(1, 0), cA + kstep, voffA); PG8_STAGE(PG8_SB(1, 1), cB + hstep + kstep, voffB);
        PG8_WAIT_V(6); PG8_BAR;
    } else {
        PG8_STAGE(PG8_SB(0, 0), cB, voffB); PG8_STAGE(PG8_SA(0, 0), cA, voffA); PG8_STAGE(PG8_SB(0, 1), cB + hstep, voffB); PG8_STAGE(PG8_SA(0, 1), cA + hstep, voffA);
        if (wr == 1) PG8_BAR;
        PG8_WAIT_V(4); PG8_BAR;
        PG8_STAGE(PG8_SB(1, 0), cB + kstep, voffB); PG8_STAGE(PG8_SA(1, 0), cA + kstep, voffA); PG8_STAGE(PG8_SB(1, 1), cB + hstep + kstep, voffB);
        PG8_WAIT_V(6); PG8_BAR;
    }
    for (;;) {
        const bool has_next = S.next(ui + 1, nxt);
        const char* nA = has_next ? (const char*)g.A + (size_t)nxt.pm * tstep : cA; const char* nB = has_next ? (const char*)g.Bt + (size_t)nxt.pn * tstep : cB;
#pragma unroll 1
        for (int t = 0; t < nt; t += 2) {
            const bool last = (t == nt - 2);
            const char* a1 = cA + (size_t)(t + 1) * kstep;
            const char* a2 = last ? nA : cA + (size_t)(t + 2) * kstep; const char* b2 = last ? nB : cB + (size_t)(t + 2) * kstep;
            const char* a3 = a2 + kstep; const char* b3 = b2 + kstep;
            if (last && has_next) S.a_ready(nxt);
            if constexpr (SP2) {
            PG8_LDB(B0, 0, 0); PG8_LDB(B1, 0, 1); PG8_SCHED; PG8_LDA(At, 0, 0); PG8_STAGE(PG8_SA(1, 1), a1 + hstep, voffA);
            PG8_WAIT_V(8); PG8_WAIT_L(0); PG8_BAR; PG8_MMA(0, 0, At, B0); PG8_MMA(0, 1, At, B1); PG8_BAR; PG8_SCHED;
            PG8_LDA(At, 0, 1); PG8_STAGE(PG8_SB(0, 0), b2, voffB); PG8_STAGE(PG8_SB(0, 1), b2 + hstep, voffB); PG8_STAGE(PG8_SA(0, 0), a2, voffA);
            PG8_WAIT_V(8); PG8_WAIT_L(0); PG8_BAR; PG8_MMA(1, 0, At, B0); PG8_MMA(1, 1, At, B1); PG8_BAR; PG8_SCHED;
            PG8_LDB(B0, 1, 0); PG8_LDB(B1, 1, 1); PG8_SCHED; PG8_LDA(At, 1, 0); PG8_STAGE(PG8_SA(0, 1), a2 + hstep, voffA);
            PG8_WAIT_V(8); PG8_WAIT_L(0); PG8_BAR; PG8_MMA(0, 0, At, B0); PG8_MMA(0, 1, At, B1); PG8_BAR; PG8_SCHED;
            PG8_LDA(At, 1, 1); PG8_STAGE(PG8_SB(1, 0), b3, voffB); PG8_STAGE(PG8_SB(1, 1), b3 + hstep, voffB); PG8_STAGE(PG8_SA(1, 0), a3, voffA);
            PG8_WAIT_V(8); PG8_WAIT_L(0); PG8_BAR; PG8_MMA(1, 0, At, B0); PG8_MMA(1, 1, At, B1); PG8_BAR; PG8_SCHED;
            } else {
            PG8_LDB(B0, 0, 0); PG8_SCHED; PG8_LDA(At, 0, 0); PG8_STAGE(PG8_SA(1, 1), a1 + hstep, voffA);
            PG8_WAIT_L(8); PG8_BAR; PG8_WAIT_L(0); PG8_MMA(0, 0, At, B0); PG8_BAR; PG8_SCHED;
            PG8_LDB(B1, 0, 1); PG8_STAGE(PG8_SB(0, 0), b2, voffB);
            PG8_BAR; PG8_WAIT_L(0); PG8_MMA(0, 1, At, B1); PG8_BAR;
            PG8_LDA(At, 0, 1); PG8_STAGE(PG8_SA(0, 0), a2, voffA);
            PG8_BAR; PG8_WAIT_L(0); PG8_MMA(1, 0, At, B0); PG8_BAR; PG8_SCHED;
            PG8_STAGE(PG8_SB(0, 1), b2 + hstep, voffB);
            PG8_WAIT_V(6); PG8_BAR; PG8_MMA(1, 1, At, B1); PG8_BAR;
            PG8_LDB(B0, 1, 0); PG8_SCHED; PG8_LDA(At, 1, 0); PG8_STAGE(PG8_SA(0, 1), a2 + hstep, voffA);
            PG8_WAIT_L(8); PG8_BAR; PG8_WAIT_L(0); PG8_MMA(0, 0, At, B0); PG8_BAR; PG8_SCHED;
            PG8_LDB(B1, 1, 1); PG8_STAGE(PG8_SB(1, 0), b3, voffB);
            PG8_BAR; PG8_WAIT_L(0); PG8_MMA(0, 1, At, B1); PG8_BAR;
            PG8_LDA(At, 1, 1); PG8_STAGE(PG8_SA(1, 0), a3, voffA);
            PG8_BAR; PG8_WAIT_L(0); PG8_MMA(1, 0, At, B0); PG8_BAR; PG8_SCHED;
            PG8_STAGE(PG8_SB(1, 1), b3 + hstep, voffB);
            PG8_WAIT_V(6); PG8_BAR; PG8_MMA(1, 1, At, B1); PG8_BAR;
            }
        }
        if constexpr (ALIGN_EPI) { if (wr == 0) PG8_BAR; }
        if constexpr (!Epi::AFTER_DRAIN) { E(acc, cur, wr, wc, fr, fq); S.done(cur); }
        if (!has_next) break;
#pragma unroll
        for (int a = 0; a < 2; ++a)
#pragma unroll
            for (int b = 0; b < 2; ++b)
#pragma unroll
                for (int m = 0; m < 4; ++m)
#pragma unroll
                    for (int n = 0; n < 2; ++n) acc[a][b][m][n] = (f32x4){0.f, 0.f, 0.f, 0.f};
        cur = nxt; cA = nA; cB = nB; ++ui;
        if constexpr (ALIGN_EPI) { if (wr == 1) PG8_BAR; }
    }
    PG8_WAIT_V(0);
    if constexpr (!ALIGN_EPI) { if (wr == 0) PG8_BAR; }
    PG8_BAR;
    if constexpr (Epi::AFTER_DRAIN) { E.fused(acc, cur, wr, wc, fr, fq, lds, wid, lane); S.done(cur); }
#undef PG8_SA
#undef PG8_SB
#undef PG8_STAGE
#undef PG8_LDA
#undef PG8_LDB
#undef PG8_MMA
#undef PG8_WAIT_V
#undef PG8_WAIT_L
#undef PG8_BAR
#undef PG8_SCHED
}
}
#define GAS __attribute__((address_space(1)))
#define LAS __attribute__((address_space(3)))
typedef unsigned short bf16;
typedef unsigned v4u __attribute__((ext_vector_type(4)));
typedef float f32x4 __attribute__((ext_vector_type(4)));
typedef short bf16x8 __attribute__((ext_vector_type(8)));
typedef GAS unsigned gu32;
typedef GAS unsigned long long gu64;
#define RLX_AGENT __ATOMIC_RELAXED, __HIP_MEMORY_SCOPE_AGENT
#define LDS_WAIT() asm volatile("s_waitcnt lgkmcnt(0)" ::: "memory")
#define VM_WAIT() asm volatile("s_waitcnt vmcnt(0)" ::: "memory")
__device__ __forceinline__ unsigned long long rt() { return __builtin_amdgcn_s_memrealtime(); }
__device__ __forceinline__ unsigned f2bf(float f) { unsigned u = __builtin_bit_cast(unsigned, f); return (u + 0x7fffu + ((u >> 16) & 1u)) >> 16; }
__device__ __forceinline__ unsigned pk2(float lo, float hi) { return f2bf(lo) | (f2bf(hi) << 16); }

#define XB_TMO      128
#define XB_XCNT(j)  (256  + 64 * (j))
#define XB_XSUB(j)  (1280 + 64 * (j))
#define XB_XGEN(j)  (2304 + 64 * (j))
#define XB_TOP      3328
#define XB_TOPGEN   3392
#define XCD_BAR_WORDS 3456
#define XB_SPIN_CAP (1u << 18)

__device__ __forceinline__ unsigned xb_ld(unsigned* p)              { return __hip_atomic_load(p, __ATOMIC_RELAXED, __HIP_MEMORY_SCOPE_AGENT); }
__device__ __forceinline__ unsigned xb_add(unsigned* p, unsigned v) { return __hip_atomic_fetch_add(p, v, __ATOMIC_RELAXED, __HIP_MEMORY_SCOPE_AGENT); }
__device__ __forceinline__ unsigned xb_xcc_id() { return (unsigned)__builtin_amdgcn_s_getreg((3 << 11) | 20) & 0xFu; }
#define XB_SPIN(cond, bar) do { unsigned _sp = 0; while (cond) { __builtin_amdgcn_s_sleep(1); \
    if ((++_sp & 255u) == 0u) { if (xb_ld(&(bar)[XB_TMO])) break; if (_sp > XB_SPIN_CAP) { atomicAdd(&(bar)[XB_TMO], 1u); break; } } } } while (0)

struct XcdBarrier {
    unsigned* bar; unsigned x;
    volatile LAS unsigned* st;
};

__device__ __forceinline__ XcdBarrier xcd_barrier_post(unsigned* bar, volatile LAS unsigned* st) {
    XcdBarrier b; b.bar = bar; b.x = xb_xcc_id(); b.st = st;
    if (threadIdx.x == 0) (void)xb_add(&bar[XB_XCNT(b.x)], 1u);
    return b;
}
__device__ __forceinline__ void xcd_barrier_complete(unsigned* bar, unsigned x, unsigned& nloc, unsigned& nx) {
    const unsigned G = gridDim.x * gridDim.y * gridDim.z;
    unsigned sum, cnt, mine, sp = 0u;
    for (;;) {
        sum = 0u; cnt = 0u; mine = 0u;
#pragma unroll
        for (unsigned j = 0; j < 16; ++j) { const unsigned c = xb_ld(&bar[XB_XCNT(j)]); sum += c; cnt += (c > 0u) ? 1u : 0u; mine = (j == x) ? c : mine; }
        if (sum == G) break;
        __builtin_amdgcn_s_sleep(1);
        if ((++sp & 255u) == 0u) { if (xb_ld(&bar[XB_TMO])) break; if (sp > XB_SPIN_CAP) { atomicAdd(&bar[XB_TMO], 1u); break; } }
    }
    nloc = mine > 0u ? mine : 1u; nx = cnt > 0u ? cnt : 1u;
}

__device__ __forceinline__ void xcd_barrier(const XcdBarrier& b) {
    asm volatile("s_waitcnt vmcnt(0)" ::: "memory");
    __syncthreads();
    if (threadIdx.x == 0) {
        unsigned* bar = b.bar;
        __builtin_amdgcn_s_waitcnt(0);
        unsigned nloc = b.st[0], nx = b.st[1];
        if (nloc == 0u) { xcd_barrier_complete(bar, b.x, nloc, nx); b.st[0] = nloc; b.st[1] = nx; }
        const unsigned old = xb_add(&bar[XB_XSUB(b.x)], 1u);
        const unsigned gen = old / nloc;
        if (old + 1u == (gen + 1u) * nloc) {
            __builtin_amdgcn_fence(__ATOMIC_RELEASE, "agent");
            asm volatile("s_waitcnt vmcnt(0)" ::: "memory");
            const unsigned og = xb_add(&bar[XB_TOP], 1u);
            const unsigned tg = og / nx;
            if (og + 1u == (tg + 1u) * nx) xb_add(&bar[XB_TOPGEN], 1u);
            else XB_SPIN(xb_ld(&bar[XB_TOPGEN]) == tg, bar);
            __builtin_amdgcn_fence(__ATOMIC_ACQUIRE, "agent");
            xb_add(&bar[XB_XGEN(b.x)], 1u);
            asm volatile("s_waitcnt vmcnt(0)" ::: "memory");
        } else {
            XB_SPIN(xb_ld(&bar[XB_XGEN(b.x)]) == gen, bar);
            __builtin_amdgcn_fence(__ATOMIC_ACQUIRE, "agent");
            asm volatile("s_waitcnt vmcnt(0)" ::: "memory");
        }
    }
    __syncthreads();
}

typedef float f32x16 __attribute__((ext_vector_type(16)));
typedef short s16x4 __attribute__((ext_vector_type(4)));
typedef float f32x2v __attribute__((ext_vector_type(2)));

constexpr int M = 16384, DM = 2048, SEQ = 2048, NB = 8, NPROJ = 5120, DFF = 5632, MEMR = 2048, NIN = 4932;
constexpr float EPS = 1e-6f;
constexpr float LOG2E = 1.4426950408889634f;
constexpr float QS128 = 0.08838834764831845f * LOG2E;
constexpr float QS192 = 0.07216878364870322f * LOG2E;
constexpr int NWAVES = 8;

constexpr int PC_FQ = 0, PC_FK = 512, PC_FV = 1024, PC_MCQ = 1536, PC_MCKV = 2048, PC_MKR = 2304, PC_FF = 2368,
              PC_GU = 2560, PC_GV = 3072, PC_BQ = 3584, PC_BK = 4096, PC_BV = 4608;

constexpr size_t MiB = 1u << 20;
constexpr size_t WS_CTL = 0, CTL_ZERO_BYTES = 1 * MiB;
constexpr size_t WS_W = 1 * MiB, WL_STRIDE = 104 * MiB;
constexpr size_t WO_IN = 0, WO_OUT = 20 * MiB, WO_XQ = 28 * MiB, WO_XKV = 30 * MiB, WO_XO = 34 * MiB, WO_GU = 36 * MiB, WO_D = 80 * MiB,
                 WO_UQ = 102 * MiB, WO_UKV = 102 * MiB + 768 * 1024;
constexpr size_t WS_XB = 209 * MiB, WS_PROJ = 273 * MiB, WS_OMIX = 449 * MiB, WS_CQN = 513 * MiB, WS_CKVN = 529 * MiB, WS_QM = 537 * MiB,
                 WS_KVM = 561 * MiB, WS_XQ = 593 * MiB, WS_XO = 609 * MiB, WS_XKV = 625 * MiB, WS_MEMB = 633 * MiB, WS_FKA = 641 * MiB,
                 WS_BQA = 643 * MiB, WS_BKA = 645 * MiB, WS_KPE = 646 * MiB, WS_LF = 648 * MiB, WS_LFSUM = 648 * MiB + 512 * 1024,
                 WS_ROPE = 649 * MiB, WS_FQA = 649 * MiB + 512 * 1024, WS_MEMSS = 649 * MiB + 768 * 1024, WS_END = 650 * MiB;
constexpr int CW_TMO = 0, CW_BAR = 4096  , CW_Q = 8192  ;
constexpr size_t CTL_SS = 65536, CTL_KMEAN = 524288;

struct Params { const float* in[31]; float* out; unsigned char* ws; int ph_lo, ph_hi; };

struct Frame {
    LAS unsigned char* lds;
    int tid, lane, wave, vcu, G;
    const float* const* in; float* out; unsigned char* ws;
};

__device__ __forceinline__ float wave_sum(float v) {
#pragma unroll
    for (int o = 1; o < 64; o <<= 1) v += __shfl_xor(v, o);
    return v;
}
__device__ __forceinline__ float grp16_sum(float v) { v += __shfl_xor(v, 1); v += __shfl_xor(v, 2); v += __shfl_xor(v, 4); v += __shfl_xor(v, 8); return v; }
__device__ __forceinline__ float bf2f(unsigned short b) { return __uint_as_float(((unsigned)b) << 16); }
__device__ __forceinline__ float bflo(unsigned w) { return __uint_as_float(w << 16); }
__device__ __forceinline__ float bfhi(unsigned w) { return __uint_as_float(w & 0xffff0000u); }
__device__ __forceinline__ float gelu_tanh(float x) {
    const float u = 0.7978845608028654f * (x + 0.044715f * x * x * x);
    const float e = __expf(2.f * u);
    return 0.5f * x * (2.f - 2.f / (e + 1.f));
}
__device__ __forceinline__ float silu_f(float x) { return x / (1.f + __expf(-x)); }
__device__ __forceinline__ float log_sigmoid_f(float x) { return fminf(x, 0.f) - log1pf(expf(-fabsf(x))); }

__device__ __forceinline__ bf16* wptr(unsigned char* ws, int l, size_t off) { return (bf16*)(ws + WS_W + (size_t)l * WL_STRIDE + off); }
__device__ __forceinline__ float* ss_ptr(unsigned char* ws, int k) { return (float*)(ws + CTL_SS) + (size_t)k * M; }

struct EpiScale {
    static constexpr bool PERM = true, AFTER_DRAIN = false;
    bf16* O; int ldc; const float* ss; float inv_kn;
    __device__ __forceinline__ void operator()(const pg8::f32x4 (&acc)[2][2][4][2], const pg8::Unit& u, int wr, int wc, int fr, int fq) const {
        const int row0 = u.pm * 256 + wr * 64 + fr, col0 = u.pn * 256 + wc * 32 + 8 * fq;
#pragma unroll
        for (int ai = 0; ai < 2; ++ai)
#pragma unroll
            for (int m = 0; m < 4; ++m) {
                const int row = row0 + ai * 128 + m * 16;
                const float sc = ss ? rsqrtf(ss[row] * inv_kn + EPS) : 1.f;
                bf16* rowp = O + (size_t)row * ldc + col0;
#pragma unroll
                for (int bj = 0; bj < 2; ++bj) {
                    const pg8::f32x4 v0 = acc[ai][bj][m][0] * sc, v1 = acc[ai][bj][m][1] * sc;
                    v4u w; w.x = pg8::cvt_pk_bf16(v0[0], v0[1]); w.y = pg8::cvt_pk_bf16(v0[2], v0[3]); w.z = pg8::cvt_pk_bf16(v1[0], v1[1]); w.w = pg8::cvt_pk_bf16(v1[2], v1[3]);
                    *(v4u*)(rowp + bj * 128) = w;
                }
            }
    }
};
struct EpiResid {
    static constexpr bool PERM = false, AFTER_DRAIN = false;
    const float* xin; float* xout; bf16* xb; float* ssn;
    __device__ __forceinline__ void operator()(const pg8::f32x4 (&acc)[2][2][4][2], const pg8::Unit& u, int wr, int wc, int fr, int fq) const {
        const int row0 = u.pm * 256 + wr * 64 + fr, col0 = u.pn * 256 + wc * 32 + 4 * fq;
#pragma unroll
        for (int ai = 0; ai < 2; ++ai)
#pragma unroll
            for (int m = 0; m < 4; ++m) {
                const int row = row0 + ai * 128 + m * 16; float q = 0.f;
#pragma unroll
                for (int bj = 0; bj < 2; ++bj)
#pragma unroll
                    for (int n = 0; n < 2; ++n) {
                        const size_t idx = (size_t)row * DM + col0 + bj * 128 + n * 16;
                        pg8::f32x4 x = *(const pg8::f32x4*)(xin + idx); x = x + acc[ai][bj][m][n];
                        *(pg8::f32x4*)(xout + idx) = x;
                        uint2 w; w.x = pg8::cvt_pk_bf16(x[0], x[1]); w.y = pg8::cvt_pk_bf16(x[2], x[3]);
                        *(uint2*)(xb + idx) = w;
                        q += (x[0] * x[0] + x[1] * x[1]) + (x[2] * x[2] + x[3] * x[3]);
                    }
                q += __shfl_xor(q, 16); q += __shfl_xor(q, 32);
                if (fq == 0) atomicAdd(ssn + row, q);
            }
    }
};
struct EpiSwiGLU {
    static constexpr bool PERM = true, AFTER_DRAIN = false;
    bf16* O; const float* ss;
    __device__ __forceinline__ void operator()(const pg8::f32x4 (&acc)[2][2][4][2], const pg8::Unit& u, int wr, int wc, int fr, int fq) const {
        const int row0 = u.pm * 256 + wr * 64 + fr, col0 = u.pn * 128 + wc * 32 + 8 * fq;
#pragma unroll
        for (int ai = 0; ai < 2; ++ai)
#pragma unroll
            for (int m = 0; m < 4; ++m) {
                const int row = row0 + ai * 128 + m * 16;
                const float sc = rsqrtf(ss[row] * (1.f / DM) + EPS);
                float o[8];
#pragma unroll
                for (int n = 0; n < 2; ++n)
#pragma unroll
                    for (int e = 0; e < 4; ++e) { const float g = acc[ai][0][m][n][e] * sc, uu = acc[ai][1][m][n][e] * sc; o[n * 4 + e] = silu_f(g) * uu; }
                v4u w; w.x = pg8::cvt_pk_bf16(o[0], o[1]); w.y = pg8::cvt_pk_bf16(o[2], o[3]); w.z = pg8::cvt_pk_bf16(o[4], o[5]); w.w = pg8::cvt_pk_bf16(o[6], o[7]);
                *(v4u*)(O + (size_t)row * DFF + col0) = w;
            }
    }
};

__device__ __forceinline__ void transpose_item(const float* W, int Nsrc, int K, int k0, int srcc, int valid, const float* gain, bf16* WT, int drow0, LAS float* scr, int lane) {
#pragma unroll 8
    for (int i = 0; i < 32; ++i) {
        const int kk = 2 * i + (lane >> 5), n = lane & 31;
        float v = 0.f;
        if (n < valid) { v = W[(size_t)(k0 + kk) * Nsrc + srcc + n]; if (gain) v *= gain[k0 + kk]; }
        scr[kk * 33 + n] = v;
    }
    LDS_WAIT(); asm volatile("" ::: "memory");
    const int c = lane & 7;
#pragma unroll
    for (int j = 0; j < 4; ++j) {
        const int n = (lane >> 3) + 8 * j; const LAS float* s = scr + (8 * c) * 33 + n;
        v4u o; o.x = pk2(s[0 * 33], s[1 * 33]); o.y = pk2(s[2 * 33], s[3 * 33]); o.z = pk2(s[4 * 33], s[5 * 33]); o.w = pk2(s[6 * 33], s[7 * 33]);
        *(GAS v4u*)(WT + (size_t)(drow0 + n) * K + k0 + 8 * c) = o;
    }
    LDS_WAIT(); asm volatile("" ::: "memory");
}
constexpr int ITEMS_L = 5120 + 2048 + 512 + 1024 + 512 + 11264 + 5632 + 192 + 128;
__device__ __forceinline__ void p0_prologue(Frame& F) {
    LAS float* scr = (LAS float*)(F.lds + F.wave * 16384);
    const int gw = F.vcu * NWAVES + F.wave, NGW = F.G * NWAVES;
    for (int it = gw; it < 2 * ITEMS_L; it += NGW) {
        const int l = it >= ITEMS_L ? 1 : 0; int r = it - l * ITEMS_L;
        const float* W; const float* gain = nullptr; int K, Nsrc, ND, mode = 0; bf16* WT;
        if (r < 5120) { W = F.in[3] + (size_t)l * DM * NIN; K = DM; Nsrc = NIN; ND = NPROJ; WT = wptr(F.ws, l, WO_IN); gain = F.in[2] + l * DM; mode = 1; }
        else if ((r -= 5120) < 2048) { W = F.in[20] + (size_t)l * DM * DM; K = DM; Nsrc = DM; ND = DM; WT = wptr(F.ws, l, WO_OUT); }
        else if ((r -= 2048) < 512) { W = F.in[23] + (size_t)l * DM * 512; K = DM; Nsrc = 512; ND = 512; WT = wptr(F.ws, l, WO_XQ); gain = F.in[21] + l * DM; }
        else if ((r -= 512) < 1024) { W = F.in[24] + (size_t)l * DM * 1024; K = DM; Nsrc = 1024; ND = 1024; WT = wptr(F.ws, l, WO_XKV); gain = F.in[22] + l * DM; }
        else if ((r -= 1024) < 512) { W = F.in[27] + (size_t)l * 512 * DM; K = 512; Nsrc = DM; ND = DM; WT = wptr(F.ws, l, WO_XO); }
        else if ((r -= 512) < 11264) { W = F.in[29] + (size_t)l * DM * 2 * DFF; K = DM; Nsrc = 2 * DFF; ND = 2 * DFF; WT = wptr(F.ws, l, WO_GU); gain = F.in[28] + l * DM; mode = 2; }
        else if ((r -= 11264) < 5632) { W = F.in[30] + (size_t)l * DFF * DM; K = DFF; Nsrc = DM; ND = DM; WT = wptr(F.ws, l, WO_D); }
        else if ((r -= 5632) < 192) { W = F.in[8] + (size_t)l * 512 * 768; K = 512; Nsrc = 768; ND = 768; WT = wptr(F.ws, l, WO_UQ); }
        else { r -= 192; W = F.in[10] + (size_t)l * 256 * 1024; K = 256; Nsrc = 1024; ND = 1024; WT = wptr(F.ws, l, WO_UKV); }
        const int nblk = ND / 32, kb = r / nblk, nb = r - kb * nblk, R0 = nb * 32;
        int srcc = R0, valid = 32;
        if (mode == 1) {
            if (R0 < 1536) srcc = R0; else if (R0 < 2368) srcc = R0 + 4; else if (R0 == 2368) { srcc = 1536; valid = 4; } else if (R0 < 2560) { srcc = 0; valid = 0; } else srcc = R0 - 188;
        } else if (mode == 2) { const int pn = R0 >> 8, within = R0 & 255, half = within >> 7, j = within & 127; srcc = half * DFF + 128 * pn + j; }
        transpose_item(W, Nsrc, K, kb * 64, srcc, valid, gain, WT, R0, scr, F.lane);
    }
    for (int m = gw; m < M + MEMR; m += NGW) {
        const bool isx = m < M; const int r = isx ? m : m - M;
        const float* src = (isx ? F.in[0] : F.in[1]) + (size_t)r * DM;
        bf16* dst = (bf16*)(F.ws + (isx ? WS_XB : WS_MEMB)) + (size_t)r * DM;
        float s = 0.f;
#pragma unroll
        for (int j = 0; j < 8; ++j) {
            const f32x4 v = *(const f32x4*)(src + (j * 64 + F.lane) * 4);
            s += (v[0] * v[0] + v[1] * v[1]) + (v[2] * v[2] + v[3] * v[3]);
            uint2 w; w.x = pk2(v[0], v[1]); w.y = pk2(v[2], v[3]);
            *(uint2*)(dst + (j * 64 + F.lane) * 4) = w;
        }
        s = wave_sum(s);
        if (F.lane == 0) { if (isx) ss_ptr(F.ws, 0)[r] = s; else ((float*)(F.ws + WS_MEMSS))[r] = s; }
    }
    float* rope = (float*)(F.ws + WS_ROPE);
    for (int idx = (F.vcu * NWAVES + F.wave) * 64 + F.lane; idx < SEQ * 32; idx += NGW * 64) {
        const int pos = idx >> 5, i = idx & 31;
        const float inv = powf(10000.f, -(float)i * (1.f / 32.f)); const float ang = (float)pos * inv;
        rope[2 * idx] = cosf(ang); rope[2 * idx + 1] = sinf(ang);
    }
    if (blockIdx.x == 0 && F.tid < 16) ((bf16*)(F.ws + WS_FQA))[F.tid] = F.tid < 3 ? (bf16)0x3F80 : (bf16)0;
}

__device__ __forceinline__ v4u headnorm8(v4u raw, const float* g, int d0, float sc, float* keep) {
    float x[8] = {bflo(raw.x), bfhi(raw.x), bflo(raw.y), bfhi(raw.y), bflo(raw.z), bfhi(raw.z), bflo(raw.w), bfhi(raw.w)};
    float s = 0.f;
#pragma unroll
    for (int j = 0; j < 8; ++j) s += x[j] * x[j];
    s = grp16_sum(s);
    const float rs = rsqrtf(s * (1.f / 128.f) + EPS) * sc;
#pragma unroll
    for (int j = 0; j < 8; ++j) { x[j] = x[j] * rs * g[d0 + j]; if (keep) keep[j] = x[j]; }
    v4u o; o.x = pk2(x[0], x[1]); o.y = pk2(x[2], x[3]); o.z = pk2(x[4], x[5]); o.w = pk2(x[6], x[7]);
    return o;
}
__device__ __forceinline__ void prep_phase(Frame& F, int l) {
    bf16* PROJ = (bf16*)(F.ws + WS_PROJ);
    const float* g_fq = F.in[5] + l * 128; const float* g_fk = F.in[6] + l * 128; const float* b_f = F.in[4] + l * 4;
    const float* g_ql = F.in[7] + l * 512; const float* g_kvl = F.in[9] + l * 256; const float* g_mk = F.in[12] + l * 192;
    const float* g_bq = F.in[17] + l * 128; const float* g_bk = F.in[18] + l * 128;
    bf16* CQN = (bf16*)(F.ws + WS_CQN); bf16* CKVN = (bf16*)(F.ws + WS_CKVN); bf16* KPE = (bf16*)(F.ws + WS_KPE); bf16* BKA = (bf16*)(F.ws + WS_BKA);
    float* LF = (float*)(F.ws + WS_LF); float* LFSUM = (float*)(F.ws + WS_LFSUM); const float* rope = (const float*)(F.ws + WS_ROPE);
    float* KMEAN = (float*)(F.ws + CTL_KMEAN) + (size_t)l * (8 * 4 * 8 * 128);
    LAS float* red = (LAS float*)F.lds;
    const int lane = F.lane, d0 = (lane & 15) * 8;
    for (int unit = blockIdx.x; unit < M / 64; unit += gridDim.x) {
        float ksum[8]; float lfs = 0.f;
#pragma unroll
        for (int j = 0; j < 8; ++j) ksum[j] = 0.f;
        for (int i = 0; i < 8; ++i) {
            const int m = unit * 64 + F.wave * 8 + i, t = m & (SEQ - 1);
            bf16* pr = PROJ + (size_t)m * NPROJ;
            { v4u* p = (v4u*)(pr + PC_FQ + lane * 8); *p = headnorm8(*p, g_fq, d0, QS128, nullptr); }
            { v4u* p = (v4u*)(pr + PC_FK + lane * 8); *p = headnorm8(*p, g_fk, d0, 1.f, nullptr); }
            if (lane < 4) { const float v = log_sigmoid_f(bf2f(pr[PC_FF + lane]) + b_f[lane]); LF[(size_t)m * 4 + lane] = v; lfs += v; }
            { const v4u raw = *(const v4u*)(pr + PC_MCQ + lane * 8);
              float x[8] = {bflo(raw.x), bfhi(raw.x), bflo(raw.y), bfhi(raw.y), bflo(raw.z), bfhi(raw.z), bflo(raw.w), bfhi(raw.w)}; float s = 0.f;
#pragma unroll
              for (int j = 0; j < 8; ++j) s += x[j] * x[j];
              s = wave_sum(s); const float rs = rsqrtf(s * (1.f / 512.f) + EPS);
#pragma unroll
              for (int j = 0; j < 8; ++j) x[j] = x[j] * rs * g_ql[lane * 8 + j];
              v4u o; o.x = pk2(x[0], x[1]); o.y = pk2(x[2], x[3]); o.z = pk2(x[4], x[5]); o.w = pk2(x[6], x[7]);
              *(v4u*)(CQN + (size_t)m * 512 + lane * 8) = o; }
            { const uint2 raw = *(const uint2*)(pr + PC_MCKV + lane * 4);
              float x[4] = {bflo(raw.x), bfhi(raw.x), bflo(raw.y), bfhi(raw.y)}; float s = (x[0] * x[0] + x[1] * x[1]) + (x[2] * x[2] + x[3] * x[3]);
              s = wave_sum(s); const float rs = rsqrtf(s * (1.f / 256.f) + EPS);
#pragma unroll
              for (int j = 0; j < 4; ++j) x[j] = x[j] * rs * g_kvl[lane * 4 + j];
              uint2 o; o.x = pk2(x[0], x[1]); o.y = pk2(x[2], x[3]);
              *(uint2*)(CKVN + (size_t)m * 256 + lane * 4) = o; }
            { float x = bf2f(pr[PC_MKR + lane]); const float s = wave_sum(x * x); x = x * rsqrtf(s * (1.f / 64.f) + EPS) * g_mk[128 + lane];
              const float other = __shfl_xor(x, 32); const int ii = lane & 31; const float c = rope[(t * 32 + ii) * 2], sn = rope[(t * 32 + ii) * 2 + 1];
              const float o = lane < 32 ? x * c - other * sn : other * sn + x * c;
              KPE[(size_t)m * 64 + lane] = (bf16)f2bf(o); }
            { v4u* p = (v4u*)(pr + PC_BQ + lane * 8); *p = headnorm8(*p, g_bq, d0, QS128, nullptr); }
            { float kf[8]; v4u* p = (v4u*)(pr + PC_BK + lane * 8); *p = headnorm8(*p, g_bk, d0, 1.f, kf);
#pragma unroll
              for (int j = 0; j < 8; ++j) ksum[j] += kf[j]; }
            if (lane < 16) BKA[(size_t)m * 16 + lane] = (lane == (t >> 8)) ? (bf16)0x3F80 : (bf16)0;
        }
#pragma unroll
        for (int j = 0; j < 8; ++j) red[F.wave * 512 + lane * 8 + j] = ksum[j];
        if (lane < 4) red[4096 + F.wave * 4 + lane] = lfs;
        __syncthreads();
        {
            float s = 0.f;
#pragma unroll
            for (int w = 0; w < 8; ++w) s += red[w * 512 + F.tid];
            const int m0 = unit * 64, b = m0 >> 11, blk = (m0 & (SEQ - 1)) >> 8, h = F.tid >> 7, d = F.tid & 127;
            atomicAdd(KMEAN + (((size_t)b * 4 + h) * 8 + blk) * 128 + d, s * (1.f / 256.f));
            if (F.tid < 4) { float q = 0.f;
#pragma unroll
                for (int w = 0; w < 8; ++w) q += red[4096 + w * 4 + F.tid];
                LFSUM[unit * 4 + F.tid] = q; }
        }
        __syncthreads();
    }
}

constexpr int VNT_STRIDE = 272;
__device__ __forceinline__ void gmlp_phase(Frame& F, int l) {
    const bf16* PROJ = (const bf16*)(F.ws + WS_PROJ); bf16* OMIX = (bf16*)(F.ws + WS_OMIX);
    const float* ln_g = F.in[13] + l * 512; const float* ln_b = F.in[14] + l * 512;
    const float* w_s = F.in[15] + (size_t)l * 4 * 128 * 128; const float* b_s = F.in[16] + l * 4 * 128; const float* gn = F.in[19] + l * 2048 + 2 * 512;
    LAS float* stats = (LAS float*)F.lds;
    LAS float* rowss = (LAS float*)(F.lds + 1024);
    LAS unsigned char* vnT = F.lds + 2048;
    const int lane = F.lane, r32 = lane & 31, hi = lane >> 5;
    for (int unit = blockIdx.x; unit < M / 128; unit += gridDim.x) {
        const int m0 = unit * 128;
        for (int i = 0; i < 16; ++i) {
            const int s = F.wave * 16 + i;
            const v4u raw = *(const v4u*)(PROJ + (size_t)(m0 + s) * NPROJ + PC_GV + lane * 8);
            float x[8] = {bflo(raw.x), bfhi(raw.x), bflo(raw.y), bfhi(raw.y), bflo(raw.z), bfhi(raw.z), bflo(raw.w), bfhi(raw.w)}; float sm = 0.f;
#pragma unroll
            for (int j = 0; j < 8; ++j) { x[j] = gelu_tanh(x[j]); sm += x[j]; }
            const float mean = wave_sum(sm) * (1.f / 512.f); float q = 0.f;
#pragma unroll
            for (int j = 0; j < 8; ++j) { const float d = x[j] - mean; q += d * d; }
            const float var = wave_sum(q) * (1.f / 512.f);
            if (lane == 0) { stats[s * 2] = mean; stats[s * 2 + 1] = rsqrtf(var + EPS); }
        }
        if (F.tid < 128) rowss[F.tid] = 0.f;
        __syncthreads();
        for (int g = 0; g < 4; ++g) {
            {
                const int s = F.tid >> 2, cq = F.tid & 3;
                const float mean = stats[s * 2], rstd = stats[s * 2 + 1];
                const bf16* src = PROJ + (size_t)(m0 + s) * NPROJ + PC_GV + g * 128 + cq * 32;
#pragma unroll
                for (int k = 0; k < 4; ++k) {
                    const v4u raw = *(const v4u*)(src + k * 8);
                    const float x[8] = {bflo(raw.x), bfhi(raw.x), bflo(raw.y), bfhi(raw.y), bflo(raw.z), bfhi(raw.z), bflo(raw.w), bfhi(raw.w)};
#pragma unroll
                    for (int j = 0; j < 8; ++j) {
                        const int c = cq * 32 + k * 8 + j, ch = g * 128 + c;
                        const float v = (gelu_tanh(x[j]) - mean) * rstd * ln_g[ch] + ln_b[ch];
                        *(LAS bf16*)(vnT + c * VNT_STRIDE + s * 2) = (bf16)f2bf(v);
                    }
                }
            }
            __syncthreads();
            const int tb = F.wave >> 1, cb0 = (F.wave & 1) * 2;
            f32x16 acc0 = {}, acc1 = {};
            const int trow = 32 * tb + r32;
            const float* wrow = w_s + ((size_t)g * 128 + trow) * 128;
            for (int ks = 0; ks < 2 * (tb + 1); ++ks) {
                const int s0 = 16 * ks + 8 * hi;
                const f32x4 wa = *(const f32x4*)(wrow + s0), wb = *(const f32x4*)(wrow + s0 + 4);
                float wv[8] = {wa[0], wa[1], wa[2], wa[3], wb[0], wb[1], wb[2], wb[3]};
#pragma unroll
                for (int j = 0; j < 8; ++j) if (s0 + j > trow) wv[j] = 0.f;
                v4u aw; aw.x = pk2(wv[0], wv[1]); aw.y = pk2(wv[2], wv[3]); aw.z = pk2(wv[4], wv[5]); aw.w = pk2(wv[6], wv[7]);
                const bf16x8 afrag = __builtin_bit_cast(bf16x8, aw);
                const bf16x8 b0 = *(const LAS bf16x8*)(vnT + (32 * cb0 + r32) * VNT_STRIDE + s0 * 2);
                const bf16x8 b1 = *(const LAS bf16x8*)(vnT + (32 * (cb0 + 1) + r32) * VNT_STRIDE + s0 * 2);
                acc0 = __builtin_amdgcn_mfma_f32_32x32x16_bf16(afrag, b0, acc0, 0, 0, 0);
                acc1 = __builtin_amdgcn_mfma_f32_32x32x16_bf16(afrag, b1, acc1, 0, 0, 0);
            }
#pragma unroll
            for (int i = 0; i < 16; ++i) {
                const int t = 32 * tb + (i & 3) + 8 * (i >> 2) + 4 * hi;
                const float bs = b_s[g * 128 + t];
                const int ch = g * 128 + 32 * cb0 + r32;
                const bf16* urow = PROJ + (size_t)(m0 + t) * NPROJ + PC_GU + ch;
                const float u0 = gelu_tanh(bf2f(urow[0])), u1 = gelu_tanh(bf2f(urow[32]));
                const float o0 = u0 * (acc0[i] + bs), o1 = u1 * (acc1[i] + bs);
                bf16* op = OMIX + (size_t)(m0 + t) * DM + 1024 + ch;
                const unsigned short h0 = (unsigned short)f2bf(o0), h1 = (unsigned short)f2bf(o1);
                op[0] = h0; op[32] = h1;
                const float f0 = bf2f(h0), f1 = bf2f(h1);
                float q = f0 * f0 + f1 * f1;
                q += __shfl_xor(q, 1); q += __shfl_xor(q, 2); q += __shfl_xor(q, 4); q += __shfl_xor(q, 8); q += __shfl_xor(q, 16);
                if (r32 == 0) atomicAdd((float*)(rowss + t), q);
            }
            __syncthreads();
        }
        {
            const int tb = F.wave >> 1, cb0 = (F.wave & 1) * 2;
            for (int g = 0; g < 4; ++g)
#pragma unroll
                for (int i = 0; i < 16; ++i) {
                    const int t = 32 * tb + (i & 3) + 8 * (i >> 2) + 4 * hi;
                    const float rs = rsqrtf(rowss[t] * (1.f / 512.f) + EPS);
                    const int ch = g * 128 + 32 * cb0 + r32;
                    bf16* op = OMIX + (size_t)(m0 + t) * DM + 1024 + ch;
                    op[0] = (bf16)f2bf(bf2f(op[0]) * rs * gn[ch]); op[32] = (bf16)f2bf(bf2f(op[32]) * rs * gn[ch + 32]);
                }
        }
        __syncthreads();
    }
}

__device__ __forceinline__ void foxbias_phase(Frame& F) {
    const float* LF = (const float*)(F.ws + WS_LF); const float* LFSUM = (const float*)(F.ws + WS_LFSUM); bf16* FKA = (bf16*)(F.ws + WS_FKA);
    for (int idx = blockIdx.x * 512 + F.tid; idx < M * 4; idx += gridDim.x * 512) {
        const int m = idx >> 2, h = idx & 3, unit = m >> 6, u0 = (m >> 11) * 32;
        float c = 0.f;
        for (int u = u0; u < unit; ++u) c += LFSUM[u * 4 + h];
        for (int mm = unit * 64; mm <= m; ++mm) c += LF[(size_t)mm * 4 + h];
        const float v = -c * LOG2E;
        const unsigned b0 = f2bf(v); const float r1 = v - __uint_as_float(b0 << 16);
        const unsigned b1 = f2bf(r1); const float r2 = r1 - __uint_as_float(b1 << 16);
        const unsigned b2 = f2bf(r2);
        v4u w0 = {b0 | (b1 << 16), b2, 0u, 0u}, w1 = {0u, 0u, 0u, 0u};
        *(v4u*)(FKA + (size_t)idx * 16) = w0; *(v4u*)(FKA + (size_t)idx * 16 + 8) = w1;
    }
}
__device__ __forceinline__ void gating_phase(Frame& F, int l) {
    const bf16* PROJ = (const bf16*)(F.ws + WS_PROJ); bf16* BQA = (bf16*)(F.ws + WS_BQA);
    const float* KMEAN = (const float*)(F.ws + CTL_KMEAN) + (size_t)l * (8 * 4 * 8 * 128);
    const int gw = blockIdx.x * NWAVES + F.wave, NGW = gridDim.x * NWAVES, lane = F.lane;
    for (int m = gw; m < M; m += NGW) {
        const int b = m >> 11, blk = (m & (SEQ - 1)) >> 8;
        for (int h = 0; h < 4; ++h) {
            const unsigned qw = *(const unsigned*)(PROJ + (size_t)m * NPROJ + PC_BQ + h * 128 + lane * 2);
            const float q0 = bflo(qw), q1 = bfhi(qw);
            float gate[8];
#pragma unroll
            for (int n = 0; n < 8; ++n) {
                gate[n] = -__builtin_inff();
                if (n < blk) { const float* km = KMEAN + (((size_t)b * 4 + h) * 8 + n) * 128 + lane * 2; gate[n] = wave_sum(q0 * km[0] + q1 * km[1]); }
            }
            unsigned sel = 0;
            if (blk <= 3) sel = (1u << blk) - 1u;
            else {
#pragma unroll
                for (int k = 0; k < 3; ++k) { int best = 0; float bv = -__builtin_inff();
#pragma unroll
                    for (int n = 0; n < 8; ++n) if (n < blk && !((sel >> n) & 1u) && gate[n] > bv) { bv = gate[n]; best = n; }
                    sel |= 1u << best; }
            }
            sel |= 1u << blk;
            if (lane < 16) BQA[((size_t)m * 4 + h) * 16 + lane] = (lane < 8 && lane < blk && !((sel >> lane) & 1u)) ? (bf16)0xC700 : (bf16)0;
        }
    }
}
__device__ __forceinline__ void mlapost_phase(Frame& F, int l) {
    bf16* QM = (bf16*)(F.ws + WS_QM); bf16* KVM = (bf16*)(F.ws + WS_KVM); bf16* XKV = (bf16*)(F.ws + WS_XKV) + (size_t)l * MEMR * 1024;
    const float* g_mq = F.in[11] + l * 192; const float* g_mk = F.in[12] + l * 192; const float* g_xk = F.in[26] + l * 128; const float* rope = (const float*)(F.ws + WS_ROPE);
    const int gw = blockIdx.x * NWAVES + F.wave, NGW = gridDim.x * NWAVES, lane = F.lane;
    for (int m = gw; m < M + MEMR; m += NGW) {
        if (m < M) {
            const int t = m & (SEQ - 1);
            for (int h = 0; h < 4; ++h) {
                { unsigned* p = (unsigned*)(QM + (size_t)m * 768 + h * 192 + lane * 2); const unsigned w = *p; float a = bflo(w), c = bfhi(w);
                  const float rs = rsqrtf(wave_sum(a * a + c * c) * (1.f / 128.f) + EPS) * QS192;
                  *p = pk2(a * rs * g_mq[lane * 2], c * rs * g_mq[lane * 2 + 1]); }
                { bf16* p = QM + (size_t)m * 768 + h * 192 + 128 + lane; float x = bf2f(*p);
                  x = x * rsqrtf(wave_sum(x * x) * (1.f / 64.f) + EPS) * g_mq[128 + lane];
                  const float other = __shfl_xor(x, 32); const int ii = lane & 31; const float c = rope[(t * 32 + ii) * 2], sn = rope[(t * 32 + ii) * 2 + 1];
                  const float o = lane < 32 ? x * c - other * sn : other * sn + x * c;
                  *p = (bf16)f2bf(o * QS192); }
                { unsigned* p = (unsigned*)(KVM + (size_t)m * 1024 + h * 256 + lane * 2); const unsigned w = *p; float a = bflo(w), c = bfhi(w);
                  const float rs = rsqrtf(wave_sum(a * a + c * c) * (1.f / 128.f) + EPS);
                  *p = pk2(a * rs * g_mk[lane * 2], c * rs * g_mk[lane * 2 + 1]); }
            }
        } else {
            const int r = m - M;
            for (int h = 0; h < 4; ++h) {
                unsigned* p = (unsigned*)(XKV + (size_t)r * 1024 + h * 128 + lane * 2); const unsigned w = *p; float a = bflo(w), c = bfhi(w);
                const float rs = rsqrtf(wave_sum(a * a + c * c) * (1.f / 128.f) + EPS);
                *p = pk2(a * rs * g_xk[lane * 2], c * rs * g_xk[lane * 2 + 1]);
            }
        }
    }
}
__device__ __forceinline__ void groupnorm_phase(Frame& F, int l) {
    bf16* OMIX = (bf16*)(F.ws + WS_OMIX); const float* gn = F.in[19] + l * 2048;
    const int gw = blockIdx.x * NWAVES + F.wave, NGW = gridDim.x * NWAVES, lane = F.lane;
    for (int m = gw; m < M; m += NGW) {
#pragma unroll
        for (int gi = 0; gi < 3; ++gi) {
            const int g = gi == 2 ? 3 : gi;
            v4u* p = (v4u*)(OMIX + (size_t)m * DM + g * 512 + lane * 8); const v4u raw = *p;
            float x[8] = {bflo(raw.x), bfhi(raw.x), bflo(raw.y), bfhi(raw.y), bflo(raw.z), bfhi(raw.z), bflo(raw.w), bfhi(raw.w)}; float s = 0.f;
#pragma unroll
            for (int j = 0; j < 8; ++j) s += x[j] * x[j];
            const float rs = rsqrtf(wave_sum(s) * (1.f / 512.f) + EPS);
#pragma unroll
            for (int j = 0; j < 8; ++j) x[j] = x[j] * rs * gn[g * 512 + lane * 8 + j];
            v4u o; o.x = pk2(x[0], x[1]); o.y = pk2(x[2], x[3]); o.z = pk2(x[4], x[5]); o.w = pk2(x[6], x[7]);
            *p = o;
        }
    }
}

struct AttnSpec {
    const bf16 *q0, *q1, *k0, *k1, *v; bf16* o;
    int pq0, pq1, pk0, pk1, pv, po;
    int hq0, hq1, hk0, hk1, hv, ho;
    int qrows, kvrows;
};
__device__ __forceinline__ int v_st(int k, int c) { const int kk = (k & ~0xC) | ((k & 4) << 1) | ((k & 8) >> 1); return ((kk >> 3) * 4 + (c >> 5)) * 512 + ((kk & 7) * 32 + (c & 31)) * 2; }
__device__ __forceinline__ int v_rd_base(int lane) { return ((lane & 3) << 3) | (((lane >> 2) & 3) << 6) | (((lane >> 4) & 1) << 5) | (((lane >> 5) & 1) << 8); }
__device__ __forceinline__ unsigned cvtpk(float lo, float hi) { unsigned r; asm volatile("v_cvt_pk_bf16_f32 %0, %1, %2" : "=v"(r) : "v"(lo), "v"(hi)); return r; }
#define SBAR() __builtin_amdgcn_sched_barrier(0)

template <int NKS, int NQ0, bool CAUSAL, bool QNORM>
__device__ __forceinline__ void attn_unit(LAS unsigned char* lds, const AttnSpec& S, int b, int h, int qb, const float* qgain) {
    constexpr int NCH = 2 * NKS, KSTR = (NCH + 1) * 16, KBUF = 64 * KSTR, VBUF = 16384, NP = (64 * NCH + 511) / 512;
    const int tid = otid(), wid = __builtin_amdgcn_readfirstlane(tid >> 6), lane = tid & 63, r32 = lane & 31, hi = lane >> 5;
    LAS unsigned char* kbuf = lds; LAS unsigned char* vbuf = lds + 2 * KBUF;
    const int q_row0 = qb * 256, qlo = q_row0 + wid * 32, qpos = qlo + r32;
    const int NT = CAUSAL ? (q_row0 + 256) / 64 : S.kvrows / 64;
    const bf16* k0p = S.k0 + (size_t)b * S.kvrows * S.pk0 + h * S.hk0;
    const bf16* k1p = S.k1 + (size_t)b * S.kvrows * S.pk1 + h * S.hk1;
    const bf16* vp = S.v + (size_t)b * S.kvrows * S.pv + h * S.hv;
    bf16x8 qr[NKS];
    {
        const bf16* q0p = S.q0 + ((size_t)b * S.qrows + qpos) * S.pq0 + h * S.hq0;
        const bf16* q1p = S.q1 + ((size_t)b * S.qrows + qpos) * S.pq1 + h * S.hq1;
#pragma unroll
        for (int d0 = 0; d0 < NKS; ++d0) {
            if (2 * d0 < NQ0) qr[d0] = *(const bf16x8*)(q0p + (2 * d0 + hi) * 8);
            else qr[d0] = *(const bf16x8*)(q1p + (2 * d0 + hi - NQ0) * 8);
        }
        if constexpr (QNORM) {
            float ssq = 0.f;
#pragma unroll
            for (int d0 = 0; d0 < NKS; ++d0)
#pragma unroll
                for (int j = 0; j < 8; ++j) { const float x = bf2f((unsigned short)qr[d0][j]); ssq += x * x; }
            ssq += __shfl_xor(ssq, 32);
            const float rs = rsqrtf(ssq * (1.f / 128.f) + EPS) * QS128;
#pragma unroll
            for (int d0 = 0; d0 < NKS; ++d0) {
                float x[8];
#pragma unroll
                for (int j = 0; j < 8; ++j) x[j] = bf2f((unsigned short)qr[d0][j]) * rs * qgain[d0 * 16 + hi * 8 + j];
                v4u w; w.x = pk2(x[0], x[1]); w.y = pk2(x[2], x[3]); w.z = pk2(x[4], x[5]); w.w = pk2(x[6], x[7]);
                qr[d0] = __builtin_bit_cast(bf16x8, w);
            }
        }
    }
    v4u kst[NP], vst[2];
    int koff[NP], voff[2]; const bf16* ksrc[NP]; const bf16* vsrc[2]; int kpitch[NP];
#pragma unroll
    for (int i = 0; i < NP; ++i) {
        const int idx = tid + 512 * i, row = idx / NCH, ch = idx - row * NCH;
        koff[i] = row * KSTR + ch * 16;
        if (ch < 16) { ksrc[i] = k0p + (size_t)row * S.pk0 + ch * 8; kpitch[i] = S.pk0; }
        else { ksrc[i] = k1p + (size_t)row * S.pk1 + (ch - 16) * 8; kpitch[i] = S.pk1; }
    }
#pragma unroll
    for (int i = 0; i < 2; ++i) { const int idx = tid + 512 * i, k = idx >> 4, c8 = idx & 15; voff[i] = v_st(k, c8 * 8); vsrc[i] = vp + (size_t)k * S.pv + c8 * 8; }
#define ATT_LOAD(t) do { _Pragma("unroll") for (int i_ = 0; i_ < NP; ++i_) if (tid + 512 * i_ < 64 * NCH) kst[i_] = *(const v4u*)(ksrc[i_] + (size_t)(t) * 64 * kpitch[i_]); \
        _Pragma("unroll") for (int i_ = 0; i_ < 2; ++i_) vst[i_] = *(const v4u*)(vsrc[i_] + (size_t)(t) * 64 * S.pv); } while (0)
#define ATT_WRITE(bf) do { _Pragma("unroll") for (int i_ = 0; i_ < NP; ++i_) if (tid + 512 * i_ < 64 * NCH) *(LAS v4u*)(kbuf + (bf) * KBUF + koff[i_]) = kst[i_]; \
        _Pragma("unroll") for (int i_ = 0; i_ < 2; ++i_) *(LAS v4u*)(vbuf + (bf) * VBUF + voff[i_]) = vst[i_]; } while (0)
    float m_run = -1e30f, l_run = 0.f; f32x16 o[4] = {};
    ATT_LOAD(0); ATT_WRITE(0); __syncthreads();
    for (int t = 0; t < NT; ++t) {
        const int cur = t & 1, kb = t * 64;
        if (t + 1 < NT) ATT_LOAD(t + 1);
        const bool act = !CAUSAL || (kb <= qlo + 31);
        if (act) {
            f32x16 p0 = {}, p1 = {};
            const LAS unsigned char* ka = kbuf + cur * KBUF + r32 * KSTR + hi * 16;
#pragma unroll
            for (int d0 = 0; d0 < NKS; ++d0) {
                const bf16x8 b0 = *(const LAS bf16x8*)(ka + d0 * 32);
                const bf16x8 b1 = *(const LAS bf16x8*)(ka + 32 * KSTR + d0 * 32);
                p0 = __builtin_amdgcn_mfma_f32_32x32x16_bf16(b0, qr[d0], p0, 0, 0, 0);
                p1 = __builtin_amdgcn_mfma_f32_32x32x16_bf16(b1, qr[d0], p1, 0, 0, 0);
            }
            if (CAUSAL && kb + 63 > qlo) {
                const float NEG = -__builtin_inff();
#pragma unroll
                for (int i = 0; i < 16; ++i) {
                    const int key = kb + (i & 3) + 8 * (i >> 2) + 4 * hi;
                    if (key > qpos) p0[i] = NEG;
                    if (key + 32 > qpos) p1[i] = NEG;
                }
            }
            float pmax = p0[0];
#pragma unroll
            for (int i = 1; i < 16; ++i) pmax = fmaxf(pmax, p0[i]);
#pragma unroll
            for (int i = 0; i < 16; ++i) pmax = fmaxf(pmax, p1[i]);
            pmax = fmaxf(pmax, __shfl_xor(pmax, 32));
            const float mn = fmaxf(m_run, pmax), alpha = __builtin_amdgcn_exp2f(m_run - mn);
            m_run = mn;
            float ps = 0.f;
#pragma unroll
            for (int i = 0; i < 16; ++i) { p0[i] = __builtin_amdgcn_exp2f(p0[i] - mn); ps += p0[i]; }
#pragma unroll
            for (int i = 0; i < 16; ++i) { p1[i] = __builtin_amdgcn_exp2f(p1[i] - mn); ps += p1[i]; }
            ps += __shfl_xor(ps, 32);
            l_run = l_run * alpha + ps;
            if (!__all(alpha == 1.f)) {
#pragma unroll
                for (int d = 0; d < 4; ++d)
#pragma unroll
                    for (int i = 0; i < 16; ++i) o[d][i] *= alpha;
            }
            bf16x8 pa0, pa1, pa2, pa3;
#define PK4(P, B_, OUT) do { unsigned a0 = cvtpk(P[B_ + 0], P[B_ + 1]), a1 = cvtpk(P[B_ + 2], P[B_ + 3]); \
        unsigned b0_ = cvtpk(P[B_ + 4], P[B_ + 5]), b1_ = cvtpk(P[B_ + 6], P[B_ + 7]); \
        auto r0 = __builtin_amdgcn_permlane32_swap(a0, b0_, false, false); auto r1 = __builtin_amdgcn_permlane32_swap(a1, b1_, false, false); \
        v4u w = {r0[0], r1[0], r0[1], r1[1]}; OUT = __builtin_bit_cast(bf16x8, w); } while (0)
            PK4(p0, 0, pa0); PK4(p0, 8, pa1); PK4(p1, 0, pa2); PK4(p1, 8, pa3);
#undef PK4
            const unsigned vb0 = (unsigned)(uintptr_t)(vbuf + cur * VBUF) + (unsigned)v_rd_base(lane);
#define TRRD(dst, off) asm volatile("ds_read_b64_tr_b16 %0, %1 offset:%2" : "=&v"(dst) : "v"(vb0), "i"(off) : "memory")
#define PV_D0(d0) do { s16x4 l0, l1, l2, l3, h0, h1, h2, h3; constexpr int b_ = (d0) * 512; \
        TRRD(l0, b_); TRRD(h0, b_ + 2048); TRRD(l1, b_ + 4096); TRRD(h1, b_ + 6144); TRRD(l2, b_ + 8192); TRRD(h2, b_ + 10240); TRRD(l3, b_ + 12288); TRRD(h3, b_ + 14336); \
        asm volatile("s_waitcnt lgkmcnt(0)" ::: "memory"); SBAR(); \
        o[d0] = __builtin_amdgcn_mfma_f32_32x32x16_bf16((bf16x8){l0[0], l0[1], l0[2], l0[3], h0[0], h0[1], h0[2], h0[3]}, pa0, o[d0], 0, 0, 0); \
        o[d0] = __builtin_amdgcn_mfma_f32_32x32x16_bf16((bf16x8){l1[0], l1[1], l1[2], l1[3], h1[0], h1[1], h1[2], h1[3]}, pa1, o[d0], 0, 0, 0); \
        o[d0] = __builtin_amdgcn_mfma_f32_32x32x16_bf16((bf16x8){l2[0], l2[1], l2[2], l2[3], h2[0], h2[1], h2[2], h2[3]}, pa2, o[d0], 0, 0, 0); \
        o[d0] = __builtin_amdgcn_mfma_f32_32x32x16_bf16((bf16x8){l3[0], l3[1], l3[2], l3[3], h3[0], h3[1], h3[2], h3[3]}, pa3, o[d0], 0, 0, 0); } while (0)
            PV_D0(0); PV_D0(1); PV_D0(2); PV_D0(3);
#undef PV_D0
#undef TRRD
        }
        if (t + 1 < NT) ATT_WRITE(cur ^ 1);
        __syncthreads();
    }
#undef ATT_LOAD
#undef ATT_WRITE
    const float inv = 1.f / l_run;
    bf16* orow = S.o + ((size_t)b * S.qrows + qpos) * S.po + h * S.ho;
#pragma unroll
    for (int d0 = 0; d0 < 4; ++d0)
#pragma unroll
        for (int g = 0; g < 4; ++g) {
            uint2 w; w.x = cvtpk(o[d0][4 * g] * inv, o[d0][4 * g + 1] * inv); w.y = cvtpk(o[d0][4 * g + 2] * inv, o[d0][4 * g + 3] * inv);
            *(uint2*)(orow + 32 * d0 + 8 * g + 4 * hi) = w;
        }
}

__device__ __forceinline__ int queue_next(gu32* ctr, LAS unsigned* slot) {
    __syncthreads();
    if (threadIdx.x == 0) *slot = __hip_atomic_fetch_add(ctr, 1u, __ATOMIC_RELAXED, __HIP_MEMORY_SCOPE_AGENT);
    __syncthreads();
    return (int)*slot;
}

__global__ void __launch_bounds__(256) naive_attn(AttnSpec S, int nq0, int nq1, int causal, int qnorm, const float* qgain) {
    const int tid = threadIdx.x, qi = tid >> 4, ln = tid & 15;
    const int bh = blockIdx.y, b = bh >> 2, h = bh & 3, t = blockIdx.x * 16 + qi;
    const bf16* q0p = S.q0 + ((size_t)b * S.qrows + t) * S.pq0 + h * S.hq0;
    const bf16* q1p = S.q1 + ((size_t)b * S.qrows + t) * S.pq1 + h * S.hq1;
    float q[12]; float qa = 0.f;
    const int n0 = nq0 / 16;
    for (int i = 0; i < 12; ++i) q[i] = i < n0 ? bf2f(q0p[ln + 16 * i]) : 0.f;
    if (nq1) qa = bf2f(q1p[ln]);
    if (qnorm) {
        float s = 0.f; for (int i = 0; i < 8; ++i) s += q[i] * q[i];
        s = grp16_sum(s); const float rs = rsqrtf(s * (1.f / 128.f) + EPS) * QS128;
        for (int i = 0; i < 8; ++i) q[i] = bf2f((unsigned short)f2bf(q[i] * rs * qgain[ln + 16 * i]));
    }
    const bf16* k0p = S.k0 + (size_t)b * S.kvrows * S.pk0 + h * S.hk0;
    const bf16* k1p = S.k1 + (size_t)b * S.kvrows * S.pk1 + h * S.hk1;
    const bf16* vp = S.v + (size_t)b * S.kvrows * S.pv + h * S.hv;
    const int nkey = causal ? t + 1 : S.kvrows;
    float m = -1e30f, l = 0.f, o[8];
    for (int i = 0; i < 8; ++i) o[i] = 0.f;
    for (int s = 0; s < nkey; ++s) {
        float d = 0.f;
        for (int i = 0; i < 8; ++i) d += q[i] * bf2f(k0p[(size_t)s * S.pk0 + ln + 16 * i]);
        if (n0 > 8) { for (int i = 8; i < 12; ++i) d += q[i] * bf2f(k1p[(size_t)s * S.pk1 + ln + 16 * (i - 8)]); }
        else if (nq1) d += qa * bf2f(k1p[(size_t)s * S.pk1 + ln]);
        d = grp16_sum(d);
        const float mn = fmaxf(m, d), al = exp2f(m - mn), p = exp2f(d - mn);
        const float pb = bf2f((unsigned short)f2bf(p));
        m = mn; l = l * al + p;
        for (int i = 0; i < 8; ++i) o[i] = o[i] * al + pb * bf2f(vp[(size_t)s * S.pv + ln + 16 * i]);
    }
    bf16* op = S.o + ((size_t)b * S.qrows + t) * S.po + h * S.ho;
    for (int i = 0; i < 8; ++i) op[ln + 16 * i] = (bf16)f2bf(o[i] / l);
}

#ifndef ATTN_NAIVE
#define ATTN_NAIVE 0
#endif
constexpr int LDS_BYTES = 147456;
constexpr int MISC_OFF = 131072 + 320;
constexpr int NPH_L = 14, NPHASE = 1 + 2 * NPH_L;

__device__ __forceinline__ AttnSpec spec_fox(unsigned char* ws) {
    bf16* PROJ = (bf16*)(ws + WS_PROJ); AttnSpec S;
    S.q0 = PROJ + PC_FQ; S.pq0 = NPROJ; S.hq0 = 128; S.q1 = (const bf16*)(ws + WS_FQA); S.pq1 = 0; S.hq1 = 0;
    S.k0 = PROJ + PC_FK; S.pk0 = NPROJ; S.hk0 = 128; S.k1 = (const bf16*)(ws + WS_FKA); S.pk1 = 64; S.hk1 = 16;
    S.v = PROJ + PC_FV; S.pv = NPROJ; S.hv = 128; S.o = (bf16*)(ws + WS_OMIX); S.po = DM; S.ho = 128; S.qrows = SEQ; S.kvrows = SEQ; return S;
}
__device__ __forceinline__ AttnSpec spec_moba(unsigned char* ws) {
    bf16* PROJ = (bf16*)(ws + WS_PROJ); AttnSpec S;
    S.q0 = PROJ + PC_BQ; S.pq0 = NPROJ; S.hq0 = 128; S.q1 = (const bf16*)(ws + WS_BQA); S.pq1 = 64; S.hq1 = 16;
    S.k0 = PROJ + PC_BK; S.pk0 = NPROJ; S.hk0 = 128; S.k1 = (const bf16*)(ws + WS_BKA); S.pk1 = 16; S.hk1 = 0;
    S.v = PROJ + PC_BV; S.pv = NPROJ; S.hv = 128; S.o = (bf16*)(ws + WS_OMIX) + 1536; S.po = DM; S.ho = 128; S.qrows = SEQ; S.kvrows = SEQ; return S;
}
__device__ __forceinline__ AttnSpec spec_mla(unsigned char* ws) {
    AttnSpec S; bf16* QM = (bf16*)(ws + WS_QM); bf16* KVM = (bf16*)(ws + WS_KVM);
    S.q0 = QM; S.pq0 = 768; S.hq0 = 192; S.q1 = QM; S.pq1 = 0; S.hq1 = 0;
    S.k0 = KVM; S.pk0 = 1024; S.hk0 = 256; S.k1 = (const bf16*)(ws + WS_KPE); S.pk1 = 64; S.hk1 = 0;
    S.v = KVM + 128; S.pv = 1024; S.hv = 256; S.o = (bf16*)(ws + WS_OMIX) + 512; S.po = DM; S.ho = 128; S.qrows = SEQ; S.kvrows = SEQ; return S;
}
__device__ __forceinline__ AttnSpec spec_cross(unsigned char* ws, int l) {
    AttnSpec S; bf16* XQ = (bf16*)(ws + WS_XQ); bf16* XKV = (bf16*)(ws + WS_XKV) + (size_t)l * MEMR * 1024;
    S.q0 = XQ; S.pq0 = 512; S.hq0 = 128; S.q1 = XQ; S.pq1 = 0; S.hq1 = 0;
    S.k0 = XKV; S.pk0 = 1024; S.hk0 = 128; S.k1 = XKV; S.pk1 = 0; S.hk1 = 0;
    S.v = XKV + 512; S.pv = 1024; S.hv = 128; S.o = (bf16*)(ws + WS_XO); S.po = 512; S.ho = 128; S.qrows = SEQ; S.kvrows = 256; return S;
}

__global__ void __launch_bounds__(NWAVES * 64, 2) mega(Params P) {
    extern __shared__ __attribute__((aligned(16))) unsigned char lds_raw[];
    Frame F;
    F.lds = (LAS unsigned char*)lds_raw;
    F.tid = threadIdx.x; F.lane = F.tid & 63; F.wave = __builtin_amdgcn_readfirstlane(F.tid >> 6);
    F.G = gridDim.x; { const int bx = blockIdx.x; F.vcu = (F.G % 8 == 0) ? (bx % 8) * (F.G / 8) + bx / 8 : bx; }
    F.in = P.in; F.out = P.out; F.ws = P.ws;
    volatile LAS unsigned* MISC = (volatile LAS unsigned*)(F.lds + MISC_OFF);
    for (int u = F.tid; u < (LDS_BYTES - 131072) / 4; u += NWAVES * 64) ((LAS unsigned*)(F.lds + 131072))[u] = 0u;
    __syncthreads();
    gu32* ctl = (gu32*)(P.ws + WS_CTL);
    const int lo = P.ph_lo, hi = P.ph_hi;
    XcdBarrier bar; bar.bar = (unsigned*)ctl + CW_BAR; bar.x = 0; bar.st = nullptr;
    if (hi - lo > 1) bar = xcd_barrier_post((unsigned*)ctl + CW_BAR, MISC + 8);
#define IN(k) (lo <= (k) && (k) < hi)
#ifndef PH_ENABLE
#define PH_ENABLE 0xFFFFF
#endif
#define PHEN(k) ((PH_ENABLE >> (k)) & 1)
#define REFRESH() do { F.tid = otid(); F.lane = F.tid & 63; F.wave = __builtin_amdgcn_readfirstlane(F.tid >> 6); } while (0)
#define SEAM(k) do { if (IN(k) && IN((k) + 1)) xcd_barrier(bar); } while (0)
    unsigned char* ws = P.ws;
    bf16* XB = (bf16*)(ws + WS_XB); bf16* PROJ = (bf16*)(ws + WS_PROJ); bf16* OMIX = (bf16*)(ws + WS_OMIX);

    if (PHEN(16) && IN(0)) { REFRESH(); p0_prologue(F); }
    SEAM(0);
    for (int l = 0; l < 2; ++l) {
        const int pb = 1 + NPH_L * l;
        if (PHEN(0) && IN(pb + 0)) {
            pg8::Gemm g{XB, wptr(ws, l, WO_IN), M, NPROJ, DM}; pg8::StaticOrder S; S.init(M, NPROJ, F.G, (int)blockIdx.x);
            EpiScale E{PROJ, NPROJ, ss_ptr(ws, 3 * l + 0), 1.f / DM};
            pg8::gemm_phase<EpiScale, pg8::StaticOrder, true, true>(F.lds, g, S, E);
        }
        SEAM(pb + 0);
        if (PHEN(1) && IN(pb + 1)) { if (PHEN(17)) { REFRESH(); prep_phase(F, l); } if (PHEN(18)) { REFRESH(); gmlp_phase(F, l); } }
        SEAM(pb + 1);
        if (PHEN(2) && IN(pb + 2)) {
            { pg8::Gemm g{(bf16*)(ws + WS_CQN), wptr(ws, l, WO_UQ), M, 768, 512}; pg8::StaticOrder S; S.init(M, 768, F.G, (int)blockIdx.x);
              EpiScale E{(bf16*)(ws + WS_QM), 768, nullptr, 0.f};
              pg8::gemm_phase<EpiScale, pg8::StaticOrder, true, true>(F.lds, g, S, E); }
            if (PHEN(15)) { REFRESH(); foxbias_phase(F); REFRESH(); gating_phase(F, l); }
        }
        SEAM(pb + 2);
        if (PHEN(3) && IN(pb + 3)) {
            pg8::Gemm g{(bf16*)(ws + WS_CKVN), wptr(ws, l, WO_UKV), M, 1024, 256}; pg8::StaticOrder S; S.init(M, 1024, F.G, (int)blockIdx.x);
            EpiScale E{(bf16*)(ws + WS_KVM), 1024, nullptr, 0.f};
            pg8::gemm_phase<EpiScale, pg8::StaticOrder, true, true>(F.lds, g, S, E);
        }
        SEAM(pb + 3);
        if (PHEN(4) && IN(pb + 4)) {
            pg8::Gemm g{(bf16*)(ws + WS_MEMB), wptr(ws, l, WO_XKV), MEMR, 1024, DM}; pg8::StaticOrder S; S.init(MEMR, 1024, F.G, (int)blockIdx.x);
            EpiScale E{(bf16*)(ws + WS_XKV) + (size_t)l * MEMR * 1024, 1024, (const float*)(ws + WS_MEMSS), 1.f / DM};
            pg8::gemm_phase<EpiScale, pg8::StaticOrder, true, true>(F.lds, g, S, E);
        }
        SEAM(pb + 4);
        if (PHEN(5) && IN(pb + 5)) { REFRESH(); mlapost_phase(F, l); }
        SEAM(pb + 5);
        if (PHEN(6) && IN(pb + 6)) {
#if !ATTN_NAIVE
            LAS unsigned* slot = (LAS unsigned*)(F.lds + MISC_OFF + 64);
            { const AttnSpec SF = spec_fox(ws), SB = spec_moba(ws); gu32* ctr = ctl + CW_Q + 64 * (2 * l);
              for (;;) { const int it = queue_next(ctr, slot); if (it >= 512) break;
                  const int qb = 7 - (it >> 6), r = it & 63, ty = r >> 5, bh = r & 31;
                  attn_unit<9, 16, true, false>(F.lds, ty ? SB : SF, bh >> 2, bh & 3, qb, nullptr); } }
            { const AttnSpec SM = spec_mla(ws); gu32* ctr = ctl + CW_Q + 64 * (2 * l + 1);
              for (;;) { const int it = queue_next(ctr, slot); if (it >= 256) break;
                  const int qb = 7 - (it >> 5), bh = it & 31;
                  attn_unit<12, 24, true, false>(F.lds, SM, bh >> 2, bh & 3, qb, nullptr); } }
#endif
        }
        SEAM(pb + 6);
        if (PHEN(7) && IN(pb + 7)) { REFRESH(); groupnorm_phase(F, l); }
        SEAM(pb + 7);
        if (PHEN(8) && IN(pb + 8)) {
            pg8::Gemm g{OMIX, wptr(ws, l, WO_OUT), M, DM, DM}; pg8::StaticOrder S; S.init(M, DM, F.G, (int)blockIdx.x);
            EpiResid E{l == 0 ? P.in[0] : P.out, P.out, XB, ss_ptr(ws, 3 * l + 1)};
            pg8::gemm_phase<EpiResid, pg8::StaticOrder, true, true>(F.lds, g, S, E);
        }
        SEAM(pb + 8);
        if (PHEN(9) && IN(pb + 9)) {
            pg8::Gemm g{XB, wptr(ws, l, WO_XQ), M, 512, DM}; pg8::StaticOrder S; S.init(M, 512, F.G, (int)blockIdx.x);
            EpiScale E{(bf16*)(ws + WS_XQ), 512, ss_ptr(ws, 3 * l + 1), 1.f / DM};
            pg8::gemm_phase<EpiScale, pg8::StaticOrder, true, true>(F.lds, g, S, E);
        }
        SEAM(pb + 9);
        if (PHEN(10) && IN(pb + 10)) {
#if !ATTN_NAIVE
            const AttnSpec SX = spec_cross(ws, l); const float* qg = P.in[25] + l * 128;
            for (int it = blockIdx.x; it < 256; it += gridDim.x) { attn_unit<8, 16, false, true>(F.lds, SX, it >> 5, (it >> 3) & 3, it & 7, qg); }
#endif
        }
        SEAM(pb + 10);
        if (PHEN(11) && IN(pb + 11)) {
            pg8::Gemm g{(bf16*)(ws + WS_XO), wptr(ws, l, WO_XO), M, DM, 512}; pg8::StaticOrder S; S.init(M, DM, F.G, (int)blockIdx.x);
            EpiResid E{P.out, P.out, XB, ss_ptr(ws, 3 * l + 2)};
            pg8::gemm_phase<EpiResid, pg8::StaticOrder, true, true>(F.lds, g, S, E);
        }
        SEAM(pb + 11);
        if (PHEN(12) && IN(pb + 12)) {
            pg8::Gemm g{XB, wptr(ws, l, WO_GU), M, 2 * DFF, DM}; pg8::StaticOrder S; S.init(M, 2 * DFF, F.G, (int)blockIdx.x);
            EpiSwiGLU E{PROJ, ss_ptr(ws, 3 * l + 2)};
            pg8::gemm_phase<EpiSwiGLU, pg8::StaticOrder, true, true>(F.lds, g, S, E);
        }
        SEAM(pb + 12);
        if (PHEN(13) && IN(pb + 13)) {
            pg8::Gemm g{PROJ, wptr(ws, l, WO_D), M, DM, DFF}; pg8::StaticOrder S; S.init(M, DM, F.G, (int)blockIdx.x);
            EpiResid E{P.out, P.out, XB, ss_ptr(ws, 3 * l + 3)};
            pg8::gemm_phase<EpiResid, pg8::StaticOrder, true, true>(F.lds, g, S, E);
        }
        SEAM(pb + 13);
    }
#undef IN
#undef SEAM
}

#ifndef N_LAUNCH_MODE
#define N_LAUNCH_MODE 0
#endif
extern "C" void kernel_launch(void* const* d_in, const int* in_sizes, int n_in, void* d_out, int out_size, void* d_ws, size_t ws_size, hipStream_t stream) {
    static int grid = 0;
    if (grid == 0) {
        if (n_in != 31 || out_size != M * DM || ws_size < WS_END) { fprintf(stderr, "kernel_launch: unexpected shapes (n_in %d out %d ws %zu)\n", n_in, out_size, ws_size); grid = -1; return; }
        int dev = 0, cus = 0, per_cu = 0;
        if (hipGetDevice(&dev) != hipSuccess || hipDeviceGetAttribute(&cus, hipDeviceAttributeMultiprocessorCount, dev) != hipSuccess) { grid = -1; return; }
        if (hipFuncSetAttribute((const void*)mega, hipFuncAttributeMaxDynamicSharedMemorySize, LDS_BYTES) != hipSuccess) { fprintf(stderr, "kernel_launch: hipFuncSetAttribute failed\n"); grid = -1; return; }
        if (hipOccupancyMaxActiveBlocksPerMultiprocessor(&per_cu, (const void*)mega, NWAVES * 64, LDS_BYTES) != hipSuccess || per_cu < 1) fprintf(stderr, "kernel_launch: occupancy query says %d\n", per_cu);
        (void)hipGetLastError();
        grid = cus;
    }
    if (grid < 0) return;
    (void)hipMemsetAsync((char*)d_ws + WS_CTL, 0, CTL_ZERO_BYTES, stream);
    Params p{};
    for (int i = 0; i < 31; ++i) p.in[i] = (const float*)d_in[i];
    p.out = (float*)d_out; p.ws = (unsigned char*)d_ws;
#if N_LAUNCH_MODE == 1
    p.ph_lo = 0; p.ph_hi = NPHASE;
    hipLaunchKernelGGL(mega, dim3(grid), dim3(NWAVES * 64), LDS_BYTES, stream, p);
#else
    for (int ph = 0; ph < NPHASE; ++ph) {
        p.ph_lo = ph; p.ph_hi = ph + 1;
        hipLaunchKernelGGL(mega, dim3(grid), dim3(NWAVES * 64), LDS_BYTES, stream, p);
#if ATTN_NAIVE
        const int pl = ph >= 1 ? (ph - 1) % NPH_L : -1, l = ph >= 1 ? (ph - 1) / NPH_L : 0;
        unsigned char* ws = (unsigned char*)d_ws;
        if (pl == 6) {
            AttnSpec SF, SB, SM;
            { bf16* PROJ = (bf16*)(ws + WS_PROJ);
              SF.q0 = PROJ + PC_FQ; SF.pq0 = NPROJ; SF.hq0 = 128; SF.q1 = (const bf16*)(ws + WS_FQA); SF.pq1 = 0; SF.hq1 = 0;
              SF.k0 = PROJ + PC_FK; SF.pk0 = NPROJ; SF.hk0 = 128; SF.k1 = (const bf16*)(ws + WS_FKA); SF.pk1 = 64; SF.hk1 = 16;
              SF.v = PROJ + PC_FV; SF.pv = NPROJ; SF.hv = 128; SF.o = (bf16*)(ws + WS_OMIX); SF.po = DM; SF.ho = 128; SF.qrows = SEQ; SF.kvrows = SEQ;
              SB.q0 = PROJ + PC_BQ; SB.pq0 = NPROJ; SB.hq0 = 128; SB.q1 = (const bf16*)(ws + WS_BQA); SB.pq1 = 64; SB.hq1 = 16;
              SB.k0 = PROJ + PC_BK; SB.pk0 = NPROJ; SB.hk0 = 128; SB.k1 = (const bf16*)(ws + WS_BKA); SB.pk1 = 16; SB.hk1 = 0;
              SB.v = PROJ + PC_BV; SB.pv = NPROJ; SB.hv = 128; SB.o = (bf16*)(ws + WS_OMIX) + 1536; SB.po = DM; SB.ho = 128; SB.qrows = SEQ; SB.kvrows = SEQ;
              bf16* QM = (bf16*)(ws + WS_QM); bf16* KVM = (bf16*)(ws + WS_KVM);
              SM.q0 = QM; SM.pq0 = 768; SM.hq0 = 192; SM.q1 = QM; SM.pq1 = 0; SM.hq1 = 0;
              SM.k0 = KVM; SM.pk0 = 1024; SM.hk0 = 256; SM.k1 = (const bf16*)(ws + WS_KPE); SM.pk1 = 64; SM.hk1 = 0;
              SM.v = KVM + 128; SM.pv = 1024; SM.hv = 256; SM.o = (bf16*)(ws + WS_OMIX) + 512; SM.po = DM; SM.ho = 128; SM.qrows = SEQ; SM.kvrows = SEQ; }
            hipLaunchKernelGGL(naive_attn, dim3(SEQ / 16, 32), dim3(256), 0, stream, SF, 128, 16, 1, 0, (const float*)nullptr);
            hipLaunchKernelGGL(naive_attn, dim3(SEQ / 16, 32), dim3(256), 0, stream, SB, 128, 16, 1, 0, (const float*)nullptr);
            hipLaunchKernelGGL(naive_attn, dim3(SEQ / 16, 32), dim3(256), 0, stream, SM, 192, 0, 1, 0, (const float*)nullptr);
        } else if (pl == 10) {
            AttnSpec S; bf16* XQ = (bf16*)(ws + WS_XQ); bf16* XKV = (bf16*)(ws + WS_XKV) + (size_t)l * MEMR * 1024;
            S.q0 = XQ; S.pq0 = 512; S.hq0 = 128; S.q1 = XQ; S.pq1 = 0; S.hq1 = 0;
            S.k0 = XKV; S.pk0 = 1024; S.hk0 = 128; S.k1 = XKV; S.pk1 = 0; S.hk1 = 0;
            S.v = XKV + 512; S.pv = 1024; S.hv = 128; S.o = (bf16*)(ws + WS_XO); S.po = 512; S.ho = 128; S.qrows = SEQ; S.kvrows = 256;
            hipLaunchKernelGGL(naive_attn, dim3(SEQ / 16, 32), dim3(256), 0, stream, S, 128, 0, 0, 1, (const float*)d_in[25] + l * 128);
        }
#endif
    }
#endif
}
```

```cpp
#include <hip/hip_runtime.h>
#include <cstdio>
#include <cstdint>
__device__ __forceinline__ int olane() { int l; asm volatile("v_mbcnt_lo_u32_b32 %0, -1, 0\n\tv_mbcnt_hi_u32_b32 %0, -1, %0" : "=v"(l)); return l; }
__device__ __forceinline__ int otid(int wv) { return (wv << 6) | olane(); }
template <class T> __device__ __forceinline__ T* uni_launder(T* p) {
    const unsigned z = (unsigned)olane() >> 7; const unsigned long long v = (unsigned long long)p;
    const unsigned lo = (unsigned)__builtin_amdgcn_readfirstlane((int)((unsigned)v + z)), hi = (unsigned)__builtin_amdgcn_readfirstlane((int)(unsigned)(v >> 32));
    return (T*)(((unsigned long long)hi << 32) | lo);
}
__device__ __forceinline__ const char* uni64(const char* p) { const unsigned long long v = (unsigned long long)p; const unsigned lo = (unsigned)__builtin_amdgcn_readfirstlane((int)(unsigned)v), hi = (unsigned)__builtin_amdgcn_readfirstlane((int)(unsigned)(v >> 32)); return (const char*)(((unsigned long long)hi << 32) | lo); }
__device__ __forceinline__ float shx(float v, int mask, int lane) { return __uint_as_float((unsigned)__builtin_amdgcn_ds_bpermute((lane ^ mask) << 2, (int)__float_as_uint(v))); }
__device__ __forceinline__ float shup(float v, int d, int lane) { return __uint_as_float((unsigned)__builtin_amdgcn_ds_bpermute((lane >= d ? lane - d : lane) << 2, (int)__float_as_uint(v))); }
#define N_LAUNCH_MODE 1
namespace pg8 {
#define PG8_LAS __attribute__((address_space(3)))
typedef unsigned short bf16_t;
typedef short bf16x8 __attribute__((ext_vector_type(8)));
typedef float f32x4 __attribute__((ext_vector_type(4)));
typedef unsigned u32x4 __attribute__((ext_vector_type(4)));
constexpr int BM = 256, BK = 64, HALF = 128, HTB = HALF * BK * 2  , STAGE_BYTES = 8 * HTB, NXCD = 8, WGM = 4;

__host__ __device__ __forceinline__ int lds_byte(int r, int c) { const int st = (r >> 4) * 2 + (c >> 5), rr = r & 15, cc = c & 31, ob = rr * 64 + cc * 2; return st * 1024 + (ob ^ (((ob >> 9) & 1) << 5)); }
__host__ __device__ __forceinline__ void stage_rc(int b, int& R, int& C) { const int st = b / 1024, sb = b % 1024, swz = sb ^ (((sb >> 9) & 1) << 5); R = (st >> 1) * 16 + swz / 64; C = (st & 1) * 32 + (swz % 64) / 2; }
__host__ __device__ __forceinline__ int perm32(int rho) { const int n = rho >> 4, i = rho & 15; return 8 * (i >> 2) + 4 * n + (i & 3); }

struct Unit { int pm, pn; };
struct Gemm { const bf16_t* A; const bf16_t* Bt; int M, N, K; };

struct StaticOrder {
    int nM, nN, nwg, G, c;
    __host__ __device__ void init(int M, int N, int G_, int c_) { nM = M / BM; nN = N / BM; nwg = nM * nN; G = G_; c = c_; }
    __host__ __device__ bool next(int i, Unit& u) const {
        const long L = (long)i * G + c; if (L >= nwg) return false;
        int wgid = (int)L; { const int q = nwg / NXCD, r = nwg % NXCD, xcd = wgid % NXCD, off = wgid / NXCD; wgid = (xcd < r ? xcd * (q + 1) : r * (q + 1) + (xcd - r) * q) + off; }
        const int nig = WGM * nN, gid = wgid / nig, fm = gid * WGM, gsz = (nM - fm) < WGM ? (nM - fm) : WGM;
        u.pm = fm + ((wgid % nig) % gsz); u.pn = (wgid % nig) / gsz; return true;
    }
    __device__ __forceinline__ void a_ready(const Unit&) const {}
    __device__ __forceinline__ void done(const Unit&) const {}
};

struct ListOrder2 {
    int nM0, n0, nM1, n1, G, c;
    __host__ __device__ void init(int M0, int N0, int M1, int N1, int G_, int c_) { nM0 = M0 / BM; n0 = nM0 * (N0 / BM); nM1 = M1 / BM; n1 = nM1 * (N1 / BM); G = G_; c = c_; }
    __host__ __device__ bool next(int i, Unit& u) const {
        int L = i * G + c; if (L >= n0 + n1) return false;
        if (L < n0) { u.pm = L % nM0; u.pn = L / nM0; } else { L -= n0; u.pm = L % nM1; u.pn = (L / nM1) | 0x10000; }
        return true;
    }
    __device__ __forceinline__ void a_ready(const Unit&) const {}
    __device__ __forceinline__ void done(const Unit&) const {}
};
struct ListOrder2G {
    int pb0, np0, n0, pb1, np1, n1, gs, j;
    __host__ __device__ void init(int pb0_, int np0_, int nN0, int pb1_, int np1_, int nN1, int gs_, int j_) { pb0 = pb0_; np0 = np0_; n0 = np0_ * nN0; pb1 = pb1_; np1 = np1_; n1 = np1_ * nN1; gs = gs_; j = j_; }
    __host__ __device__ bool next(int i, Unit& u) const {
        int L = i * gs + j; if (L >= n0 + n1) return false;
        if (L < n0) { u.pm = pb0 + L % np0; u.pn = L / np0; } else { L -= n0; u.pm = pb1 + L % np1; u.pn = (L / np1) | 0x10000; }
        return true;
    }
    __device__ __forceinline__ void a_ready(const Unit&) const {}
    __device__ __forceinline__ void done(const Unit&) const {}
};
__device__ __forceinline__ unsigned cvt_pk_bf16(float lo, float hi) { unsigned r; asm volatile("v_cvt_pk_bf16_f32 %0, %1, %2" : "=v"(r) : "v"(lo), "v"(hi)); return r; }
typedef float f32x2 __attribute__((ext_vector_type(2)));
#ifndef FP8_DIAG_NONSCALED
#define FP8_DIAG_NONSCALED 0
#endif
typedef int v4i_t __attribute__((ext_vector_type(4)));
typedef int v8i_t __attribute__((ext_vector_type(8)));
__device__ __forceinline__ v8i_t cat8(bf16x8 a, bf16x8 b) { return __builtin_shufflevector(__builtin_bit_cast(v4i_t, a), __builtin_bit_cast(v4i_t, b), 0, 1, 2, 3, 4, 5, 6, 7); }
template <class Epi, class Sched, bool ALIGN_EPI = false, bool SP2 = false, bool FP8 = false, bool MULTI = false>
__device__ __forceinline__ void gemm_phase(PG8_LAS unsigned char* lds, const Gemm g, const Sched& S, const Epi& E, const int wv, const Gemm g1 = Gemm{nullptr, nullptr, 0, 0, 0}) {
    const int tid = otid(wv), wid = wv, lane = tid & 63, wr = wid >> 2, wc = wid & 3, fr = lane & 15, fq = lane >> 4;
    unsigned voffA[2], voffB[2], vRA[2], vRB[2], vC[2];
#pragma unroll
    for (int i = 0; i < 2; ++i) { int R, C; stage_rc(tid * 16 + i * 8192, R, C); const int Rb = Epi::PERM ? ((R & ~31) + perm32(R & 31)) : R;
        vRA[i] = (unsigned)R * 2u; vRB[i] = (unsigned)Rb * 2u; vC[i] = (unsigned)C * 2u; }
    const size_t kstep = (size_t)(BK * 2);
#define PG8_VA(i) (MULTI ? vRA[i] * (unsigned)K + vC[i] : voffA[i])
#define PG8_VB(i) (MULTI ? vRB[i] * (unsigned)K + vC[i] : voffB[i])
#define PG8_VA2(i) (MULTI ? vRA[i] * (unsigned)K2 + vC[i] : voffA[i])
#define PG8_VB2(i) (MULTI ? vRB[i] * (unsigned)K2 + vC[i] : voffB[i])
#define PG8_GK(u) ((MULTI && ((u).pn >> 16)) ? g1.K : g.K)
#define PG8_GA(u) ((MULTI && ((u).pn >> 16)) ? (const char*)g1.A : (const char*)g.A)
#define PG8_GB(u) ((MULTI && ((u).pn >> 16)) ? (const char*)g1.Bt : (const char*)g.Bt)
    const unsigned ldsw = (unsigned)wid * 1024u; const unsigned ldsbase = (unsigned)__builtin_amdgcn_readfirstlane((int)((unsigned)(uintptr_t)lds + ldsw));
    const int aoff = lds_byte(wr * 64 + fr, fq * 8), boff = lds_byte(wc * 32 + fr, fq * 8);
#define PG8_SA(b, h) (((b) * 2 + (h)) * HTB)
#define PG8_SB(b, h) ((4 + (b) * 2 + (h)) * HTB)
#define PG8_STAGE(bufoff, gbase, voff) do { _Pragma("unroll") for (int _i = 0; _i < 2; ++_i) { unsigned keep_; \
        asm volatile("s_mov_b32 %0, m0\n\ts_add_u32 m0, %3, %4\n\ts_nop 2\n\tglobal_load_lds_dwordx4 %1, %2\n\ts_mov_b32 m0, %0"     \
            : "=&s"(keep_) : "v"(voff(_i)), "s"(uni64((const char*)(gbase))), "s"(ldsbase), "i"((bufoff) + _i * 8192) : "memory", "scc"); } } while (0)
#define PG8_LDA(dst, b, h) do { _Pragma("unroll") for (int m = 0; m < 4; ++m) { if constexpr (FP8) dst##8[m] = cat8(*(const PG8_LAS bf16x8*)(lds + PG8_SA(b, h) + aoff + m * 2048), *(const PG8_LAS bf16x8*)(lds + PG8_SA(b, h) + aoff + m * 2048 + 1024)); \
        else { _Pragma("unroll") for (int k = 0; k < 2; ++k) dst[m][k] = *(const PG8_LAS bf16x8*)(lds + PG8_SA(b, h) + aoff + m * 2048 + k * 1024); } } } while (0)
#define PG8_LDB(dst, b, h) do { _Pragma("unroll") for (int n = 0; n < 2; ++n) { if constexpr (FP8) dst##8[n] = cat8(*(const PG8_LAS bf16x8*)(lds + PG8_SB(b, h) + boff + n * 2048), *(const PG8_LAS bf16x8*)(lds + PG8_SB(b, h) + boff + n * 2048 + 1024)); \
        else { _Pragma("unroll") for (int k = 0; k < 2; ++k) dst[n][k] = *(const PG8_LAS bf16x8*)(lds + PG8_SB(b, h) + boff + n * 2048 + k * 1024); } } } while (0)
#define PG8_MMA(ai, bj, At, Bt) do { __builtin_amdgcn_s_setprio(1); _Pragma("unroll") for (int m = 0; m < 4; ++m) _Pragma("unroll") for (int n = 0; n < 2; ++n) { \
        if constexpr (FP8) { if constexpr (FP8_DIAG_NONSCALED) { _Pragma("unroll") for (int q_ = 0; q_ < 4; ++q_) { \
            const long bq_ = ((long)(unsigned)Bt##8[n][2 * q_ + 1] << 32) | (unsigned)Bt##8[n][2 * q_], aq_ = ((long)(unsigned)At##8[m][2 * q_ + 1] << 32) | (unsigned)At##8[m][2 * q_]; \
            acc[ai][bj][m][n] = __builtin_amdgcn_mfma_f32_16x16x32_fp8_fp8(bq_, aq_, acc[ai][bj][m][n], 0, 0, 0); } } \
          else asm volatile("v_mfma_scale_f32_16x16x128_f8f6f4 %0, %1, %2, %0, %3, %3 op_sel_hi:[0,0,0]" : "+v"(acc[ai][bj][m][n]) : "v"(Bt##8[n]), "v"(At##8[m]), "v"(scl1)); }   \
        else { _Pragma("unroll") for (int k = 0; k < 2; ++k) acc[ai][bj][m][n] = __builtin_amdgcn_mfma_f32_16x16x32_bf16(Bt[n][k], At[m][k], acc[ai][bj][m][n], 0, 0, 0); } } __builtin_amdgcn_s_setprio(0); } while (0)
#define PG8_WAIT_V(n) asm volatile("s_waitcnt vmcnt(" #n ")" ::: "memory")
#define PG8_WAIT_L(n) asm volatile("s_waitcnt lgkmcnt(" #n ")" ::: "memory")
#define PG8_BAR __builtin_amdgcn_s_barrier()
#define PG8_SCHED __builtin_amdgcn_sched_barrier(0)
    Unit cur, nxt; int ui = 0;
    if (!S.next(0, cur)) return;
    int K = PG8_GK(cur), nt = K / BK;
    size_t hstep = (size_t)HALF * K * 2;
#pragma unroll
    for (int i = 0; i < 2; ++i) { voffA[i] = vRA[i] * (unsigned)K + vC[i]; voffB[i] = vRB[i] * (unsigned)K + vC[i]; }
    f32x4 acc[2][2][4][2];
#pragma unroll
    for (int a = 0; a < 2; ++a)
#pragma unroll
        for (int b = 0; b < 2; ++b)
#pragma unroll
            for (int m = 0; m < 4; ++m)
#pragma unroll
                for (int n = 0; n < 2; ++n) acc[a][b][m][n] = (f32x4){0.f, 0.f, 0.f, 0.f};
    bf16x8 At[4][2], B0[2][2], B1[2][2]; v8i_t At8[4], B08[2], B18[2]; int scl1 = 0x7F7F7F7F; asm volatile("" : "+v"(scl1));
    const char* cA = PG8_GA(cur) + (size_t)cur.pm * 2 * hstep; const char* cB = PG8_GB(cur) + (size_t)(cur.pn & 0xffff) * 2 * hstep;
    S.a_ready(cur);
    if constexpr (SP2) {
        PG8_STAGE(PG8_SB(0, 0), cB, PG8_VB); PG8_STAGE(PG8_SB(0, 1), cB + hstep, PG8_VB); PG8_STAGE(PG8_SA(0, 0), cA, PG8_VA); PG8_STAGE(PG8_SA(0, 1), cA + hstep, PG8_VA);
        if (wr == 1) PG8_BAR;
        PG8_WAIT_V(2); PG8_BAR;
        PG8_STAGE(PG8_SB(1, 0), cB + kstep, PG8_VB); PG8_STAGE(PG8_SA(1, 0), cA + kstep, PG8_VA); PG8_STAGE(PG8_SB(1, 1), cB + hstep + kstep, PG8_VB);
        PG8_WAIT_V(6); PG8_BAR;
    } else {
        PG8_STAGE(PG8_SB(0, 0), cB, PG8_VB); PG8_STAGE(PG8_SA(0, 0), cA, PG8_VA); PG8_STAGE(PG8_SB(0, 1), cB + hstep, PG8_VB); PG8_STAGE(PG8_SA(0, 1), cA + hstep, PG8_VA);
        if (wr == 1) PG8_BAR;
        PG8_WAIT_V(4); PG8_BAR;
        PG8_STAGE(PG8_SB(1, 0), cB + kstep, PG8_VB); PG8_STAGE(PG8_SA(1, 0), cA + kstep, PG8_VA); PG8_STAGE(PG8_SB(1, 1), cB + hstep + kstep, PG8_VB);
        PG8_WAIT_V(6); PG8_BAR;
    }
    for (;;) {
        const bool has_next = S.next(ui + 1, nxt);
        int Kn = K; size_t hstepn = hstep;
        if constexpr (MULTI) { if (has_next) { Kn = PG8_GK(nxt); hstepn = (size_t)HALF * Kn * 2; } }
        const char* nA = has_next ? PG8_GA(nxt) + (size_t)nxt.pm * 2 * hstepn : cA; const char* nB = has_next ? PG8_GB(nxt) + (size_t)(nxt.pn & 0xffff) * 2 * hstepn : cB;
#pragma unroll 1
        for (int t = 0; t < nt; t += 2) {
            const bool last = (t == nt - 2);
            const char* a1 = cA + (size_t)(t + 1) * kstep;
            const char* a2 = last ? nA : cA + (size_t)(t + 2) * kstep; const char* b2 = last ? nB : cB + (size_t)(t + 2) * kstep;
            const char* a3 = a2 + kstep; const char* b3 = b2 + kstep;
            const int K2 = (MULTI && last) ? Kn : K; const size_t hs2 = (MULTI && last) ? hstepn : hstep;
            if (last && has_next) S.a_ready(nxt);
            if constexpr (SP2) {
            PG8_LDB(B0, 0, 0); PG8_LDB(B1, 0, 1); PG8_SCHED; PG8_LDA(At, 0, 0); PG8_STAGE(PG8_SA(1, 1), a1 + hstep, PG8_VA);
            PG8_WAIT_V(8); PG8_WAIT_L(0); PG8_BAR; PG8_MMA(0, 0, At, B0); PG8_MMA(0, 1, At, B1); PG8_BAR; PG8_SCHED;
            PG8_LDA(At, 0, 1); PG8_STAGE(PG8_SB(0, 0), b2, PG8_VB2); PG8_STAGE(PG8_SB(0, 1), b2 + hs2, PG8_VB2); PG8_STAGE(PG8_SA(0, 0), a2, PG8_VA2);
            PG8_WAIT_V(8); PG8_WAIT_L(0); PG8_BAR; PG8_MMA(1, 0, At, B0); PG8_MMA(1, 1, At, B1); PG8_BAR; PG8_SCHED;
            PG8_LDB(B0, 1, 0); PG8_LDB(B1, 1, 1); PG8_SCHED; PG8_LDA(At, 1, 0); PG8_STAGE(PG8_SA(0, 1), a2 + hs2, PG8_VA2);
            PG8_WAIT_V(8); PG8_WAIT_L(0); PG8_BAR; PG8_MMA(0, 0, At, B0); PG8_MMA(0, 1, At, B1); PG8_BAR; PG8_SCHED;
            PG8_LDA(At, 1, 1); PG8_STAGE(PG8_SB(1, 0), b3, PG8_VB2); PG8_STAGE(PG8_SB(1, 1), b3 + hs2, PG8_VB2); PG8_STAGE(PG8_SA(1, 0), a3, PG8_VA2);
            PG8_WAIT_V(8); PG8_WAIT_L(0); PG8_BAR; PG8_MMA(1, 0, At, B0); PG8_MMA(1, 1, At, B1); PG8_BAR; PG8_SCHED;
            } else {
            PG8_LDB(B0, 0, 0); PG8_SCHED; PG8_LDA(At, 0, 0); PG8_STAGE(PG8_SA(1, 1), a1 + hstep, PG8_VA);
            PG8_WAIT_L(8); PG8_BAR; PG8_WAIT_L(0); PG8_MMA(0, 0, At, B0); PG8_BAR; PG8_SCHED;
            PG8_LDB(B1, 0, 1); PG8_STAGE(PG8_SB(0, 0), b2, PG8_VB2);
            PG8_BAR; PG8_WAIT_L(0); PG8_MMA(0, 1, At, B1); PG8_BAR;
            PG8_LDA(At, 0, 1); PG8_STAGE(PG8_SA(0, 0), a2, PG8_VA2);
            PG8_BAR; PG8_WAIT_L(0); PG8_MMA(1, 0, At, B0); PG8_BAR; PG8_SCHED;
            PG8_STAGE(PG8_SB(0, 1), b2 + hs2, PG8_VB2);
            PG8_WAIT_V(6); PG8_BAR; PG8_MMA(1, 1, At, B1); PG8_BAR;
            PG8_LDB(B0, 1, 0); PG8_SCHED; PG8_LDA(At, 1, 0); PG8_STAGE(PG8_SA(0, 1), a2 + hs2, PG8_VA2);
            PG8_WAIT_L(8); PG8_BAR; PG8_WAIT_L(0); PG8_MMA(0, 0, At, B0); PG8_BAR; PG8_SCHED;
            PG8_LDB(B1, 1, 1); PG8_STAGE(PG8_SB(1, 0), b3, PG8_VB2);
            PG8_BAR; PG8_WAIT_L(0); PG8_MMA(0, 1, At, B1); PG8_BAR;
            PG8_LDA(At, 1, 1); PG8_STAGE(PG8_SA(1, 0), a3, PG8_VA2);
            PG8_BAR; PG8_WAIT_L(0); PG8_MMA(1, 0, At, B0); PG8_BAR; PG8_SCHED;
            PG8_STAGE(PG8_SB(1, 1), b3 + hs2, PG8_VB2);
            PG8_WAIT_V(6); PG8_BAR; PG8_MMA(1, 1, At, B1); PG8_BAR;
            }
        }
        if constexpr (FP8) asm volatile("s_nop 15\n\ts_nop 15" ::: "memory");
        if constexpr (ALIGN_EPI) { if (wr == 0) PG8_BAR; }
        if constexpr (!Epi::AFTER_DRAIN) { E(acc, cur, wr, wc, fr, fq); if constexpr (Epi::REP) { asm volatile("" ::: "memory"); const Epi E2_ = E.rep(); E2_(acc, cur, wr, wc, fr, fq); } S.done(cur); }
        if (!has_next) break;
#pragma unroll
        for (int a = 0; a < 2; ++a)
#pragma unroll
            for (int b = 0; b < 2; ++b)
#pragma unroll
                for (int m = 0; m < 4; ++m)
#pragma unroll
                    for (int n = 0; n < 2; ++n) acc[a][b][m][n] = (f32x4){0.f, 0.f, 0.f, 0.f};
        cur = nxt; cA = nA; cB = nB; ++ui;
        if constexpr (MULTI) { K = Kn; nt = K / BK; hstep = hstepn; }
        if constexpr (ALIGN_EPI) { if (wr == 1) PG8_BAR; }
    }
    PG8_WAIT_V(0);
    if constexpr (!ALIGN_EPI) { if (wr == 0) PG8_BAR; }
    PG8_BAR;
    if constexpr (Epi::AFTER_DRAIN) { E.fused(acc, cur, wr, wc, fr, fq, lds, wid, lane); S.done(cur); }
#undef PG8_VA
#undef PG8_VB
#undef PG8_VA2
#undef PG8_VB2
#undef PG8_GK
#undef PG8_GA
#undef PG8_GB
#undef PG8_SA
#undef PG8_SB
#undef PG8_STAGE
#undef PG8_LDA
#undef PG8_LDB
#undef PG8_MMA
#undef PG8_WAIT_V
#undef PG8_WAIT_L
#undef PG8_BAR
#undef PG8_SCHED
}
}
#define GAS __attribute__((address_space(1)))
#define LAS __attribute__((address_space(3)))
typedef unsigned short bf16;
typedef unsigned v4u __attribute__((ext_vector_type(4)));
typedef float f32x4 __attribute__((ext_vector_type(4)));
typedef short bf16x8 __attribute__((ext_vector_type(8)));
typedef GAS unsigned gu32;
typedef GAS unsigned long long gu64;
#define RLX_AGENT __ATOMIC_RELAXED, __HIP_MEMORY_SCOPE_AGENT
#define LDS_WAIT() asm volatile("s_waitcnt lgkmcnt(0)" ::: "memory")
#define VM_WAIT() asm volatile("s_waitcnt vmcnt(0)" ::: "memory")
__device__ __forceinline__ unsigned long long rt() { return __builtin_amdgcn_s_memrealtime(); }
__device__ __forceinline__ unsigned f2bf(float f) { unsigned u = __builtin_bit_cast(unsigned, f); return (u + 0x7fffu + ((u >> 16) & 1u)) >> 16; }
__device__ __forceinline__ unsigned pk2(float lo, float hi) { unsigned r; asm("v_cvt_pk_bf16_f32 %0, %1, %2" : "=v"(r) : "v"(lo), "v"(hi)); return r; }

#define XB_TMO      128
#define XB_XCNT(j)  (256  + 64 * (j))
#define XB_XSUB(j)  (1280 + 64 * (j))
#define XB_XGEN(j)  (2304 + 64 * (j))
#define XB_TOP      3328
#define XB_TOPGEN   3392
#define XCD_BAR_WORDS 3456
#define XB_SPIN_CAP (1u << 18)

__device__ __forceinline__ unsigned xb_ld(unsigned* p)              { return __hip_atomic_load(p, __ATOMIC_RELAXED, __HIP_MEMORY_SCOPE_AGENT); }
__device__ __forceinline__ unsigned xb_add(unsigned* p, unsigned v) { return __hip_atomic_fetch_add(p, v, __ATOMIC_RELAXED, __HIP_MEMORY_SCOPE_AGENT); }
__device__ __forceinline__ unsigned xb_xcc_id() { return (unsigned)__builtin_amdgcn_s_getreg((3 << 11) | 20) & 0xFu; }
#define XB_SPIN(cond, bar) do { unsigned _sp = 0; while (cond) { __builtin_amdgcn_s_sleep(1); \
    if ((++_sp & 255u) == 0u) { if (xb_ld(&(bar)[XB_TMO])) break; if (_sp > XB_SPIN_CAP) { atomicAdd(&(bar)[XB_TMO], 1u); break; } } } } while (0)

struct XcdBarrier {
    unsigned* bar; unsigned x; int wv;
    volatile LAS unsigned* st;
};

__device__ __forceinline__ XcdBarrier xcd_barrier_post(unsigned* bar, volatile LAS unsigned* st, const int wv) {
    XcdBarrier b; b.bar = bar; b.x = xb_xcc_id(); b.st = st; b.wv = wv;
    if (wv == 0 && olane() == 0) (void)xb_add(&bar[XB_XCNT(b.x)], 1u);
    return b;
}
__device__ __forceinline__ void xcd_barrier_complete(unsigned* bar, unsigned x, unsigned& nloc, unsigned& nx) {
    const unsigned G = gridDim.x * gridDim.y * gridDim.z;
    unsigned sum, cnt, mine, sp = 0u;
    for (;;) {
        sum = 0u; cnt = 0u; mine = 0u;
#pragma unroll
        for (unsigned j = 0; j < 16; ++j) { const unsigned c = xb_ld(&bar[XB_XCNT(j)]); sum += c; cnt += (c > 0u) ? 1u : 0u; mine = (j == x) ? c : mine; }
        if (sum == G) break;
        __builtin_amdgcn_s_sleep(1);
        if ((++sp & 255u) == 0u) { if (xb_ld(&bar[XB_TMO])) break; if (sp > XB_SPIN_CAP) { atomicAdd(&bar[XB_TMO], 1u); break; } }
    }
    nloc = mine > 0u ? mine : 1u; nx = cnt > 0u ? cnt : 1u;
}

__device__ __forceinline__ void xcd_barrier(const XcdBarrier& b) {
    asm volatile("s_waitcnt vmcnt(0)" ::: "memory");
    __syncthreads();
    if (b.wv == 0 && olane() == 0) {
        unsigned* bar = b.bar;
        __builtin_amdgcn_s_waitcnt(0);
        unsigned nloc = b.st[0], nx = b.st[1];
        if (nloc == 0u) { xcd_barrier_complete(bar, b.x, nloc, nx); b.st[0] = nloc; b.st[1] = nx; }
        const unsigned old = xb_add(&bar[XB_XSUB(b.x)], 1u);
        const unsigned gen = old / nloc;
        if (old + 1u == (gen + 1u) * nloc) {
            __builtin_amdgcn_fence(__ATOMIC_RELEASE, "agent");
            asm volatile("s_waitcnt vmcnt(0)" ::: "memory");
            const unsigned og = xb_add(&bar[XB_TOP], 1u);
            const unsigned tg = og / nx;
            if (og + 1u == (tg + 1u) * nx) xb_add(&bar[XB_TOPGEN], 1u);
            else XB_SPIN(xb_ld(&bar[XB_TOPGEN]) == tg, bar);
            __builtin_amdgcn_fence(__ATOMIC_ACQUIRE, "agent");
            xb_add(&bar[XB_XGEN(b.x)], 1u);
            asm volatile("s_waitcnt vmcnt(0)" ::: "memory");
        } else {
            XB_SPIN(xb_ld(&bar[XB_XGEN(b.x)]) == gen, bar);
            __builtin_amdgcn_fence(__ATOMIC_ACQUIRE, "agent");
            asm volatile("s_waitcnt vmcnt(0)" ::: "memory");
        }
    }
    __syncthreads();
}

struct GrpBarrier { unsigned* cnt; unsigned* tmo; unsigned target, step; int fast, wv; };
__device__ __forceinline__ void grp_barrier(GrpBarrier& gb) {
    asm volatile("s_waitcnt vmcnt(0)" ::: "memory");
    __syncthreads();
    gb.target += gb.step;
    if (gb.wv == 0 && olane() == 0) {
        __builtin_amdgcn_s_waitcnt(0);
        if (!gb.fast) { __builtin_amdgcn_fence(__ATOMIC_RELEASE, "agent"); asm volatile("s_waitcnt vmcnt(0)" ::: "memory"); }
        (void)xb_add(gb.cnt, 1u);
        { unsigned _sp = 0; while (xb_ld(gb.cnt) < gb.target) { __builtin_amdgcn_s_sleep(1);
            if ((++_sp & 255u) == 0u) { if (xb_ld(gb.tmo)) break; if (_sp > XB_SPIN_CAP) { atomicAdd(gb.tmo, 1u); break; } } } }
        __builtin_amdgcn_fence(__ATOMIC_ACQUIRE, "agent");
        asm volatile("s_waitcnt vmcnt(0)" ::: "memory");
    }
    __syncthreads();
}

typedef float f32x16 __attribute__((ext_vector_type(16)));
typedef short s16x4 __attribute__((ext_vector_type(4)));
typedef float f32x2v __attribute__((ext_vector_type(2)));

constexpr int M = 16384, DM = 2048, SEQ = 2048, NB = 8, NPROJ = 5120, DFF = 5632, MEMR = 2048, NIN = 4932;
constexpr float EPS = 1e-6f;
constexpr float LOG2E = 1.4426950408889634f;
constexpr float QS128 = 0.08838834764831845f * LOG2E;
constexpr float QS192 = 0.07216878364870322f * LOG2E;
constexpr int NWAVES = 8;

constexpr int PC_FQ = 0, PC_FK = 512, PC_FV = 1024, PC_MCQ = 1536, PC_MCKV = 2048, PC_MKR = 2304, PC_FF = 2368,
              PC_GU = 2560, PC_GV = 3072, PC_BQ = 3584, PC_BK = 4096, PC_BV = 4608;

constexpr size_t MiB = 1u << 20;
constexpr size_t WS_CTL = 683 * MiB + 1536 * 1024;
constexpr size_t WS_W = 1 * MiB, WL_STRIDE = 104 * MiB;
constexpr size_t WO_IN = 0, WO_OUT = 20 * MiB, WO_XQ = 28 * MiB, WO_XKV = 30 * MiB, WO_XO = 34 * MiB, WO_GU = 36 * MiB, WO_D = 80 * MiB,
                 WO_UQ = 102 * MiB, WO_UKV = 102 * MiB + 768 * 1024;
constexpr size_t WS_XB = 209 * MiB, WS_PROJ = 273 * MiB, WS_OMIX = 449 * MiB, WS_CQN = 513 * MiB, WS_CKVN = 529 * MiB, WS_QM = 537 * MiB,
                 WS_KVM = 561 * MiB, WS_XQ = 593 * MiB, WS_XO = 609 * MiB, WS_XKV = 625 * MiB, WS_MEMB = 633 * MiB, WS_FKA = 641 * MiB,
                 WS_BQA = 643 * MiB, WS_BKA = 645 * MiB, WS_KPE = 646 * MiB, WS_LF = 648 * MiB, WS_LFSUM = 648 * MiB + 512 * 1024,
                 WS_ROPE = 649 * MiB, WS_FQA = 649 * MiB + 512 * 1024, WS_MEMSS = 649 * MiB + 768 * 1024, WS_GSTAT = 648 * MiB + 768 * 1024, WS_FBIAS = 648 * MiB + 256 * 1024  , WS_TRIL = 650 * MiB, WS_X8 = 651 * MiB, WS_ACC = 683 * MiB  , WS_END = 685 * MiB; constexpr size_t WS_X8_OLD_ALIAS = 513 * MiB  ;
constexpr int CW_TMO = 0, CW_BAR = 4096  , CW_Q = 8192  , CW_GB = 16384  , CW_COLO = 16384 + 512  ;

struct Params { const float* in[31]; float* out; unsigned char* ws; int ph_lo, ph_hi; };

typedef const float* const __attribute__((address_space(4)))* KIN;
struct Frame {
    LAS unsigned char* lds;
    int tid, lane, wave, vcu, G;
    KIN in; float* out; unsigned char* ws;
};

template <int CTRL> __device__ __forceinline__ float dppf(float v) { return __builtin_bit_cast(float, __builtin_amdgcn_update_dpp(0, __builtin_bit_cast(int, v), CTRL, 0xF, 0xF, true)); }
__device__ __forceinline__ float sum32(float v) { const unsigned x = __builtin_bit_cast(unsigned, v); auto r = __builtin_amdgcn_permlane32_swap(x, x, false, false); return __builtin_bit_cast(float, (unsigned)r[0]) + __builtin_bit_cast(float, (unsigned)r[1]); }
__device__ __forceinline__ float max32(float v) { const unsigned x = __builtin_bit_cast(unsigned, v); auto r = __builtin_amdgcn_permlane32_swap(x, x, false, false); return fmaxf(__builtin_bit_cast(float, (unsigned)r[0]), __builtin_bit_cast(float, (unsigned)r[1])); }
__device__ __forceinline__ float sum16(float v) { const unsigned x = __builtin_bit_cast(unsigned, v); auto r = __builtin_amdgcn_permlane16_swap(x, x, false, false); return __builtin_bit_cast(float, (unsigned)r[0]) + __builtin_bit_cast(float, (unsigned)r[1]); }
__device__ __forceinline__ float grp8_sum(float v) { v += dppf<0xB1>(v); v += dppf<0x4E>(v); v += dppf<0x141>(v); return v; }
__device__ __forceinline__ float grp16_sum(float v) { v = grp8_sum(v); v += dppf<0x140>(v); return v; }
__device__ __forceinline__ float wave_sum(float v) { return sum32(sum16(grp16_sum(v))); }
__device__ __forceinline__ float bf2f(unsigned short b) { return __uint_as_float(((unsigned)b) << 16); }
__device__ __forceinline__ float bflo(unsigned w) { return __uint_as_float(w << 16); }
__device__ __forceinline__ float bfhi(unsigned w) { return __uint_as_float(w & 0xffff0000u); }
__device__ __forceinline__ void unpack8(const v4u raw, float (&x)[8]) { x[0] = bflo(raw.x); x[1] = bfhi(raw.x); x[2] = bflo(raw.y); x[3] = bfhi(raw.y); x[4] = bflo(raw.z); x[5] = bfhi(raw.z); x[6] = bflo(raw.w); x[7] = bfhi(raw.w); }
__device__ __forceinline__ v4u pack8f(const float (&x)[8]) { v4u o; o.x = pk2(x[0], x[1]); o.y = pk2(x[2], x[3]); o.z = pk2(x[4], x[5]); o.w = pk2(x[6], x[7]); return o; }
__device__ __forceinline__ float fp8clamp(float v) { return __builtin_amdgcn_fmed3f(v, -448.f, 448.f); }
__device__ __forceinline__ uint2 pack8_fp8(const float (&x)[8], float sc) {
    unsigned a = 0, c = 0;
    a = __builtin_amdgcn_cvt_pk_fp8_f32(fp8clamp(x[0] * sc), fp8clamp(x[1] * sc), a, false); a = __builtin_amdgcn_cvt_pk_fp8_f32(fp8clamp(x[2] * sc), fp8clamp(x[3] * sc), a, true);
    c = __builtin_amdgcn_cvt_pk_fp8_f32(fp8clamp(x[4] * sc), fp8clamp(x[5] * sc), c, false); c = __builtin_amdgcn_cvt_pk_fp8_f32(fp8clamp(x[6] * sc), fp8clamp(x[7] * sc), c, true);
    uint2 r; r.x = a; r.y = c; return r;
}
__device__ __forceinline__ float gelu_tanh(float x) {
    const float u = 0.7978845608028654f * (x + 0.044715f * x * x * x);
    const float e = __builtin_amdgcn_exp2f(u * 2.8853900817779268f);
    return x * (1.f - __builtin_amdgcn_rcpf(e + 1.f));
}
__device__ __forceinline__ float silu_f(float x) { return x * __builtin_amdgcn_rcpf(1.f + __builtin_amdgcn_exp2f(x * -1.4426950408889634f)); }
__device__ __forceinline__ float log_sigmoid_f(float x) { return fminf(x, 0.f) - log1pf(expf(-fabsf(x))); }

__device__ __forceinline__ bf16* wptr(unsigned char* ws, int l, size_t off) { return (bf16*)(ws + WS_W + (size_t)l * WL_STRIDE + off); }
typedef unsigned long long u64;
constexpr float SS_FIX = 1048576.f, SS_INV = 1.f / 1048576.f, KM_FIX = 1073741824.f, KM_INV = 1.f / 1073741824.f;
__device__ __forceinline__ u64* ss_ptr(unsigned char* ws, int k) { return (u64*)(ws + WS_ACC) + (size_t)k * M; }

__device__ __forceinline__ int queue_next(gu32* ctr, LAS unsigned* slot, const int wv) {
    __syncthreads();
    if (wv == 0 && olane() == 0) *slot = __hip_atomic_fetch_add(ctr, 1u, __ATOMIC_RELAXED, __HIP_MEMORY_SCOPE_AGENT);
    __syncthreads();
    return (int)*slot;
}

#ifndef REP_EPI_SCALE
#define REP_EPI_SCALE 0
#endif
#ifndef REP_EPI_SWIGLU
#define REP_EPI_SWIGLU 0
#endif
struct EpiScale {
    static constexpr bool PERM = true, AFTER_DRAIN = false, REP = REP_EPI_SCALE;
    __device__ __forceinline__ EpiScale rep() const { return *this; }
    bf16* O; int ldc; const u64* ss; float inv_kn; float oscale;
    __device__ __forceinline__ void operator()(const pg8::f32x4 (&acc)[2][2][4][2], const pg8::Unit& u, int wr_, int wc_, int fr_, int fq_) const {
        const int ot_ = olane(), wr = wr_, wc = wc_, fr = ot_ & 15, fq = ot_ >> 4;
        const int row0 = u.pm * 256 + wr * 64 + fr, col0 = u.pn * 256 + wc * 32 + 8 * fq;
        float scv[2][4];
#pragma unroll
        for (int ai = 0; ai < 2; ++ai)
#pragma unroll
            for (int m = 0; m < 4; ++m) scv[ai][m] = ss ? (float)ss[row0 + ai * 128 + m * 16] : 0.f;
#pragma unroll
        for (int ai = 0; ai < 2; ++ai)
#pragma unroll
            for (int m = 0; m < 4; ++m) {
                const int row = row0 + ai * 128 + m * 16;
                const float sc = ss ? rsqrtf(scv[ai][m] * (SS_INV * inv_kn) + EPS) * oscale : oscale;
                bf16* rowp = O + (size_t)row * ldc + col0;
#pragma unroll
                for (int bj = 0; bj < 2; ++bj) {
                    const pg8::f32x4 v0 = acc[ai][bj][m][0] * sc, v1 = acc[ai][bj][m][1] * sc;
                    v4u w; w.x = pg8::cvt_pk_bf16(v0[0], v0[1]); w.y = pg8::cvt_pk_bf16(v0[2], v0[3]); w.z = pg8::cvt_pk_bf16(v1[0], v1[1]); w.w = pg8::cvt_pk_bf16(v1[2], v1[3]);
                    *(v4u*)(rowp + bj * 128) = w;
                }
            }
    }
};
struct EpiScale2 {
    static constexpr bool PERM = true, AFTER_DRAIN = false, REP = false;
    EpiScale e0, e1;
    __device__ __forceinline__ void operator()(const pg8::f32x4 (&acc)[2][2][4][2], const pg8::Unit& u, int wr, int wc, int fr, int fq) const { const EpiScale e = (u.pn >> 16) ? e1 : e0; pg8::Unit v; v.pm = u.pm; v.pn = u.pn & 0xffff; e(acc, v, wr, wc, fr, fq); }
};
#ifndef XATT_FP8
#define XATT_FP8 1
#endif
#ifndef FFN_FP8
#define FFN_FP8 3
#endif
constexpr float X8_SCALE = 4.f;
#ifndef REP_EPI_RESID
#define REP_EPI_RESID 0
#endif
struct EpiResid2 {
    static constexpr bool PERM = true, AFTER_DRAIN = false, REP = REP_EPI_RESID != 0;
    bf16* xb; u64* ssn; unsigned char* x8; float* outf; float ascale;
    __device__ __forceinline__ EpiResid2 rep() const { EpiResid2 e = *this; if (!outf) { e.ascale = 0.f; e.ssn = nullptr; } return e; }
    __device__ __forceinline__ void operator()(const pg8::f32x4 (&acc)[2][2][4][2], const pg8::Unit& u, int wr_, int wc_, int fr_, int fq_) const {
        const int ot_ = olane(), wr = wr_, wc = wc_, fr = ot_ & 15, fq = ot_ >> 4;
        const int row0 = u.pm * 256 + wr * 64 + fr, col0 = u.pn * 256 + wc * 32 + 8 * fq;
        v4u xin[2][2][2];
#define RESID_LOAD(b_) do { _Pragma("unroll") for (int mm = 0; mm < 2; ++mm) _Pragma("unroll") for (int bj = 0; bj < 2; ++bj) \
            xin[(b_) & 1][mm][bj] = *(const v4u*)(xb + (size_t)(row0 + ((b_) >> 1) * 128 + (2 * ((b_) & 1) + mm) * 16) * DM + col0 + bj * 128); } while (0)
        RESID_LOAD(0);
#pragma unroll
        for (int b = 0; b < 4; ++b) {
            if (b + 1 < 4) RESID_LOAD(b + 1);
            const int ai = b >> 1;
#pragma unroll
            for (int mm = 0; mm < 2; ++mm) {
                const int m = 2 * (b & 1) + mm;
                const int row = row0 + ai * 128 + m * 16; float q = 0.f;
#pragma unroll
                for (int bj = 0; bj < 2; ++bj) {
                    const size_t idx = (size_t)row * DM + col0 + bj * 128;
                    float x[8]; unpack8(xin[b & 1][mm][bj], x);
#pragma unroll
                    for (int e = 0; e < 4; ++e) { x[e] += acc[ai][bj][m][0][e] * ascale; x[4 + e] += acc[ai][bj][m][1][e] * ascale; }
                    if (!outf) *(v4u*)(xb + idx) = pack8f(x);
                    if (outf) { __builtin_nontemporal_store((pg8::f32x4){x[0], x[1], x[2], x[3]}, (pg8::f32x4*)(outf + idx)); __builtin_nontemporal_store((pg8::f32x4){x[4], x[5], x[6], x[7]}, (pg8::f32x4*)(outf + idx + 4)); }
                    if (x8) *(uint2*)(x8 + idx) = pack8_fp8(x, X8_SCALE);
#pragma unroll
                    for (int e = 0; e < 8; ++e) q += x[e] * x[e];
                }
                q = sum32(sum16(q));
                if (fq == 0 && !outf && ssn) atomicAdd(ssn + row, (u64)(q * SS_FIX));
            }
        }
#undef RESID_LOAD
    }
};

constexpr float W8_SCALE = 256.f, ACT8_SCALE = 8.f, XO8_SCALE = 32.f;
template <bool OUT8> struct EpiSwiGLUx {
    static constexpr bool PERM = true, AFTER_DRAIN = false, REP = REP_EPI_SWIGLU;
    __device__ __forceinline__ EpiSwiGLUx rep() const { return *this; }
    void* O; const u64* ss; float insc;
    __device__ __forceinline__ void operator()(const pg8::f32x4 (&acc)[2][2][4][2], const pg8::Unit& u, int wr_, int wc_, int fr_, int fq_) const {
        typedef float f2 __attribute__((ext_vector_type(2)));
        const int ot_ = olane(), wr = wr_, wc = wc_, fr = ot_ & 15, fq = ot_ >> 4;
        const int row0 = u.pm * 256 + wr * 64 + fr, col0 = u.pn * 128 + wc * 32 + 8 * fq;
        float scv[2][4];
#pragma unroll
        for (int ai = 0; ai < 2; ++ai)
#pragma unroll
            for (int m = 0; m < 4; ++m) scv[ai][m] = (float)ss[row0 + ai * 128 + m * 16];
#pragma unroll
        for (int ai = 0; ai < 2; ++ai)
#pragma unroll
            for (int m = 0; m < 4; ++m) {
                const int row = row0 + ai * 128 + m * 16;
                const float sc = rsqrtf(scv[ai][m] * (SS_INV / DM) + EPS) * insc;
                const float nsl = sc * -1.4426950408889634f, scu = OUT8 ? sc * ACT8_SCALE : sc;
                float o[8];
#pragma unroll
                for (int n = 0; n < 2; ++n)
#pragma unroll
                    for (int p = 0; p < 2; ++p) {
                        const f2 ga = {acc[ai][0][m][n][2 * p], acc[ai][0][m][n][2 * p + 1]}, ua = {acc[ai][1][m][n][2 * p], acc[ai][1][m][n][2 * p + 1]};
                        const f2 g = ga * sc, t = ga * nsl, uu = ua * scu;
                        f2 ex; ex.x = __builtin_amdgcn_exp2f(t.x); ex.y = __builtin_amdgcn_exp2f(t.y);
                        const f2 d = ex + 1.f; f2 r; r.x = __builtin_amdgcn_rcpf(d.x); r.y = __builtin_amdgcn_rcpf(d.y);
                        const f2 out = (g * r) * uu;
                        o[n * 4 + 2 * p] = out.x; o[n * 4 + 2 * p + 1] = out.y;
                    }
                if constexpr (OUT8) *(uint2*)((unsigned char*)O + (size_t)row * DFF + col0) = pack8_fp8(o, 1.f);
                else *(v4u*)((bf16*)O + (size_t)row * DFF + col0) = pack8f(o);
            }
    }
};
struct WItem { const float* W; const float* gain; bf16* WT; int Nsrc, K, k0, srcc, valid, R0, f8; };
constexpr int ITEMS_L = 5120 + 2048 + 512 + 1024 + 512 + 11264 + 5632 + 192 + 128;
__device__ __forceinline__ WItem p0_decode(Frame& F, int git) {
    const int l = git >= ITEMS_L ? 1 : 0; int r = git - l * ITEMS_L;
    WItem d; d.gain = nullptr; d.f8 = 0; int ND, mode = 0;
    if (r < 5120) { d.W = F.in[3] + (size_t)l * DM * NIN; d.K = DM; d.Nsrc = NIN; ND = NPROJ; d.WT = wptr(F.ws, l, WO_IN); d.gain = F.in[2] + l * DM; mode = 1; }
    else if ((r -= 5120) < 2048) { d.W = F.in[20] + (size_t)l * DM * DM; d.K = DM; d.Nsrc = DM; ND = DM; d.WT = wptr(F.ws, l, WO_OUT); }
    else if ((r -= 2048) < 512) { d.W = F.in[23] + (size_t)l * DM * 512; d.K = DM; d.Nsrc = 512; ND = 512; d.WT = wptr(F.ws, l, WO_XQ); d.gain = F.in[21] + l * DM; d.f8 = XATT_FP8; }
    else if ((r -= 512) < 1024) { d.W = F.in[24] + (size_t)l * DM * 1024; d.K = DM; d.Nsrc = 1024; ND = 1024; d.WT = wptr(F.ws, l, WO_XKV); d.gain = F.in[22] + l * DM; d.f8 = XATT_FP8; }
    else if ((r -= 1024) < 512) { d.W = F.in[27] + (size_t)l * 512 * DM; d.K = 512; d.Nsrc = DM; ND = DM; d.WT = wptr(F.ws, l, WO_XO); d.f8 = XATT_FP8; }
    else if ((r -= 512) < 11264) { d.W = F.in[29] + (size_t)l * DM * 2 * DFF; d.K = DM; d.Nsrc = 2 * DFF; ND = 2 * DFF; d.WT = wptr(F.ws, l, WO_GU); d.gain = F.in[28] + l * DM; mode = 2; d.f8 = (FFN_FP8 & 1) != 0; }
    else if ((r -= 11264) < 5632) { d.W = F.in[30] + (size_t)l * DFF * DM; d.K = DFF; d.Nsrc = DM; ND = DM; d.WT = wptr(F.ws, l, WO_D); d.f8 = (FFN_FP8 & 2) != 0; }
    else if ((r -= 5632) < 192) { d.W = F.in[8] + (size_t)l * 512 * 768; d.K = 512; d.Nsrc = 768; ND = 768; d.WT = wptr(F.ws, l, WO_UQ); }
    else { r -= 192; d.W = F.in[10] + (size_t)l * 256 * 1024; d.K = 256; d.Nsrc = 1024; ND = 1024; d.WT = wptr(F.ws, l, WO_UKV); }
    const int nblk = ND / 32, kb = r / nblk, nb = r - kb * nblk, R0 = nb * 32;
    int srcc = R0, valid = 32;
    if (mode == 1) {
        if (R0 < 1536) srcc = R0; else if (R0 < 2368) srcc = R0 + 4; else if (R0 == 2368) { srcc = 1536; valid = 4; } else if (R0 < 2560) { srcc = 0; valid = 0; } else srcc = R0 - 188;
    } else if (mode == 2) { const int pn = R0 >> 8, within = R0 & 255, half = within >> 7, j = within & 127; srcc = half * DFF + 128 * pn + j; }
    d.k0 = kb * 64; d.srcc = srcc; d.valid = valid; d.R0 = R0;
    return d;
}
__device__ __forceinline__ void tr_load(const WItem& d, int lane, float (&v)[32]) {
    const int n = lane & 31, nn = n < d.valid ? n : 0, kh = lane >> 5;
    const float* src = d.W + (size_t)(d.k0 + kh) * d.Nsrc + d.srcc + nn;
#pragma unroll
    for (int i = 0; i < 32; ++i) v[i] = __builtin_nontemporal_load(src + (size_t)(2 * i) * d.Nsrc);
}
__device__ __forceinline__ void tr_store(const WItem& d, const float (&v)[32], LAS float* scr, int lane) {
    const int n = lane & 31, kh = lane >> 5;
    const bool ok = n < d.valid;
#pragma unroll
    for (int i = 0; i < 32; ++i) scr[(2 * i + kh) * 33 + n] = ok ? v[i] : 0.f;
    LDS_WAIT(); asm volatile("" ::: "memory");
    const int c = lane & 7;
    float gk[8];
#pragma unroll
    for (int j = 0; j < 8; ++j) gk[j] = d.gain ? d.gain[d.k0 + 8 * c + j] : 1.f;
#pragma unroll
    for (int j = 0; j < 4; ++j) {
        const int nr = (lane >> 3) + 8 * j; const LAS float* s = scr + (8 * c) * 33 + nr;
        float xv[8];
#pragma unroll
        for (int e = 0; e < 8; ++e) xv[e] = s[e * 33] * gk[e];
        if (d.f8) *(uint2*)((unsigned char*)d.WT + (size_t)(d.R0 + nr) * d.K + d.k0 + 8 * c) = pack8_fp8(xv, W8_SCALE);
        else *(GAS v4u*)(d.WT + (size_t)(d.R0 + nr) * d.K + d.k0 + 8 * c) = pack8f(xv);
    }
    LDS_WAIT(); asm volatile("" ::: "memory");
}
__device__ __forceinline__ void p0_weights(Frame& F, int gw, int NGW) {
    LAS float* scr = (LAS float*)(F.lds + F.wave * 16384);
    int it = gw; if (it >= 2 * ITEMS_L) return;
    WItem cur = p0_decode(F, it); float v[32]; tr_load(cur, F.lane, v);
#pragma unroll 1
    for (;;) {
        const int itn = it + NGW; const bool hn = itn < 2 * ITEMS_L;
        WItem nxt; float vn[32];
        if (hn) { nxt = p0_decode(F, itn); tr_load(nxt, F.lane, vn); }
        tr_store(cur, v, scr, F.lane);
        if (!hn) break;
        cur = nxt; it = itn;
#pragma unroll
        for (int i = 0; i < 32; ++i) v[i] = vn[i];
    }
}
__device__ __forceinline__ void p0_xrow_load(Frame& F, int m, f32x4 (&v)[8]) {
    const bool isx = m < M; const int r = isx ? m : m - M;
    const float* src = (isx ? F.in[0] : F.in[1]) + (size_t)r * DM;
#pragma unroll
    for (int j = 0; j < 8; ++j) v[j] = __builtin_nontemporal_load((const f32x4*)(src + (j * 64 + F.lane) * 4));
}
__device__ __forceinline__ void p0_prologue(Frame& F) {
    const int gw = F.vcu * NWAVES + F.wave, NGW = F.G * NWAVES;
    p0_weights(F, gw, NGW);
    if (gw < M + MEMR) {
        int m = gw; f32x4 v[8]; p0_xrow_load(F, m, v);
#pragma unroll 1
        for (;;) {
            const int mn = m + NGW; const bool hn = mn < M + MEMR;
            f32x4 vn[8];
            if (hn) p0_xrow_load(F, mn, vn);
            const bool isx = m < M; const int r = isx ? m : m - M;
            bf16* dst = (bf16*)(F.ws + (isx ? WS_XB : WS_MEMB)) + (size_t)r * DM;
            float s = 0.f;
#pragma unroll
            for (int j = 0; j < 8; ++j) {
                s += (v[j][0] * v[j][0] + v[j][1] * v[j][1]) + (v[j][2] * v[j][2] + v[j][3] * v[j][3]);
                if (XATT_FP8 && !isx) { unsigned a8 = 0; a8 = __builtin_amdgcn_cvt_pk_fp8_f32(fp8clamp(v[j][0] * X8_SCALE), fp8clamp(v[j][1] * X8_SCALE), a8, false); a8 = __builtin_amdgcn_cvt_pk_fp8_f32(fp8clamp(v[j][2] * X8_SCALE), fp8clamp(v[j][3] * X8_SCALE), a8, true);
                    *(unsigned*)(F.ws + WS_MEMB + (size_t)r * DM + (j * 64 + F.lane) * 4) = a8; }
                else { uint2 w; w.x = pk2(v[j][0], v[j][1]); w.y = pk2(v[j][2], v[j][3]);
                *(uint2*)(dst + (j * 64 + F.lane) * 4) = w; }
            }
            s = wave_sum(s);
            if (F.lane == 0) { if (isx) ss_ptr(F.ws, 0)[r] = (u64)(s * SS_FIX); else ((u64*)(F.ws + WS_MEMSS))[r] = (u64)(s * SS_FIX); }
            if (!hn) break;
            m = mn;
#pragma unroll
            for (int j = 0; j < 8; ++j) v[j] = vn[j];
        }
    }
    float* rope = (float*)(F.ws + WS_ROPE);
    const int gt = (F.vcu * NWAVES + F.wave) * 64 + F.lane, NGT = NGW * 64;
    for (int idx = gt; idx < SEQ * 32; idx += NGT) {
        const int pos = idx >> 5, i = idx & 31;
        const float inv = powf(10000.f, -(float)i * (1.f / 32.f)); const float ang = (float)pos * inv;
        rope[2 * idx] = cosf(ang); rope[2 * idx + 1] = sinf(ang);
    }
    bf16* tril = (bf16*)(F.ws + WS_TRIL);
    for (int idx = gt; idx < 2 * 4 * 128 * 128; idx += NGT) { const int s = idx & 127, t = (idx >> 7) & 127; tril[idx] = (bf16)(s <= t ? f2bf(F.in[15][idx]) : 0u); }
    if (blockIdx.x == 0 && F.tid < 16) ((bf16*)(F.ws + WS_FQA))[F.tid] = F.tid < 3 ? (bf16)0x3F80 : (bf16)0;
}

__device__ __forceinline__ v4u headnorm8(v4u raw, const float* g, int d0, float sc, float* keep) {
    float x[8]; unpack8(raw, x);
    float s = 0.f;
#pragma unroll
    for (int j = 0; j < 8; ++j) s += x[j] * x[j];
    s = grp16_sum(s);
    const float rs = rsqrtf(s * (1.f / 128.f) + EPS) * sc;
#pragma unroll
    for (int j = 0; j < 8; ++j) { x[j] = x[j] * rs * g[d0 + j]; if (keep) keep[j] = x[j]; }
    return pack8f(x);
}
struct PrepRow { v4u fk, mcq, bk, gv; uint2 mckv; unsigned short ff, mkr; };
__device__ __forceinline__ PrepRow prep_load(const bf16* pr, int lane) {
    PrepRow r;
    r.fk = *(const v4u*)(pr + PC_FK + lane * 8); r.mcq = *(const v4u*)(pr + PC_MCQ + lane * 8);
    r.bk = *(const v4u*)(pr + PC_BK + lane * 8); r.gv = *(const v4u*)(pr + PC_GV + lane * 8);
    r.mckv = *(const uint2*)(pr + PC_MCKV + lane * 4); r.ff = pr[PC_FF + (lane & 3)]; r.mkr = pr[PC_MKR + lane];
    return r;
}
__device__ __forceinline__ void prep_phase(Frame& F, int l) {
    bf16* PROJ = (bf16*)(F.ws + WS_PROJ);
    const float* g_fk = F.in[6] + l * 128; const float* b_f = F.in[4] + l * 4;
    const float* g_ql = F.in[7] + l * 512; const float* g_kvl = F.in[9] + l * 256; const float* g_mk = F.in[12] + l * 192;
    const float* g_bk = F.in[18] + l * 128;
    bf16* CQN = (bf16*)(F.ws + WS_CQN); bf16* CKVN = (bf16*)(F.ws + WS_CKVN); bf16* KPE = (bf16*)(F.ws + WS_KPE); bf16* BKA = (bf16*)(F.ws + WS_BKA);
    float* LF = (float*)(F.ws + WS_LF); float* LFSUM = (float*)(F.ws + WS_LFSUM); const float* rope = (const float*)(F.ws + WS_ROPE); float* GSTAT = (float*)(F.ws + WS_GSTAT);
    u64* KMQ = (u64*)(F.ws + WS_ACC + MiB) + (size_t)l * (8 * 4 * 8 * 128);
    LAS float* red = (LAS float*)F.lds;
    const int lane = F.lane, d0 = (lane & 15) * 8;
    for (int unit = F.vcu; unit < M / 64; unit += F.G) {
        float ksum[8]; float lfs = 0.f;
#pragma unroll
        for (int j = 0; j < 8; ++j) ksum[j] = 0.f;
        const int mbase = unit * 64 + F.wave * 8;
        PrepRow cur = prep_load(PROJ + (size_t)mbase * NPROJ, lane);
#pragma unroll 1
        for (int i = 0; i < 8; ++i) {
            const int m = mbase + i, t = m & (SEQ - 1);
            bf16* pr = PROJ + (size_t)m * NPROJ;
            PrepRow nxt = cur;
            if (i + 1 < 8) nxt = prep_load(pr + NPROJ, lane);
            const f32x2v cs = *(const f32x2v*)(rope + (t * 32 + (lane & 31)) * 2);
            *(v4u*)(pr + PC_FK + lane * 8) = headnorm8(cur.fk, g_fk, d0, 1.f, nullptr);
            if (lane < 4) { const float v = log_sigmoid_f(bf2f(cur.ff) + b_f[lane]); LF[(size_t)m * 4 + lane] = v; lfs += v; }
            { float x[8]; unpack8(cur.mcq, x); float s = 0.f;
#pragma unroll
              for (int j = 0; j < 8; ++j) s += x[j] * x[j];
              s = wave_sum(s); const float rs = rsqrtf(s * (1.f / 512.f) + EPS);
#pragma unroll
              for (int j = 0; j < 8; ++j) x[j] = x[j] * rs * g_ql[lane * 8 + j];
              *(v4u*)(CQN + (size_t)m * 512 + lane * 8) = pack8f(x); }
            { float x[4] = {bflo(cur.mckv.x), bfhi(cur.mckv.x), bflo(cur.mckv.y), bfhi(cur.mckv.y)}; float s = (x[0] * x[0] + x[1] * x[1]) + (x[2] * x[2] + x[3] * x[3]);
              s = wave_sum(s); const float rs = rsqrtf(s * (1.f / 256.f) + EPS);
#pragma unroll
              for (int j = 0; j < 4; ++j) x[j] = x[j] * rs * g_kvl[lane * 4 + j];
              uint2 o; o.x = pk2(x[0], x[1]); o.y = pk2(x[2], x[3]);
              *(uint2*)(CKVN + (size_t)m * 256 + lane * 4) = o; }
            { float x = bf2f(cur.mkr); const float s = wave_sum(x * x); x = x * rsqrtf(s * (1.f / 64.f) + EPS) * g_mk[128 + lane];
              const float other = __shfl_xor(x, 32);
              const float o = lane < 32 ? x * cs[0] - other * cs[1] : other * cs[1] + x * cs[0];
              KPE[(size_t)m * 64 + lane] = (bf16)f2bf(o); }
            { float kf[8]; *(v4u*)(pr + PC_BK + lane * 8) = headnorm8(cur.bk, g_bk, d0, 1.f, kf);
#pragma unroll
              for (int j = 0; j < 8; ++j) ksum[j] += kf[j]; }
            if (lane < 16) BKA[(size_t)m * 16 + lane] = (lane == (t >> 8)) ? (bf16)0x3F80 : (bf16)0;
            { float x[8]; unpack8(cur.gv, x); float sm = 0.f;
#pragma unroll
              for (int j = 0; j < 8; ++j) { x[j] = gelu_tanh(x[j]); sm += x[j]; }
              const float mean = wave_sum(sm) * (1.f / 512.f); float q = 0.f;
#pragma unroll
              for (int j = 0; j < 8; ++j) { const float d = x[j] - mean; q += d * d; }
              const float var = wave_sum(q) * (1.f / 512.f);
              if (lane == 0) { f32x2v st = {mean, rsqrtf(var + EPS)}; *(f32x2v*)(GSTAT + (size_t)m * 2) = st; } }
            cur = nxt;
        }
#pragma unroll
        for (int j = 0; j < 8; ++j) red[F.wave * 512 + lane * 8 + j] = ksum[j];
        if (lane < 4) red[4096 + F.wave * 4 + lane] = lfs;
        __syncthreads();
        {
            float s = 0.f;
#pragma unroll
            for (int w = 0; w < 8; ++w) s += red[w * 512 + F.tid];
            const int m0 = unit * 64, b = m0 >> 11, blk = (m0 & (SEQ - 1)) >> 8, h = F.tid >> 7, d = F.tid & 127;
            atomicAdd(KMQ + (((size_t)b * 4 + h) * 8 + blk) * 128 + d, (u64)(long long)(s * (KM_FIX / 256.f)));
            if (F.tid < 4) { float q = 0.f;
#pragma unroll
                for (int w = 0; w < 8; ++w) q += red[4096 + w * 4 + F.tid];
                LFSUM[unit * 4 + F.tid] = q; }
        }
        __syncthreads();
    }
}

constexpr int VNT_STRIDE = 272;
__device__ __forceinline__ void gmlp_unit(unsigned char* ws, KIN in, LAS unsigned char* lds, int l, int chunk, int g, const int wv) {
    const bf16* PROJ = (const bf16*)(ws + WS_PROJ); bf16* OMIX = (bf16*)(ws + WS_OMIX); const float* GSTAT = (const float*)(ws + WS_GSTAT);
    const float* ln_g = in[13] + l * 512; const float* ln_b = in[14] + l * 512; const float* b_s = in[16] + l * 4 * 128;
    const bf16* tril = (const bf16*)(ws + WS_TRIL) + ((size_t)l * 4 + g) * 128 * 128;
    LAS unsigned char* vnT = lds;
    const int tid = otid(wv), wave = wv, lane = tid & 63, r32 = lane & 31, hi = lane >> 5;
    const int m0 = chunk * 128;
    {
        const int s = tid >> 2, cq = tid & 3;
        const f32x2v st = *(const f32x2v*)(GSTAT + (size_t)(m0 + s) * 2);
        const bf16* src = PROJ + (size_t)(m0 + s) * NPROJ + PC_GV + g * 128 + cq * 32;
        v4u raw[4];
#pragma unroll
        for (int k = 0; k < 4; ++k) raw[k] = *(const v4u*)(src + k * 8);
#pragma unroll
        for (int k = 0; k < 4; ++k) {
            float x[8]; unpack8(raw[k], x);
#pragma unroll
            for (int j = 0; j < 8; ++j) {
                const int c = cq * 32 + k * 8 + j, ch = g * 128 + c;
                const float v = (gelu_tanh(x[j]) - st[0]) * st[1] * ln_g[ch] + ln_b[ch];
                *(LAS bf16*)(vnT + c * VNT_STRIDE + s * 2) = (bf16)f2bf(v);
            }
        }
    }
    __syncthreads();
    const int tb = wave >> 1, cb0 = (wave & 1) * 2;
    const int ch0 = g * 128 + 32 * cb0 + r32;
    unsigned short ur0[16], ur1[16];
#pragma unroll
    for (int i = 0; i < 16; ++i) {
        const int t = 32 * tb + (i & 3) + 8 * (i >> 2) + 4 * hi;
        const bf16* urow = PROJ + (size_t)(m0 + t) * NPROJ + PC_GU + ch0;
        ur0[i] = urow[0]; ur1[i] = urow[32];
    }
    f32x16 acc0 = {}, acc1 = {};
    const int trow = 32 * tb + r32;
    const bf16* wrow = tril + (size_t)trow * 128;
#pragma unroll 2
    for (int ks = 0; ks < 2 * (tb + 1); ++ks) {
        const int s0 = 16 * ks + 8 * hi;
        const bf16x8 afrag = *(const bf16x8*)(wrow + s0);
        const bf16x8 b0 = *(const LAS bf16x8*)(vnT + (32 * cb0 + r32) * VNT_STRIDE + s0 * 2);
        const bf16x8 b1 = *(const LAS bf16x8*)(vnT + (32 * (cb0 + 1) + r32) * VNT_STRIDE + s0 * 2);
        acc0 = __builtin_amdgcn_mfma_f32_32x32x16_bf16(afrag, b0, acc0, 0, 0, 0);
        acc1 = __builtin_amdgcn_mfma_f32_32x32x16_bf16(afrag, b1, acc1, 0, 0, 0);
    }
#pragma unroll
    for (int i = 0; i < 16; ++i) {
        const int t = 32 * tb + (i & 3) + 8 * (i >> 2) + 4 * hi;
        const float bs = b_s[g * 128 + t];
        bf16* op = OMIX + (size_t)(m0 + t) * DM + 1024 + ch0;
        op[0] = (bf16)f2bf(gelu_tanh(bf2f(ur0[i])) * (acc0[i] + bs));
        op[32] = (bf16)f2bf(gelu_tanh(bf2f(ur1[i])) * (acc1[i] + bs));
    }
    __syncthreads();
}

__device__ __forceinline__ void foxbias_phase(Frame& F) {
    const float* LF = (const float*)(F.ws + WS_LF); const float* LFSUM = (const float*)(F.ws + WS_LFSUM); bf16* FKA = (bf16*)(F.ws + WS_FKA);
    const int lane = F.lane;
    if (F.wave < 4)
    for (int unit = F.vcu; unit < M / 64; unit += F.G) {
        const int h = F.wave, u0 = unit & ~31, m = unit * 64 + lane;
        float pre = (u0 + lane < unit) ? LFSUM[(u0 + lane) * 4 + h] : 0.f;
        float v = LF[(size_t)m * 4 + h];
        pre = wave_sum(pre);
#pragma unroll
        for (int o = 1; o < 64; o <<= 1) { const float tt = __shfl_up(v, o); if (lane >= o) v += tt; }
        const float val = -(pre + v) * LOG2E;
        const unsigned b0 = f2bf(val); const float r1 = val - __uint_as_float(b0 << 16);
        const unsigned b1 = f2bf(r1); const float r2 = r1 - __uint_as_float(b1 << 16);
        const unsigned b2 = f2bf(r2);
        v4u w0 = {b0 | (b1 << 16), b2, 0u, 0u}, w1 = {0u, 0u, 0u, 0u};
        *(v4u*)(FKA + ((size_t)m * 4 + h) * 16) = w0; *(v4u*)(FKA + ((size_t)m * 4 + h) * 16 + 8) = w1;
        ((float*)(F.ws + WS_FBIAS))[(size_t)m * 4 + h] = val;
    }
}
__device__ __forceinline__ void gating_phase(Frame& F, int l, gu32* qctr, const int ubase, const int nunit) {
    const bf16* PROJ = (const bf16*)(F.ws + WS_PROJ); bf16* BQA = (bf16*)(F.ws + WS_BQA);
    const u64* KMQ = (const u64*)(F.ws + WS_ACC + MiB) + (size_t)l * (8 * 4 * 8 * 128);
    LAS float* km = (LAS float*)F.lds;
    const float* gbq = F.in[17] + l * 128;
    const int lane = F.lane, n = lane >> 3, dc = lane & 7;
    LAS unsigned* slot = (LAS unsigned*)(F.lds + 131072 + 320 + 64);
    for (;;) {
        const int qi_ = queue_next(qctr, slot, F.wave); if (qi_ >= nunit) break;
        const int unit = ubase + qi_;
        const int m0 = unit * 64, b = m0 >> 11, blk = (m0 & (SEQ - 1)) >> 8;
        for (int i = F.tid; i < 4 * 8 * 128; i += 512) km[i] = (float)(long long)KMQ[(size_t)b * 4096 + i] * KM_INV * gbq[i & 127];
        __syncthreads();
        const int mb = m0 + F.wave * 8;
        v4u q[4][2], qn[4][2];
#pragma unroll
        for (int h = 0; h < 4; ++h) { const bf16* p = PROJ + (size_t)mb * NPROJ + PC_BQ + h * 128 + dc * 16; q[h][0] = *(const v4u*)p; q[h][1] = *(const v4u*)(p + 8); }
#pragma unroll 1
        for (int i = 0; i < 8; ++i) {
            const int m = mb + i;
            if (i + 1 < 8) {
#pragma unroll
                for (int h = 0; h < 4; ++h) { const bf16* p = PROJ + (size_t)(m + 1) * NPROJ + PC_BQ + h * 128 + dc * 16; qn[h][0] = *(const v4u*)p; qn[h][1] = *(const v4u*)(p + 8); }
            }
#pragma unroll
            for (int h = 0; h < 4; ++h) {
                float x[16]; { float a[8], c[8]; unpack8(q[h][0], a); unpack8(q[h][1], c);
#pragma unroll
                    for (int j = 0; j < 8; ++j) { x[j] = a[j]; x[8 + j] = c[j]; } }
                const LAS float* kp = km + (h * 8 + n) * 128 + dc * 16;
                float gsum = 0.f;
#pragma unroll
                for (int j4 = 0; j4 < 4; ++j4) { const f32x4 kv = *(const LAS f32x4*)(kp + j4 * 4); gsum += x[j4 * 4] * kv[0] + x[j4 * 4 + 1] * kv[1] + x[j4 * 4 + 2] * kv[2] + x[j4 * 4 + 3] * kv[3]; }
                gsum = grp8_sum(gsum);
                const float gate = n < blk ? gsum : -__builtin_inff();
                int rank = 0;
#pragma unroll
                for (int xo = 1; xo < 8; ++xo) { const float og = __shfl_xor(gate, 8 * xo); const int on = n ^ xo; rank += (og > gate || (og == gate && on < n)) ? 1 : 0; }
                const bool selected = n < blk && (blk <= 3 || rank < 3);
                const bool masked = n < blk && !selected;
                if (dc == 0) BQA[((size_t)m * 4 + h) * 16 + n] = masked ? (bf16)0xC700 : (bf16)0;
                if (dc == 1) BQA[((size_t)m * 4 + h) * 16 + 8 + n] = (bf16)0;
            }
#pragma unroll
            for (int h = 0; h < 4; ++h) { q[h][0] = qn[h][0]; q[h][1] = qn[h][1]; }
        }
    }
}
__device__ __forceinline__ void groupnorm_phase(Frame& F, int l) {
    bf16* OMIX = (bf16*)(F.ws + WS_OMIX); const float* gn = F.in[19] + l * 2048;
    const int lane = F.lane;
    const int nst = F.vcu < M / 64 ? ((M / 64 - 1 - F.vcu) / F.G + 1) * 8 : 0;
    if (nst == 0) return;
#define GN_ROW(t_) ((F.vcu + ((t_) >> 3) * F.G) * 64 + F.wave + 8 * ((t_) & 7))
    v4u cur[4], nxt[4];
#pragma unroll
    for (int g = 0; g < 4; ++g) cur[g] = *(const v4u*)(OMIX + (size_t)GN_ROW(0) * DM + g * 512 + lane * 8);
#pragma unroll 1
    for (int t = 0; t < nst; ++t) {
        const int m = GN_ROW(t);
        if (t + 1 < nst) {
#pragma unroll
            for (int g = 0; g < 4; ++g) nxt[g] = *(const v4u*)(OMIX + (size_t)GN_ROW(t + 1) * DM + g * 512 + lane * 8);
        }
#pragma unroll
        for (int g = 0; g < 4; ++g) {
            float x[8]; unpack8(cur[g], x); float s = 0.f;
#pragma unroll
            for (int j = 0; j < 8; ++j) s += x[j] * x[j];
            const float rs = rsqrtf(wave_sum(s) * (1.f / 512.f) + EPS);
            const f32x4 g0 = *(const f32x4*)(gn + g * 512 + lane * 8), g1 = *(const f32x4*)(gn + g * 512 + lane * 8 + 4);
            x[0] *= rs * g0[0]; x[1] *= rs * g0[1]; x[2] *= rs * g0[2]; x[3] *= rs * g0[3]; x[4] *= rs * g1[0]; x[5] *= rs * g1[1]; x[6] *= rs * g1[2]; x[7] *= rs * g1[3];
            *(v4u*)(OMIX + (size_t)m * DM + g * 512 + lane * 8) = pack8f(x);
        }
#pragma unroll
        for (int g = 0; g < 4; ++g) cur[g] = nxt[g];
    }
#undef GN_ROW
}

struct AttnSpec {
    const bf16 *q0, *q1, *k0, *k1, *v; bf16* o;
    int pq0, pq1, pk0, pk1, pv, po;
    int hq0, hq1, hk0, hk1, hv, ho;
    int qrows, kvrows;
};
__device__ __forceinline__ int v_st(int k, int c) { const int kk = (k & ~0xC) | ((k & 4) << 1) | ((k & 8) >> 1); return ((kk >> 3) * 4 + (c >> 5)) * 512 + ((kk & 7) * 32 + (c & 31)) * 2; }
__device__ __forceinline__ int v_rd_base(int lane) { return ((lane & 3) << 3) | (((lane >> 2) & 3) << 6) | (((lane >> 4) & 1) << 5) | (((lane >> 5) & 1) << 8); }
__device__ __forceinline__ unsigned cvtpk(float lo, float hi) { unsigned r; asm volatile("v_cvt_pk_bf16_f32 %0, %1, %2" : "=v"(r) : "v"(lo), "v"(hi)); return r; }
#define SBAR() __builtin_amdgcn_sched_barrier(0)

template <int NKS, int NQ0, bool CAUSAL, int QMODE, bool KNORM, bool OUT8 = false>
__device__ __forceinline__ void attn_unit(LAS unsigned char* lds, const AttnSpec& S, int b, int h, int qb, const float* qgain, const float* kgain, const int wv, const float* rope = nullptr, const int t_lo = 0) {
    constexpr int NCH = 2 * NKS, KSTR = (NCH + 1) * 16, KBUF = 64 * KSTR, VBUF = 16384, NX = NCH - 16, NP = NX ? 3 : 2;
    const int tid = otid(wv), wid = wv, lane = tid & 63, r32 = lane & 31, hi = lane >> 5;
    LAS unsigned char* kbuf = lds; LAS unsigned char* vbuf = lds + 2 * KBUF;
    const int q_row0 = qb * 256, qlo = q_row0 + wid * 32, qpos = qlo + r32;
    const int NT = CAUSAL ? (q_row0 + 256) / 64 : S.kvrows / 64;
    const bf16* k0p = S.k0 + (size_t)b * S.kvrows * S.pk0 + h * S.hk0;
    const bf16* k1p = S.k1 + (size_t)b * S.kvrows * S.pk1 + h * S.hk1;
    const bf16* vp = S.v + (size_t)b * S.kvrows * S.pv + h * S.hv;
    bf16x8 qr[NKS];
    {
        const bf16* q0p = S.q0 + ((size_t)b * S.qrows + qpos) * S.pq0 + h * S.hq0;
        const bf16* q1p = S.q1 + ((size_t)b * S.qrows + qpos) * S.pq1 + h * S.hq1;
#pragma unroll
        for (int d0 = 0; d0 < NKS; ++d0) {
            if (2 * d0 < NQ0) qr[d0] = *(const bf16x8*)(q0p + (2 * d0 + hi) * 8);
            else qr[d0] = *(const bf16x8*)(q1p + (2 * d0 + hi - NQ0) * 8);
        }
    }
    v4u kst[NP], vst[2];
    int koff[NP], voff[2]; const bf16* ksrc[NP]; const bf16* vsrc[2]; int kpitch[NP];
#pragma unroll
    for (int i = 0; i < 2; ++i) { const int p = tid + 512 * i, row = p >> 4, ch = p & 15; koff[i] = row * KSTR + ch * 16; ksrc[i] = k0p + (size_t)row * S.pk0 + ch * 8; kpitch[i] = S.pk0; }
    if constexpr (NX > 0) { const int row = NX == 8 ? tid >> 3 : tid >> 1, ch = NX == 8 ? tid & 7 : tid & 1; koff[2] = row * KSTR + (16 + ch) * 16; ksrc[2] = k1p + (size_t)row * S.pk1 + ch * 8; kpitch[2] = S.pk1; }
    const bool xact = NX == 8 || tid < 128;
#pragma unroll
    for (int i = 0; i < 2; ++i) { const int idx = tid + 512 * i, k = idx >> 4, c8 = idx & 15; voff[i] = v_st(k, c8 * 8); vsrc[i] = vp + (size_t)k * S.pv + c8 * 8; }
#define ATT_LOAD(t) do { _Pragma("unroll") for (int i_ = 0; i_ < NP; ++i_) if (i_ < 2 || xact) kst[i_] = *(const v4u*)(ksrc[i_] + (size_t)(t) * 64 * kpitch[i_]); \
        _Pragma("unroll") for (int i_ = 0; i_ < 2; ++i_) vst[i_] = *(const v4u*)(vsrc[i_] + (size_t)(t) * 64 * S.pv); } while (0)
    ATT_LOAD(t_lo);
    {
        if constexpr (QMODE == 1) {
            float ssq = 0.f;
#pragma unroll
            for (int d0 = 0; d0 < 8; ++d0)
#pragma unroll
                for (int j = 0; j < 8; ++j) { const float x = bf2f((unsigned short)qr[d0][j]); ssq += x * x; }
            ssq = sum32(ssq);
            const float rs = rsqrtf(ssq * (1.f / 128.f) + EPS) * QS128;
#pragma unroll
            for (int d0 = 0; d0 < 8; ++d0) {
                float x[8];
#pragma unroll
                for (int j = 0; j < 8; ++j) x[j] = bf2f((unsigned short)qr[d0][j]) * rs * qgain[d0 * 16 + hi * 8 + j];
                v4u w; w.x = pk2(x[0], x[1]); w.y = pk2(x[2], x[3]); w.z = pk2(x[4], x[5]); w.w = pk2(x[6], x[7]);
                qr[d0] = __builtin_bit_cast(bf16x8, w);
            }
        }
        if constexpr (QMODE == 2) {
            float ssn = 0.f, ssp = 0.f;
#pragma unroll
            for (int d0 = 0; d0 < 8; ++d0)
#pragma unroll
                for (int j = 0; j < 8; ++j) { const float x = bf2f((unsigned short)qr[d0][j]); ssn += x * x; }
#pragma unroll
            for (int d0 = 8; d0 < 12; ++d0)
#pragma unroll
                for (int j = 0; j < 8; ++j) { const float x = bf2f((unsigned short)qr[d0][j]); ssp += x * x; }
            ssn = sum32(ssn); ssp = sum32(ssp);
            const float rsn = rsqrtf(ssn * (1.f / 128.f) + EPS) * QS192, rsp = rsqrtf(ssp * (1.f / 64.f) + EPS);
#pragma unroll
            for (int d0 = 0; d0 < 8; ++d0) {
                float x[8];
#pragma unroll
                for (int j = 0; j < 8; ++j) x[j] = bf2f((unsigned short)qr[d0][j]) * rsn * qgain[d0 * 16 + hi * 8 + j];
                qr[d0] = __builtin_bit_cast(bf16x8, pack8f(x));
            }
#pragma unroll
            for (int d0 = 8; d0 < 10; ++d0) {
                const int i0 = 16 * (d0 - 8) + 8 * hi;
                const float* rp = rope + ((size_t)qpos * 32 + i0) * 2;
                float o1[8], o2[8];
#pragma unroll
                for (int j = 0; j < 8; ++j) {
                    const float x1 = bf2f((unsigned short)qr[d0][j]) * rsp * qgain[128 + i0 + j], x2 = bf2f((unsigned short)qr[d0 + 2][j]) * rsp * qgain[160 + i0 + j];
                    const float c = rp[2 * j], sn = rp[2 * j + 1];
                    o1[j] = (x1 * c - x2 * sn) * QS192; o2[j] = (x1 * sn + x2 * c) * QS192;
                }
                qr[d0] = __builtin_bit_cast(bf16x8, pack8f(o1)); qr[d0 + 2] = __builtin_bit_cast(bf16x8, pack8f(o2));
            }
        }
    }
    float kg[8];
    if constexpr (KNORM) {
#pragma unroll
        for (int j = 0; j < 8; ++j) kg[j] = kgain[(tid & 15) * 8 + j];
    }
#define ATT_KNORM() do { if constexpr (KNORM) { _Pragma("unroll") for (int i_ = 0; i_ < 2; ++i_) { float x_[8]; unpack8(kst[i_], x_); float s_ = 0.f; \
        _Pragma("unroll") for (int j_ = 0; j_ < 8; ++j_) s_ += x_[j_] * x_[j_]; s_ = grp16_sum(s_); const float rs_ = rsqrtf(s_ * (1.f / 128.f) + EPS); \
        _Pragma("unroll") for (int j_ = 0; j_ < 8; ++j_) x_[j_] = x_[j_] * rs_ * kg[j_]; kst[i_] = pack8f(x_); } } } while (0)
#define ATT_WRITE(bf) do { ATT_KNORM(); _Pragma("unroll") for (int i_ = 0; i_ < NP; ++i_) if (i_ < 2 || xact) *(LAS v4u*)(kbuf + (bf) * KBUF + koff[i_]) = kst[i_]; \
        _Pragma("unroll") for (int i_ = 0; i_ < 2; ++i_) *(LAS v4u*)(vbuf + (bf) * VBUF + voff[i_]) = vst[i_]; } while (0)
    float m_run = -1e30f, l_run = 0.f; f32x16 o[4] = {};
    ATT_WRITE(t_lo & 1); __syncthreads();
    for (int t = t_lo; t < NT; ++t) {
        const int cur = t & 1, kb = t * 64;
        if (t + 1 < NT) ATT_LOAD(t + 1);
        const bool act = !CAUSAL || (kb <= qlo + 31);
        if (act) {
            f32x16 p0 = {}, p1 = {};
            const LAS unsigned char* ka = kbuf + cur * KBUF + r32 * KSTR + hi * 16;
#pragma unroll
            for (int d0 = 0; d0 < NKS; ++d0) {
                const bf16x8 b0 = *(const LAS bf16x8*)(ka + d0 * 32);
                const bf16x8 b1 = *(const LAS bf16x8*)(ka + 32 * KSTR + d0 * 32);
                p0 = __builtin_amdgcn_mfma_f32_32x32x16_bf16(b0, qr[d0], p0, 0, 0, 0);
                p1 = __builtin_amdgcn_mfma_f32_32x32x16_bf16(b1, qr[d0], p1, 0, 0, 0);
            }
            if (CAUSAL && kb + 63 > qlo) {
                const float NEG = -__builtin_inff();
#pragma unroll
                for (int i = 0; i < 16; ++i) {
                    const int key = kb + (i & 3) + 8 * (i >> 2) + 4 * hi;
                    if (key > qpos) p0[i] = NEG;
                    if (key + 32 > qpos) p1[i] = NEG;
                }
            }
            float pmax = p0[0];
#pragma unroll
            for (int i = 1; i < 16; ++i) pmax = fmaxf(pmax, p0[i]);
#pragma unroll
            for (int i = 0; i < 16; ++i) pmax = fmaxf(pmax, p1[i]);
            pmax = max32(pmax);
            const float mn = pmax > m_run + 8.f ? pmax : m_run, alpha = __builtin_amdgcn_exp2f(m_run - mn);
            m_run = mn;
            float ps = 0.f;
#pragma unroll
            for (int i = 0; i < 16; ++i) { p0[i] = __builtin_amdgcn_exp2f(p0[i] - mn); ps += p0[i]; }
#pragma unroll
            for (int i = 0; i < 16; ++i) { p1[i] = __builtin_amdgcn_exp2f(p1[i] - mn); ps += p1[i]; }
            ps = sum32(ps);
            l_run = l_run * alpha + ps;
            if (!__all(alpha == 1.f)) {
#pragma unroll
                for (int d = 0; d < 4; ++d)
#pragma unroll
                    for (int i = 0; i < 16; ++i) o[d][i] *= alpha;
            }
            bf16x8 pa0, pa1, pa2, pa3;
#define PK4(P, B_, OUT) do { unsigned a0 = cvtpk(P[B_ + 0], P[B_ + 1]), a1 = cvtpk(P[B_ + 2], P[B_ + 3]); \
        unsigned b0_ = cvtpk(P[B_ + 4], P[B_ + 5]), b1_ = cvtpk(P[B_ + 6], P[B_ + 7]); \
        auto r0 = __builtin_amdgcn_permlane32_swap(a0, b0_, false, false); auto r1 = __builtin_amdgcn_permlane32_swap(a1, b1_, false, false); \
        v4u w = {r0[0], r1[0], r0[1], r1[1]}; OUT = __builtin_bit_cast(bf16x8, w); } while (0)
            PK4(p0, 0, pa0); PK4(p0, 8, pa1); PK4(p1, 0, pa2); PK4(p1, 8, pa3);
#undef PK4
            const unsigned vb0 = (unsigned)(uintptr_t)(vbuf + cur * VBUF) + (unsigned)v_rd_base(lane);
#define TRRD(dst, off) asm volatile("ds_read_b64_tr_b16 %0, %1 offset:%2" : "=&v"(dst) : "v"(vb0), "i"(off) : "memory")
#define PV_D0(d0) do { s16x4 l0, l1, l2, l3, h0, h1, h2, h3; constexpr int b_ = (d0) * 512; \
        TRRD(l0, b_); TRRD(h0, b_ + 2048); TRRD(l1, b_ + 4096); TRRD(h1, b_ + 6144); TRRD(l2, b_ + 8192); TRRD(h2, b_ + 10240); TRRD(l3, b_ + 12288); TRRD(h3, b_ + 14336); \
        asm volatile("s_waitcnt lgkmcnt(0)" ::: "memory"); SBAR(); \
        o[d0] = __builtin_amdgcn_mfma_f32_32x32x16_bf16((bf16x8){l0[0], l0[1], l0[2], l0[3], h0[0], h0[1], h0[2], h0[3]}, pa0, o[d0], 0, 0, 0); \
        o[d0] = __builtin_amdgcn_mfma_f32_32x32x16_bf16((bf16x8){l1[0], l1[1], l1[2], l1[3], h1[0], h1[1], h1[2], h1[3]}, pa1, o[d0], 0, 0, 0); \
        o[d0] = __builtin_amdgcn_mfma_f32_32x32x16_bf16((bf16x8){l2[0], l2[1], l2[2], l2[3], h2[0], h2[1], h2[2], h2[3]}, pa2, o[d0], 0, 0, 0); \
        o[d0] = __builtin_amdgcn_mfma_f32_32x32x16_bf16((bf16x8){l3[0], l3[1], l3[2], l3[3], h3[0], h3[1], h3[2], h3[3]}, pa3, o[d0], 0, 0, 0); } while (0)
            PV_D0(0); PV_D0(1); PV_D0(2); PV_D0(3);
#undef PV_D0
#undef TRRD
        }
        if (t + 1 < NT) ATT_WRITE(cur ^ 1);
        __syncthreads();
    }
#undef ATT_LOAD
#undef ATT_WRITE
#undef ATT_KNORM
    const float inv = 1.f / l_run;
    if constexpr (OUT8) {
        constexpr int OSTR = 128 + 16;
        LAS unsigned char* ost = lds + wid * (32 * OSTR);
#pragma unroll
        for (int d0 = 0; d0 < 4; ++d0)
#pragma unroll
            for (int g = 0; g < 4; ++g) {
                const float sc8 = inv * XO8_SCALE; unsigned a8 = 0;
                a8 = __builtin_amdgcn_cvt_pk_fp8_f32(fp8clamp(o[d0][4 * g] * sc8), fp8clamp(o[d0][4 * g + 1] * sc8), a8, false);
                a8 = __builtin_amdgcn_cvt_pk_fp8_f32(fp8clamp(o[d0][4 * g + 2] * sc8), fp8clamp(o[d0][4 * g + 3] * sc8), a8, true);
                *(LAS unsigned*)(ost + r32 * OSTR + 32 * d0 + 8 * g + 4 * hi) = a8;
            }
        unsigned char* obase8 = (unsigned char*)S.o + ((size_t)b * S.qrows + qlo) * S.po + h * S.ho;
#pragma unroll
        for (int j = 0; j < 4; ++j) { const int row = (lane >> 3) + 8 * j, ch = lane & 7;
            *(v4u*)(obase8 + (size_t)row * S.po + ch * 16) = *(const LAS v4u*)(ost + row * OSTR + ch * 16); }
    } else {
        constexpr int OSTR = 256 + 16;
        LAS unsigned char* ost = lds + wid * (32 * OSTR);
#pragma unroll
        for (int d0 = 0; d0 < 4; ++d0)
#pragma unroll
            for (int g = 0; g < 4; ++g) {
                typedef unsigned v2u_t __attribute__((ext_vector_type(2)));
                v2u_t w; w.x = cvtpk(o[d0][4 * g] * inv, o[d0][4 * g + 1] * inv); w.y = cvtpk(o[d0][4 * g + 2] * inv, o[d0][4 * g + 3] * inv);
                *(LAS v2u_t*)(ost + r32 * OSTR + (32 * d0 + 8 * g + 4 * hi) * 2) = w;
            }
        bf16* obase = S.o + ((size_t)b * S.qrows + qlo) * S.po + h * S.ho;
#pragma unroll
        for (int j = 0; j < 8; ++j) { const int row = (lane >> 4) + 4 * j, ch = lane & 15;
            *(v4u*)(obase + (size_t)row * S.po + ch * 8) = *(const LAS v4u*)(ost + row * OSTR + ch * 16); }
    }
    __syncthreads();
}

constexpr int LDS_BYTES = 147456;
constexpr int MISC_OFF = 131072 + 320;
constexpr int NPH_L = 11, NPHASE = 1 + 2 * NPH_L;

__device__ __forceinline__ AttnSpec spec_fox(unsigned char* ws) {
    bf16* PROJ = (bf16*)(ws + WS_PROJ); AttnSpec S;
    S.q0 = PROJ + PC_FQ; S.pq0 = NPROJ; S.hq0 = 128; S.q1 = (const bf16*)(ws + WS_FQA); S.pq1 = 0; S.hq1 = 0;
    S.k0 = PROJ + PC_FK; S.pk0 = NPROJ; S.hk0 = 128; S.k1 = (const bf16*)(ws + WS_FKA); S.pk1 = 64; S.hk1 = 16;
    S.v = PROJ + PC_FV; S.pv = NPROJ; S.hv = 128; S.o = (bf16*)(ws + WS_OMIX); S.po = DM; S.ho = 128; S.qrows = SEQ; S.kvrows = SEQ; return S;
}
__device__ __forceinline__ AttnSpec spec_moba(unsigned char* ws) {
    bf16* PROJ = (bf16*)(ws + WS_PROJ); AttnSpec S;
    S.q0 = PROJ + PC_BQ; S.pq0 = NPROJ; S.hq0 = 128; S.q1 = (const bf16*)(ws + WS_BQA); S.pq1 = 64; S.hq1 = 16;
    S.k0 = PROJ + PC_BK; S.pk0 = NPROJ; S.hk0 = 128; S.k1 = (const bf16*)(ws + WS_BKA); S.pk1 = 16; S.hk1 = 0;
    S.v = PROJ + PC_BV; S.pv = NPROJ; S.hv = 128; S.o = (bf16*)(ws + WS_OMIX) + 1536; S.po = DM; S.ho = 128; S.qrows = SEQ; S.kvrows = SEQ; return S;
}
__device__ __forceinline__ AttnSpec spec_mla(unsigned char* ws) {
    AttnSpec S; bf16* QM = (bf16*)(ws + WS_QM); bf16* KVM = (bf16*)(ws + WS_KVM);
    S.q0 = QM; S.pq0 = 768; S.hq0 = 192; S.q1 = QM; S.pq1 = 0; S.hq1 = 0;
    S.k0 = KVM; S.pk0 = 1024; S.hk0 = 256; S.k1 = (const bf16*)(ws + WS_KPE); S.pk1 = 64; S.hk1 = 0;
    S.v = KVM + 128; S.pv = 1024; S.hv = 256; S.o = (bf16*)(ws + WS_OMIX) + 512; S.po = DM; S.ho = 128; S.qrows = SEQ; S.kvrows = SEQ; return S;
}
__device__ __forceinline__ AttnSpec spec_cross(unsigned char* ws, int l) {
    AttnSpec S; bf16* XQ = (bf16*)(ws + WS_XQ); bf16* XKV = (bf16*)(ws + WS_XKV) + (size_t)l * MEMR * 1024;
    S.q0 = XQ; S.pq0 = 512; S.hq0 = 128; S.q1 = XQ; S.pq1 = 0; S.hq1 = 0;
    S.k0 = XKV; S.pk0 = 1024; S.hk0 = 128; S.k1 = XKV; S.pk1 = 0; S.hk1 = 0;
    S.v = XKV + 512; S.pv = 1024; S.hv = 128; S.o = (bf16*)(ws + WS_XO); S.po = 512; S.ho = 128; S.qrows = SEQ; S.kvrows = 256; return S;
}

__global__ void __launch_bounds__(NWAVES * 64, 2) mega(Params P) {
    extern __shared__ __attribute__((aligned(16))) unsigned char lds_raw[];
    const int wv0 = __builtin_amdgcn_readfirstlane((int)threadIdx.x >> 6);
    Frame F;
    F.lds = (LAS unsigned char*)lds_raw;
    F.tid = otid(wv0); F.lane = F.tid & 63; F.wave = wv0;
    F.G = gridDim.x; { const int bx = blockIdx.x; F.vcu = (F.G % 8 == 0) ? (bx % 8) * (F.G / 8) + bx / 8 : bx; }
    F.in = (KIN)__builtin_amdgcn_kernarg_segment_ptr(); F.out = P.out; F.ws = P.ws;
    volatile LAS unsigned* MISC = (volatile LAS unsigned*)(F.lds + MISC_OFF);
    for (int u = F.tid; u < (LDS_BYTES - 131072) / 4; u += NWAVES * 64) ((LAS unsigned*)(F.lds + 131072))[u] = 0u;
    __syncthreads();
    gu32* ctl = (gu32*)(P.ws + WS_CTL);
    const int lo = P.ph_lo, hi = P.ph_hi;
    XcdBarrier bar; bar.bar = (unsigned*)ctl + CW_BAR; bar.x = 0; bar.st = nullptr; bar.wv = wv0;
    if (hi - lo > 1) bar = xcd_barrier_post((unsigned*)ctl + CW_BAR, MISC + 8, wv0);
    const int grp = (int)blockIdx.x & 7, gs = F.G >> 3, gj = (int)blockIdx.x >> 3;
    GrpBarrier gb; gb.cnt = (unsigned*)ctl + CW_GB + 64 * grp; gb.tmo = (unsigned*)ctl + CW_BAR + XB_TMO; gb.target = 0u; gb.step = (unsigned)gs; gb.fast = 0; gb.wv = wv0;
    if (hi - lo > 1 && wv0 == 0 && olane() == 0) (void)__hip_atomic_fetch_or((unsigned*)ctl + CW_COLO + 64 * grp, 1u << xb_xcc_id(), RLX_AGENT);
#define IN(k) (lo <= (k) && (k) < hi)
#ifndef PH_ENABLE
#define PH_ENABLE 0xFFFFF
#endif
#define PHEN(k) ((PH_ENABLE >> (k)) & 1)
#define REFRESH() do { F.tid = otid(wv0); F.lane = F.tid & 63; F.wave = wv0; F.in = (KIN)(unsigned long long)uni_launder((const char*)(unsigned long long)__builtin_amdgcn_kernarg_segment_ptr()); } while (0)
#if defined(DIAG_X8_PASS)
#define DIAG_X8_PASS_ON 1
#else
#define DIAG_X8_PASS_ON 0
#endif
#ifndef MULTI_GEMM
#define MULTI_GEMM 1
#endif
#ifndef REP_PHASE
#define REP_PHASE -1
#endif
#define REPS(k) ((REP_PHASE) == (k) ? 2 : 1)
#ifdef PROBE_STAMP
    typedef unsigned long long su64;
    volatile LAS su64* stamp = (volatile LAS su64*)(F.lds + 131072 + 1024);
#define STAMP_AT(l_, k_, w_) do { if ((l_) * 16 + (k_) == (PROBE_STAMP) && blockIdx.x == 0 && wv0 == 0) { const su64 c_ = __builtin_readcyclecounter(), r_ = __builtin_amdgcn_s_memrealtime(); if (olane() == 0) { stamp[2 * (w_)] = c_; stamp[2 * (w_) + 1] = r_; } } } while (0)
#else
#define STAMP_AT(l_, k_, w_) do { } while (0)
#endif
#define REPBAR(k) do { if (IN(k)) xcd_barrier(bar); } while (0)
#define SEAM(k) do { if (IN(k) && IN((k) + 1)) { if ((k) == 0) { xcd_barrier(bar); const unsigned cm_ = xb_ld((unsigned*)ctl + CW_COLO + 64 * grp); gb.fast = (cm_ & (cm_ - 1u)) == 0u; } else grp_barrier(gb); } } while (0)
    unsigned char* ws = P.ws;
    bf16* XB = (bf16*)(ws + WS_XB); bf16* PROJ = (bf16*)(ws + WS_PROJ); bf16* OMIX = (bf16*)(ws + WS_OMIX);

    _Pragma("unroll 1") for (int rep = 0; rep < REPS(16); ++rep) { if (rep) REPBAR(0); if (PHEN(16) && IN(0)) { STAMP_AT(6, 4, 0); REFRESH(); p0_prologue(F); STAMP_AT(6, 4, 1); } }
    SEAM(0); STAMP_AT(6, 4, 2);
    for (int l = 0; l < 2; ++l) {
        const int pb = 1 + NPH_L * l;
#define PHASE_BEGIN(k) _Pragma("unroll 1") for (int rep = 0; rep < REPS(k); ++rep) { if (rep) REPBAR(pb + (k)); if (PHEN(k) && IN(pb + (k))) { STAMP_AT(l, k, 0);
#define PHASE_END(k) STAMP_AT(l, k, 1); } } SEAM(pb + (k)); STAMP_AT(l, k, 2);
        PHASE_BEGIN(0)
            pg8::Gemm g{XB, wptr(ws, l, WO_IN), M, NPROJ, DM}; pg8::StaticOrder S; S.init(M, NPROJ, F.G, (int)blockIdx.x);
            EpiScale E{PROJ, NPROJ, ss_ptr(ws, 3 * l + 0), 1.f / DM, 1.f};
            pg8::gemm_phase<EpiScale, pg8::StaticOrder, true, true>(F.lds, g, S, E, wv0);
        PHASE_END(0)
        PHASE_BEGIN(1)
            REFRESH(); prep_phase(F, l);
        PHASE_END(1)
        PHASE_BEGIN(2)
#if MULTI_GEMM
            { pg8::Gemm g0{(bf16*)(ws + WS_CQN), wptr(ws, l, WO_UQ), M, 768, 512}, g1{(bf16*)(ws + WS_CKVN), wptr(ws, l, WO_UKV), M, 1024, 256};
              pg8::ListOrder2G S; S.init(8 * grp, 8, 3, 8 * grp, 8, 4, gs, gj);
              EpiScale2 E{EpiScale{(bf16*)(ws + WS_QM), 768, nullptr, 0.f, 1.f}, EpiScale{(bf16*)(ws + WS_KVM), 1024, nullptr, 0.f, 1.f}};
              pg8::gemm_phase<EpiScale2, pg8::ListOrder2G, true, true, false, true>(F.lds, g0, S, E, wv0, g1); }
#else
            { pg8::Gemm g{(bf16*)(ws + WS_CQN), wptr(ws, l, WO_UQ), M, 768, 512}; pg8::StaticOrder S; S.init(M, 768, F.G, (int)blockIdx.x);
              EpiScale E{(bf16*)(ws + WS_QM), 768, nullptr, 0.f, 1.f};
              pg8::gemm_phase<EpiScale, pg8::StaticOrder, true, true>(F.lds, g, S, E, wv0); }
            { pg8::Gemm g{(bf16*)(ws + WS_CKVN), wptr(ws, l, WO_UKV), M, 1024, 256}; pg8::StaticOrder S; S.init(M, 1024, F.G, (int)blockIdx.x);
              EpiScale E{(bf16*)(ws + WS_KVM), 1024, nullptr, 0.f, 1.f};
              pg8::gemm_phase<EpiScale, pg8::StaticOrder, true, true>(F.lds, g, S, E, wv0); }
#endif
            REFRESH(); foxbias_phase(F); REFRESH(); gating_phase(F, l, ctl + CW_Q + 64 * (32 * l + 24 + grp) + 4096 * rep, grp * 32, 32);
        PHASE_END(2)
        PHASE_BEGIN(3)
            LAS unsigned* slot = (LAS unsigned*)(F.lds + MISC_OFF + 64);
            REFRESH();
            {
                const AttnSpec SF = spec_fox(ws), SB = spec_moba(ws), SM = spec_mla(ws); const float* gq = F.in[11] + l * 192; const float* gk = F.in[12] + l * 192;
                const float* fbias = (const float*)(ws + WS_FBIAS);
                float fxB; { const float* g1 = F.in[5] + l * 128; const float* g2 = F.in[6] + l * 128; float a = fmaxf(fabsf(g1[F.lane]), fabsf(g1[F.lane + 64])), c = fmaxf(fabsf(g2[F.lane]), fabsf(g2[F.lane + 64]));
#pragma unroll
                    for (int o = 1; o < 64; o <<= 1) { a = fmaxf(a, __shfl_xor(a, o)); c = fmaxf(c, __shfl_xor(c, o)); }
                    fxB = 2.f * (128.f * QS128 * 1.01f) * a * c + 40.f; }
                gu32* ctr = ctl + CW_Q + 64 * (32 * l + grp) + 4096 * rep;
                for (;;) { const int it = queue_next(ctr, slot, wv0); if (it >= 96) break;
                    if (it < 64) { const int r = it & 7, qb = 7 - (it >> 3);
                        if (r < 4) attn_unit<12, 24, true, 2, true>(F.lds, SM, grp, r, qb, gq, gk, wv0, (const float*)(ws + WS_ROPE));
                        else attn_unit<9, 16, true, 1, false>(F.lds, SB, grp, r - 4, qb, F.in[17] + l * 128, nullptr, wv0); }
                    else { const int j = it - 64, qb = 7 - (j >> 2), b = grp, hh = j & 3;
                        int tlo = 0;
                        if (qb > 0) { const float ref = fbias[((size_t)b * SEQ + qb * 256) * 4 + hh];
                            const bool skip = F.lane < 4 * qb && (ref - fbias[((size_t)b * SEQ + F.lane * 64 + 63) * 4 + hh]) >= fxB;
                            const unsigned long long mk = __ballot(skip); tlo = mk == ~0ull ? 64 : __builtin_ctzll(~mk); tlo = __builtin_amdgcn_readfirstlane(tlo < 4 * qb ? tlo : 4 * qb); }
                        attn_unit<9, 16, true, 1, false>(F.lds, SF, b, hh, qb, F.in[5] + l * 128, nullptr, wv0, nullptr, tlo); } } }
            STAMP_AT(l, 3, 3);
            REFRESH();
            { gu32* ctr = ctl + CW_Q + 64 * (32 * l + 16 + grp) + 4096 * rep;
              for (;;) { const int it = queue_next(ctr, slot, wv0); if (it >= 64) break; gmlp_unit(ws, F.in, F.lds, l, grp * 16 + (it >> 2), it & 3, wv0); } }
        PHASE_END(3)
        PHASE_BEGIN(4)
            REFRESH(); groupnorm_phase(F, l);
        PHASE_END(4)
        PHASE_BEGIN(5)
            pg8::Gemm g{OMIX, wptr(ws, l, WO_OUT), M, DM, DM}; pg8::StaticOrder S; S.init(M, DM, F.G, (int)blockIdx.x);
            EpiResid2 E{XB, ss_ptr(ws, 3 * l + 1), XATT_FP8 ? ws + WS_X8 : nullptr, nullptr, 1.f};
            pg8::gemm_phase<EpiResid2, pg8::StaticOrder, true, true>(F.lds, g, S, E, wv0);
        PHASE_END(5)
        PHASE_BEGIN(6)
#if MULTI_GEMM
            constexpr bool XF = XATT_FP8 != 0; constexpr float XOS = XF ? 1.f / (X8_SCALE * W8_SCALE) : 1.f;
            pg8::Gemm g0{XF ? (bf16*)(ws + WS_X8) : XB, wptr(ws, l, WO_XQ), M, 512, XF ? DM / 2 : DM}, g1{(bf16*)(ws + WS_MEMB), wptr(ws, l, WO_XKV), MEMR, 1024, XF ? DM / 2 : DM};
            pg8::ListOrder2G S; S.init(8 * grp, 8, 2, grp, 1, 4, gs, gj);
            EpiScale2 E{EpiScale{(bf16*)(ws + WS_XQ), 512, ss_ptr(ws, 3 * l + 1), 1.f / DM, XOS}, EpiScale{(bf16*)(ws + WS_XKV) + (size_t)l * MEMR * 1024, 1024, (const u64*)(ws + WS_MEMSS), 1.f / DM, XOS}};
            pg8::gemm_phase<EpiScale2, pg8::ListOrder2G, true, true, XF, true>(F.lds, g0, S, E, wv0, g1);
#else
            { pg8::Gemm g{XB, wptr(ws, l, WO_XQ), M, 512, DM}; pg8::StaticOrder S; S.init(M, 512, F.G, (int)blockIdx.x);
              EpiScale E{(bf16*)(ws + WS_XQ), 512, ss_ptr(ws, 3 * l + 1), 1.f / DM, 1.f};
              pg8::gemm_phase<EpiScale, pg8::StaticOrder, true, true>(F.lds, g, S, E, wv0); }
            { pg8::Gemm g{(bf16*)(ws + WS_MEMB), wptr(ws, l, WO_XKV), MEMR, 1024, DM}; pg8::StaticOrder S; S.init(MEMR, 1024, F.G, 255 - (int)blockIdx.x);
              EpiScale E{(bf16*)(ws + WS_XKV) + (size_t)l * MEMR * 1024, 1024, (const u64*)(ws + WS_MEMSS), 1.f / DM, 1.f};
              pg8::gemm_phase<EpiScale, pg8::StaticOrder, true, true>(F.lds, g, S, E, wv0); }
#endif
        PHASE_END(6)
        PHASE_BEGIN(7)
            REFRESH(); const AttnSpec SX = spec_cross(ws, l); const float* qg = F.in[25] + l * 128; const float* kg = F.in[26] + l * 128;
            for (int it = F.vcu; it < 256; it += F.G) { attn_unit<8, 16, false, 1, true, XATT_FP8 != 0>(F.lds, SX, it >> 5, (it >> 3) & 3, it & 7, qg, kg, wv0); }
        PHASE_END(7)
        PHASE_BEGIN(8)
            constexpr bool XF = XATT_FP8 != 0;
            pg8::Gemm g{(bf16*)(ws + WS_XO), wptr(ws, l, WO_XO), M, DM, XF ? 256 : 512}; pg8::StaticOrder S; S.init(M, DM, F.G, (int)blockIdx.x);
            EpiResid2 E{XB, ss_ptr(ws, 3 * l + 2), (FFN_FP8 & 1) ? ws + WS_X8 : nullptr, nullptr, XF ? 1.f / (XO8_SCALE * W8_SCALE) : 1.f};
            pg8::gemm_phase<EpiResid2, pg8::StaticOrder, true, true, XF>(F.lds, g, S, E, wv0);
        PHASE_END(8)
        PHASE_BEGIN(9)
            constexpr bool G8F = (FFN_FP8 & 1) != 0, G9F = (FFN_FP8 & 2) != 0;
            pg8::Gemm g{G8F ? (bf16*)(ws + WS_X8) : XB, wptr(ws, l, WO_GU), M, 2 * DFF, G8F ? DM / 2 : DM}; pg8::StaticOrder S; S.init(M, 2 * DFF, F.G, (int)blockIdx.x);
            EpiSwiGLUx<G9F> E{(void*)PROJ, ss_ptr(ws, 3 * l + 2), G8F ? 1.f / (X8_SCALE * W8_SCALE) : 1.f};
            pg8::gemm_phase<EpiSwiGLUx<G9F>, pg8::StaticOrder, true, true, G8F>(F.lds, g, S, E, wv0);
        PHASE_END(9)
        PHASE_BEGIN(10)
            constexpr bool G9F = (FFN_FP8 & 2) != 0;
            pg8::Gemm g{PROJ, wptr(ws, l, WO_D), M, DM, G9F ? DFF / 2 : DFF}; pg8::StaticOrder S; S.init(M, DM, F.G, (int)blockIdx.x);
            EpiResid2 E{XB, ss_ptr(ws, 3 * l + 3), nullptr, l == 1 ? P.out : nullptr, G9F ? 1.f / (ACT8_SCALE * W8_SCALE) : 1.f};
            pg8::gemm_phase<EpiResid2, pg8::StaticOrder, true, true, G9F>(F.lds, g, S, E, wv0);
        PHASE_END(10)
#undef PHASE_BEGIN
#undef PHASE_END
    }
#ifdef PROBE_STAMP
    if (blockIdx.x == 0 && wv0 == 0) {
        __builtin_amdgcn_s_waitcnt(0);
        const su64 c0 = stamp[0], r0 = stamp[1], c1 = stamp[2], r1 = stamp[3], r2 = stamp[5];
        su64 V;
        if (PROBE_STAMP_MODE == 0) V = (su64)((float)(c1 - c0) * 100.f / (float)(r1 - r0) * 100.f);
        else if (PROBE_STAMP_MODE == 1) V = (r1 - r0) * 10;
        else if (PROBE_STAMP_MODE == 3) V = (stamp[7] - r0) * 10;
        else V = (r2 - r0) * 10;
        const su64 t0 = __builtin_amdgcn_s_memrealtime();
        while (__builtin_amdgcn_s_memrealtime() - t0 < V) __builtin_amdgcn_s_sleep(64);
    }
#endif
#undef IN
#undef SEAM
}

#ifndef N_LAUNCH_MODE
#define N_LAUNCH_MODE 0
#endif
extern "C" void kernel_launch(void* const* d_in, const int* in_sizes, int n_in, void* d_out, int out_size, void* d_ws, size_t ws_size, hipStream_t stream) {
    static int grid = 0;
    if (grid == 0) {
        if (n_in != 31 || out_size != M * DM || ws_size < WS_END) { fprintf(stderr, "kernel_launch: unexpected shapes (n_in %d out %d ws %zu)\n", n_in, out_size, ws_size); grid = -1; return; }
        int dev = 0, cus = 0, per_cu = 0;
        if (hipGetDevice(&dev) != hipSuccess || hipDeviceGetAttribute(&cus, hipDeviceAttributeMultiprocessorCount, dev) != hipSuccess) { grid = -1; return; }
        if (hipFuncSetAttribute((const void*)mega, hipFuncAttributeMaxDynamicSharedMemorySize, LDS_BYTES) != hipSuccess) { fprintf(stderr, "kernel_launch: hipFuncSetAttribute failed\n"); grid = -1; return; }
        if (hipOccupancyMaxActiveBlocksPerMultiprocessor(&per_cu, (const void*)mega, NWAVES * 64, LDS_BYTES) != hipSuccess || per_cu < 1) fprintf(stderr, "kernel_launch: occupancy query says %d\n", per_cu);
        (void)hipGetLastError();
        grid = cus - cus % 8;
        if (grid < 8) { grid = -1; return; }
    }
    if (grid < 0) return;
    (void)hipMemsetAsync((char*)d_ws + WS_ACC, 0, 2 * MiB, stream);
    Params p{};
    for (int i = 0; i < 31; ++i) p.in[i] = (const float*)d_in[i];
    p.out = (float*)d_out; p.ws = (unsigned char*)d_ws;
#if N_LAUNCH_MODE == 1
    p.ph_lo = 0; p.ph_hi = NPHASE;
    hipLaunchKernelGGL(mega, dim3(grid), dim3(NWAVES * 64), LDS_BYTES, stream, p);
#else
    for (int ph = 0; ph < NPHASE; ++ph) {
        p.ph_lo = ph; p.ph_hi = ph + 1;
        hipLaunchKernelGGL(mega, dim3(grid), dim3(NWAVES * 64), LDS_BYTES, stream, p);
    }
#endif
}
```

```cpp
#include <hip/hip_runtime.h>
#include <cstdio>
#include <cstdint>
__device__ __forceinline__ int olane() { int l; asm volatile("v_mbcnt_lo_u32_b32 %0, -1, 0\n\tv_mbcnt_hi_u32_b32 %0, -1, %0" : "=v"(l)); return l; }
__device__ __forceinline__ int otid(int wv) { return (wv << 6) | olane(); }
template <class T> __device__ __forceinline__ T* uni_launder(T* p) {
    const unsigned z = (unsigned)olane() >> 7; const unsigned long long v = (unsigned long long)p;
    const unsigned lo = (unsigned)__builtin_amdgcn_readfirstlane((int)((unsigned)v + z)), hi = (unsigned)__builtin_amdgcn_readfirstlane((int)(unsigned)(v >> 32));
    return (T*)(((unsigned long long)hi << 32) | lo);
}
__device__ __forceinline__ const char* uni64(const char* p) { const unsigned long long v = (unsigned long long)p; const unsigned lo = (unsigned)__builtin_amdgcn_readfirstlane((int)(unsigned)v), hi = (unsigned)__builtin_amdgcn_readfirstlane((int)(unsigned)(v >> 32)); return (const char*)(((unsigned long long)hi << 32) | lo); }
__device__ __forceinline__ float shx(float v, int mask, int lane) { return __uint_as_float((unsigned)__builtin_amdgcn_ds_bpermute((lane ^ mask) << 2, (int)__float_as_uint(v))); }
__device__ __forceinline__ float shup(float v, int d, int lane) { return __uint_as_float((unsigned)__builtin_amdgcn_ds_bpermute((lane >= d ? lane - d : lane) << 2, (int)__float_as_uint(v))); }
#define N_LAUNCH_MODE 1
namespace pg8 {
#define PG8_LAS __attribute__((address_space(3)))
typedef unsigned short bf16_t;
typedef short bf16x8 __attribute__((ext_vector_type(8)));
typedef float f32x4 __attribute__((ext_vector_type(4)));
typedef unsigned u32x4 __attribute__((ext_vector_type(4)));
constexpr int BM = 256, BK = 64, HALF = 128, HTB = HALF * BK * 2  , STAGE_BYTES = 8 * HTB, NXCD = 8, WGM = 4;

__host__ __device__ __forceinline__ int lds_byte(int r, int c) { const int st = (r >> 4) * 2 + (c >> 5), rr = r & 15, cc = c & 31, ob = rr * 64 + cc * 2; return st * 1024 + (ob ^ (((ob >> 9) & 1) << 5)); }
__host__ __device__ __forceinline__ void stage_rc(int b, int& R, int& C) { const int st = b / 1024, sb = b % 1024, swz = sb ^ (((sb >> 9) & 1) << 5); R = (st >> 1) * 16 + swz / 64; C = (st & 1) * 32 + (swz % 64) / 2; }
__host__ __device__ __forceinline__ int perm32(int rho) { const int n = rho >> 4, i = rho & 15; return 8 * (i >> 2) + 4 * n + (i & 3); }

struct Unit { int pm, pn; };
struct Gemm { const bf16_t* A; const bf16_t* Bt; int M, N, K; };

struct StaticOrder {
    int nM, nN, nwg, G, c;
    __host__ __device__ void init(int M, int N, int G_, int c_) { nM = M / BM; nN = N / BM; nwg = nM * nN; G = G_; c = c_; }
    __host__ __device__ bool next(int i, Unit& u) const {
        const long L = (long)i * G + c; if (L >= nwg) return false;
        int wgid = (int)L; { const int q = nwg / NXCD, r = nwg % NXCD, xcd = wgid % NXCD, off = wgid / NXCD; wgid = (xcd < r ? xcd * (q + 1) : r * (q + 1) + (xcd - r) * q) + off; }
        const int nig = WGM * nN, gid = wgid / nig, fm = gid * WGM, gsz = (nM - fm) < WGM ? (nM - fm) : WGM;
        u.pm = fm + ((wgid % nig) % gsz); u.pn = (wgid % nig) / gsz; return true;
    }
    __device__ __forceinline__ void a_ready(const Unit&) const {}
    __device__ __forceinline__ void done(const Unit&) const {}
};

struct ListOrder2 {
    int nM0, n0, nM1, n1, G, c;
    __host__ __device__ void init(int M0, int N0, int M1, int N1, int G_, int c_) { nM0 = M0 / BM; n0 = nM0 * (N0 / BM); nM1 = M1 / BM; n1 = nM1 * (N1 / BM); G = G_; c = c_; }
    __host__ __device__ bool next(int i, Unit& u) const {
        int L = i * G + c; if (L >= n0 + n1) return false;
        if (L < n0) { u.pm = L % nM0; u.pn = L / nM0; } else { L -= n0; u.pm = L % nM1; u.pn = (L / nM1) | 0x10000; }
        return true;
    }
    __device__ __forceinline__ void a_ready(const Unit&) const {}
    __device__ __forceinline__ void done(const Unit&) const {}
};
struct ListOrder2G {
    int pb0, np0, n0, pb1, np1, n1, gs, j;
    __host__ __device__ void init(int pb0_, int np0_, int nN0, int pb1_, int np1_, int nN1, int gs_, int j_) { pb0 = pb0_; np0 = np0_; n0 = np0_ * nN0; pb1 = pb1_; np1 = np1_; n1 = np1_ * nN1; gs = gs_; j = j_; }
    __host__ __device__ bool next(int i, Unit& u) const {
        int L = i * gs + j; if (L >= n0 + n1) return false;
        if (L < n0) { u.pm = pb0 + L % np0; u.pn = L / np0; } else { L -= n0; u.pm = pb1 + L % np1; u.pn = (L / np1) | 0x10000; }
        return true;
    }
    __device__ __forceinline__ void a_ready(const Unit&) const {}
    __device__ __forceinline__ void done(const Unit&) const {}
};
__device__ __forceinline__ unsigned cvt_pk_bf16(float lo, float hi) { unsigned r; asm volatile("v_cvt_pk_bf16_f32 %0, %1, %2" : "=v"(r) : "v"(lo), "v"(hi)); return r; }
typedef float f32x2 __attribute__((ext_vector_type(2)));
#ifndef FP8_DIAG_NONSCALED
#define FP8_DIAG_NONSCALED 0
#endif
typedef int v4i_t __attribute__((ext_vector_type(4)));
typedef int v8i_t __attribute__((ext_vector_type(8)));
__device__ __forceinline__ v8i_t cat8(bf16x8 a, bf16x8 b) { return __builtin_shufflevector(__builtin_bit_cast(v4i_t, a), __builtin_bit_cast(v4i_t, b), 0, 1, 2, 3, 4, 5, 6, 7); }
template <class Epi, class Sched, bool ALIGN_EPI = false, bool SP2 = false, bool FP8 = false, bool MULTI = false>
__device__ __forceinline__ void gemm_phase(PG8_LAS unsigned char* lds, const Gemm g, const Sched& S, const Epi& E, const int wv, const Gemm g1 = Gemm{nullptr, nullptr, 0, 0, 0}) {
    const int tid = otid(wv), wid = wv, lane = tid & 63, wr = wid >> 2, wc = wid & 3, fr = lane & 15, fq = lane >> 4;
    unsigned voffA[2], voffB[2], vRA[2], vRB[2], vC[2];
#pragma unroll
    for (int i = 0; i < 2; ++i) { int R, C; stage_rc(tid * 16 + i * 8192, R, C); const int Rb = Epi::PERM ? ((R & ~31) + perm32(R & 31)) : R;
        vRA[i] = (unsigned)R * 2u; vRB[i] = (unsigned)Rb * 2u; vC[i] = (unsigned)C * 2u; }
    const size_t kstep = (size_t)(BK * 2);
#define PG8_VA(i) (MULTI ? vRA[i] * (unsigned)K + vC[i] : voffA[i])
#define PG8_VB(i) (MULTI ? vRB[i] * (unsigned)K + vC[i] : voffB[i])
#define PG8_VA2(i) (MULTI ? vRA[i] * (unsigned)K2 + vC[i] : voffA[i])
#define PG8_VB2(i) (MULTI ? vRB[i] * (unsigned)K2 + vC[i] : voffB[i])
#define PG8_GK(u) ((MULTI && ((u).pn >> 16)) ? g1.K : g.K)
#define PG8_GA(u) ((MULTI && ((u).pn >> 16)) ? (const char*)g1.A : (const char*)g.A)
#define PG8_GB(u) ((MULTI && ((u).pn >> 16)) ? (const char*)g1.Bt : (const char*)g.Bt)
    const unsigned ldsw = (unsigned)wid * 1024u; const unsigned ldsbase = (unsigned)__builtin_amdgcn_readfirstlane((int)((unsigned)(uintptr_t)lds + ldsw));
    const int aoff = lds_byte(wr * 64 + fr, fq * 8), boff = lds_byte(wc * 32 + fr, fq * 8);
#define PG8_SA(b, h) (((b) * 2 + (h)) * HTB)
#define PG8_SB(b, h) ((4 + (b) * 2 + (h)) * HTB)
#define PG8_STAGE(bufoff, gbase, voff) do { _Pragma("unroll") for (int _i = 0; _i < 2; ++_i) { unsigned keep_; \
        asm volatile("s_mov_b32 %0, m0\n\ts_add_u32 m0, %3, %4\n\ts_nop 2\n\tglobal_load_lds_dwordx4 %1, %2\n\ts_mov_b32 m0, %0"     \
            : "=&s"(keep_) : "v"(voff(_i)), "s"(uni64((const char*)(gbase))), "s"(ldsbase), "i"((bufoff) + _i * 8192) : "memory", "scc"); } } while (0)
#define PG8_LDA(dst, b, h) do { _Pragma("unroll") for (int m = 0; m < 4; ++m) { if constexpr (FP8) dst##8[m] = cat8(*(const PG8_LAS bf16x8*)(lds + PG8_SA(b, h) + aoff + m * 2048), *(const PG8_LAS bf16x8*)(lds + PG8_SA(b, h) + aoff + m * 2048 + 1024)); \
        else { _Pragma("unroll") for (int k = 0; k < 2; ++k) dst[m][k] = *(const PG8_LAS bf16x8*)(lds + PG8_SA(b, h) + aoff + m * 2048 + k * 1024); } } } while (0)
#define PG8_LDB(dst, b, h) do { _Pragma("unroll") for (int n = 0; n < 2; ++n) { if constexpr (FP8) dst##8[n] = cat8(*(const PG8_LAS bf16x8*)(lds + PG8_SB(b, h) + boff + n * 2048), *(const PG8_LAS bf16x8*)(lds + PG8_SB(b, h) + boff + n * 2048 + 1024)); \
        else { _Pragma("unroll") for (int k = 0; k < 2; ++k) dst[n][k] = *(const PG8_LAS bf16x8*)(lds + PG8_SB(b, h) + boff + n * 2048 + k * 1024); } } } while (0)
#define PG8_MMA(ai, bj, At, Bt) do { __builtin_amdgcn_s_setprio(1); _Pragma("unroll") for (int m = 0; m < 4; ++m) _Pragma("unroll") for (int n = 0; n < 2; ++n) { \
        if constexpr (FP8) { if constexpr (FP8_DIAG_NONSCALED) { _Pragma("unroll") for (int q_ = 0; q_ < 4; ++q_) { \
            const long bq_ = ((long)(unsigned)Bt##8[n][2 * q_ + 1] << 32) | (unsigned)Bt##8[n][2 * q_], aq_ = ((long)(unsigned)At##8[m][2 * q_ + 1] << 32) | (unsigned)At##8[m][2 * q_]; \
            acc[ai][bj][m][n] = __builtin_amdgcn_mfma_f32_16x16x32_fp8_fp8(bq_, aq_, acc[ai][bj][m][n], 0, 0, 0); } } \
          else asm volatile("v_mfma_scale_f32_16x16x128_f8f6f4 %0, %1, %2, %0, %3, %3 op_sel_hi:[0,0,0]" : "+v"(acc[ai][bj][m][n]) : "v"(Bt##8[n]), "v"(At##8[m]), "v"(scl1)); }   \
        else { _Pragma("unroll") for (int k = 0; k < 2; ++k) acc[ai][bj][m][n] = __builtin_amdgcn_mfma_f32_16x16x32_bf16(Bt[n][k], At[m][k], acc[ai][bj][m][n], 0, 0, 0); } } __builtin_amdgcn_s_setprio(0); } while (0)
#define PG8_WAIT_V(n) asm volatile("s_waitcnt vmcnt(" #n ")" ::: "memory")
#define PG8_WAIT_L(n) asm volatile("s_waitcnt lgkmcnt(" #n ")" ::: "memory")
#define PG8_BAR __builtin_amdgcn_s_barrier()
#define PG8_SCHED __builtin_amdgcn_sched_barrier(0)
    Unit cur, nxt; int ui = 0;
    if (!S.next(0, cur)) return;
    int K = PG8_GK(cur), nt = K / BK;
    size_t hstep = (size_t)HALF * K * 2;
#pragma unroll
    for (int i = 0; i < 2; ++i) { voffA[i] = vRA[i] * (unsigned)K + vC[i]; voffB[i] = vRB[i] * (unsigned)K + vC[i]; }
    f32x4 acc[2][2][4][2];
#pragma unroll
    for (int a = 0; a < 2; ++a)
#pragma unroll
        for (int b = 0; b < 2; ++b)
#pragma unroll
            for (int m = 0; m < 4; ++m)
#pragma unroll
                for (int n = 0; n < 2; ++n) acc[a][b][m][n] = (f32x4){0.f, 0.f, 0.f, 0.f};
    bf16x8 At[4][2], B0[2][2], B1[2][2]; v8i_t At8[4], B08[2], B18[2]; int scl1 = 0x7F7F7F7F; asm volatile("" : "+v"(scl1));
    const char* cA = PG8_GA(cur) + (size_t)cur.pm * 2 * hstep; const char* cB = PG8_GB(cur) + (size_t)(cur.pn & 0xffff) * 2 * hstep;
    S.a_ready(cur);
    if constexpr (SP2) {
        PG8_STAGE(PG8_SB(0, 0), cB, PG8_VB); PG8_STAGE(PG8_SB(0, 1), cB + hstep, PG8_VB); PG8_STAGE(PG8_SA(0, 0), cA, PG8_VA); PG8_STAGE(PG8_SA(0, 1), cA + hstep, PG8_VA);
        if (wr == 1) PG8_BAR;
        PG8_WAIT_V(2); PG8_BAR;
        PG8_STAGE(PG8_SB(1, 0), cB + kstep, PG8_VB); PG8_STAGE(PG8_SA(1, 0), cA + kstep, PG8_VA); PG8_STAGE(PG8_SB(1, 1), cB + hstep + kstep, PG8_VB);
        PG8_WAIT_V(6); PG8_BAR;
    } else {
        PG8_STAGE(PG8_SB(0, 0), cB, PG8_VB); PG8_STAGE(PG8_SA(0, 0), cA, PG8_VA); PG8_STAGE(PG8_SB(0, 1), cB + hstep, PG8_VB); PG8_STAGE(PG8_SA(0, 1), cA + hstep, PG8_VA);
        if (wr == 1) PG8_BAR;
        PG8_WAIT_V(4); PG8_BAR;
        PG8_STAGE(PG8_SB(1, 0), cB + kstep, PG8_VB); PG8_STAGE(PG8_SA(1, 0), cA + kstep, PG8_VA); PG8_STAGE(PG8_SB(1, 1), cB + hstep + kstep, PG8_VB);
        PG8_WAIT_V(6); PG8_BAR;
    }
    for (;;) {
        const bool has_next = S.next(ui + 1, nxt);
        int Kn = K; size_t hstepn = hstep;
        if constexpr (MULTI) { if (has_next) { Kn = PG8_GK(nxt); hstepn = (size_t)HALF * Kn * 2; } }
        const char* nA = has_next ? PG8_GA(nxt) + (size_t)nxt.pm * 2 * hstepn : cA; const char* nB = has_next ? PG8_GB(nxt) + (size_t)(nxt.pn & 0xffff) * 2 * hstepn : cB;
#pragma unroll 1
        for (int t = 0; t < nt; t += 2) {
            const bool last = (t == nt - 2);
            const char* a1 = cA + (size_t)(t + 1) * kstep;
            const char* a2 = last ? nA : cA + (size_t)(t + 2) * kstep; const char* b2 = last ? nB : cB + (size_t)(t + 2) * kstep;
            const char* a3 = a2 + kstep; const char* b3 = b2 + kstep;
            const int K2 = (MULTI && last) ? Kn : K; const size_t hs2 = (MULTI && last) ? hstepn : hstep;
            if (last && has_next) S.a_ready(nxt);
            if constexpr (SP2) {
            PG8_LDB(B0, 0, 0); PG8_LDB(B1, 0, 1); PG8_SCHED; PG8_LDA(At, 0, 0); PG8_STAGE(PG8_SA(1, 1), a1 + hstep, PG8_VA);
            PG8_WAIT_V(8); PG8_WAIT_L(0); PG8_BAR; PG8_MMA(0, 0, At, B0); PG8_MMA(0, 1, At, B1); PG8_BAR; PG8_SCHED;
            PG8_LDA(At, 0, 1); PG8_STAGE(PG8_SB(0, 0), b2, PG8_VB2); PG8_STAGE(PG8_SB(0, 1), b2 + hs2, PG8_VB2); PG8_STAGE(PG8_SA(0, 0), a2, PG8_VA2);
            PG8_WAIT_V(8); PG8_WAIT_L(0); PG8_BAR; PG8_MMA(1, 0, At, B0); PG8_MMA(1, 1, At, B1); PG8_BAR; PG8_SCHED;
            PG8_LDB(B0, 1, 0); PG8_LDB(B1, 1, 1); PG8_SCHED; PG8_LDA(At, 1, 0); PG8_STAGE(PG8_SA(0, 1), a2 + hs2, PG8_VA2);
            PG8_WAIT_V(8); PG8_WAIT_L(0); PG8_BAR; PG8_MMA(0, 0, At, B0); PG8_MMA(0, 1, At, B1); PG8_BAR; PG8_SCHED;
            PG8_LDA(At, 1, 1); PG8_STAGE(PG8_SB(1, 0), b3, PG8_VB2); PG8_STAGE(PG8_SB(1, 1), b3 + hs2, PG8_VB2); PG8_STAGE(PG8_SA(1, 0), a3, PG8_VA2);
            PG8_WAIT_V(8); PG8_WAIT_L(0); PG8_BAR; PG8_MMA(1, 0, At, B0); PG8_MMA(1, 1, At, B1); PG8_BAR; PG8_SCHED;
            } else {
            PG8_LDB(B0, 0, 0); PG8_SCHED; PG8_LDA(At, 0, 0); PG8_STAGE(PG8_SA(1, 1), a1 + hstep, PG8_VA);
            PG8_WAIT_L(8); PG8_BAR; PG8_WAIT_L(0); PG8_MMA(0, 0, At, B0); PG8_BAR; PG8_SCHED;
            PG8_LDB(B1, 0, 1); PG8_STAGE(PG8_SB(0, 0), b2, PG8_VB2);
            PG8_BAR; PG8_WAIT_L(0); PG8_MMA(0, 1, At, B1); PG8_BAR;
            PG8_LDA(At, 0, 1); PG8_STAGE(PG8_SA(0, 0), a2, PG8_VA2);
            PG8_BAR; PG8_WAIT_L(0); PG8_MMA(1, 0, At, B0); PG8_BAR; PG8_SCHED;
            PG8_STAGE(PG8_SB(0, 1), b2 + hs2, PG8_VB2);
            PG8_WAIT_V(6); PG8_BAR; PG8_MMA(1, 1, At, B1); PG8_BAR;
            PG8_LDB(B0, 1, 0); PG8_SCHED; PG8_LDA(At, 1, 0); PG8_STAGE(PG8_SA(0, 1), a2 + hs2, PG8_VA2);
            PG8_WAIT_L(8); PG8_BAR; PG8_WAIT_L(0); PG8_MMA(0, 0, At, B0); PG8_BAR; PG8_SCHED;
            PG8_LDB(B1, 1, 1); PG8_STAGE(PG8_SB(1, 0), b3, PG8_VB2);
            PG8_BAR; PG8_WAIT_L(0); PG8_MMA(0, 1, At, B1); PG8_BAR;
            PG8_LDA(At, 1, 1); PG8_STAGE(PG8_SA(1, 0), a3, PG8_VA2);
            PG8_BAR; PG8_WAIT_L(0); PG8_MMA(1, 0, At, B0); PG8_BAR; PG8_SCHED;
            PG8_STAGE(PG8_SB(1, 1), b3 + hs2, PG8_VB2);
            PG8_WAIT_V(6); PG8_BAR; PG8_MMA(1, 1, At, B1); PG8_BAR;
            }
        }
        if constexpr (FP8) asm volatile("s_nop 15\n\ts_nop 15" ::: "memory");
        if constexpr (ALIGN_EPI) { if (wr == 0) PG8_BAR; }
        if constexpr (!Epi::AFTER_DRAIN) { E(acc, cur, wr, wc, fr, fq); if constexpr (Epi::REP) { asm volatile("" ::: "memory"); const Epi E2_ = E.rep(); E2_(acc, cur, wr, wc, fr, fq); } S.done(cur); }
        if (!has_next) break;
#pragma unroll
        for (int a = 0; a < 2; ++a)
#pragma unroll
            for (int b = 0; b < 2; ++b)
#pragma unroll
                for (int m = 0; m < 4; ++m)
#pragma unroll
                    for (int n = 0; n < 2; ++n) acc[a][b][m][n] = (f32x4){0.f, 0.f, 0.f, 0.f};
        cur = nxt; cA = nA; cB = nB; ++ui;
        if constexpr (MULTI) { K = Kn; nt = K / BK; hstep = hstepn; }
        if constexpr (ALIGN_EPI) { if (wr == 1) PG8_BAR; }
    }
    PG8_WAIT_V(0);
    if constexpr (!ALIGN_EPI) { if (wr == 0) PG8_BAR; }
    PG8_BAR;
    if constexpr (Epi::AFTER_DRAIN) { E.fused(acc, cur, wr, wc, fr, fq, lds, wid, lane); S.done(cur); }
#undef PG8_VA
#undef PG8_VB
#undef PG8_VA2
#undef PG8_VB2
#undef PG8_GK
#undef PG8_GA
#undef PG8_GB
#undef PG8_SA
#undef PG8_SB
#undef PG8_STAGE
#undef PG8_LDA
#undef PG8_LDB
#undef PG8_MMA
#undef PG8_WAIT_V
#undef PG8_WAIT_L
#undef PG8_BAR
#undef PG8_SCHED
}
}
#define GAS __attribute__((address_space(1)))
#define LAS __attribute__((address_space(3)))
typedef unsigned short bf16;
typedef unsigned v4u __attribute__((ext_vector_type(4)));
typedef float f32x4 __attribute__((ext_vector_type(4)));
typedef short bf16x8 __attribute__((ext_vector_type(8)));
typedef GAS unsigned gu32;
typedef GAS unsigned long long gu64;
#define RLX_AGENT __ATOMIC_RELAXED, __HIP_MEMORY_SCOPE_AGENT
#define LDS_WAIT() asm volatile("s_waitcnt lgkmcnt(0)" ::: "memory")
#define VM_WAIT() asm volatile("s_waitcnt vmcnt(0)" ::: "memory")
__device__ __forceinline__ unsigned long long rt() { return __builtin_amdgcn_s_memrealtime(); }
__device__ __forceinline__ unsigned f2bf(float f) { unsigned u = __builtin_bit_cast(unsigned, f); return (u + 0x7fffu + ((u >> 16) & 1u)) >> 16; }
__device__ __forceinline__ unsigned pk2(float lo, float hi) { unsigned r; asm("v_cvt_pk_bf16_f32 %0, %1, %2" : "=v"(r) : "v"(lo), "v"(hi)); return r; }

#define XB_TMO      128
#define XB_XCNT(j)  (256  + 64 * (j))
#define XB_XSUB(j)  (1280 + 64 * (j))
#define XB_XGEN(j)  (2304 + 64 * (j))
#define XB_TOP      3328
#define XB_TOPGEN   3392
#define XCD_BAR_WORDS 3456
#define XB_SPIN_CAP (1u << 18)

__device__ __forceinline__ unsigned xb_ld(unsigned* p)              { return __hip_atomic_load(p, __ATOMIC_RELAXED, __HIP_MEMORY_SCOPE_AGENT); }
__device__ __forceinline__ unsigned xb_add(unsigned* p, unsigned v) { return __hip_atomic_fetch_add(p, v, __ATOMIC_RELAXED, __HIP_MEMORY_SCOPE_AGENT); }
__device__ __forceinline__ unsigned xb_xcc_id() { return (unsigned)__builtin_amdgcn_s_getreg((3 << 11) | 20) & 0xFu; }
#define XB_SPIN(cond, bar) do { unsigned _sp = 0; while (cond) { __builtin_amdgcn_s_sleep(1); \
    if ((++_sp & 255u) == 0u) { if (xb_ld(&(bar)[XB_TMO])) break; if (_sp > XB_SPIN_CAP) { atomicAdd(&(bar)[XB_TMO], 1u); break; } } } } while (0)

struct XcdBarrier {
    unsigned* bar; unsigned x; int wv;
    volatile LAS unsigned* st;
};

__device__ __forceinline__ XcdBarrier xcd_barrier_post(unsigned* bar, volatile LAS unsigned* st, const int wv) {
    XcdBarrier b; b.bar = bar; b.x = xb_xcc_id(); b.st = st; b.wv = wv;
    if (wv == 0 && olane() == 0) (void)xb_add(&bar[XB_XCNT(b.x)], 1u);
    return b;
}
__device__ __forceinline__ void xcd_barrier_complete(unsigned* bar, unsigned x, unsigned& nloc, unsigned& nx) {
    const unsigned G = gridDim.x * gridDim.y * gridDim.z;
    unsigned sum, cnt, mine, sp = 0u;
    for (;;) {
        sum = 0u; cnt = 0u; mine = 0u;
#pragma unroll
        for (unsigned j = 0; j < 16; ++j) { const unsigned c = xb_ld(&bar[XB_XCNT(j)]); sum += c; cnt += (c > 0u) ? 1u : 0u; mine = (j == x) ? c : mine; }
        if (sum == G) break;
        __builtin_amdgcn_s_sleep(1);
        if ((++sp & 255u) == 0u) { if (xb_ld(&bar[XB_TMO])) break; if (sp > XB_SPIN_CAP) { atomicAdd(&bar[XB_TMO], 1u); break; } }
    }
    nloc = mine > 0u ? mine : 1u; nx = cnt > 0u ? cnt : 1u;
}

__device__ __forceinline__ void xcd_barrier(const XcdBarrier& b) {
    asm volatile("s_waitcnt vmcnt(0)" ::: "memory");
    __syncthreads();
    if (b.wv == 0 && olane() == 0) {
        unsigned* bar = b.bar;
        __builtin_amdgcn_s_waitcnt(0);
        unsigned nloc = b.st[0], nx = b.st[1];
        if (nloc == 0u) { xcd_barrier_complete(bar, b.x, nloc, nx); b.st[0] = nloc; b.st[1] = nx; }
        const unsigned old = xb_add(&bar[XB_XSUB(b.x)], 1u);
        const unsigned gen = old / nloc;
        if (old + 1u == (gen + 1u) * nloc) {
            __builtin_amdgcn_fence(__ATOMIC_RELEASE, "agent");
            asm volatile("s_waitcnt vmcnt(0)" ::: "memory");
            const unsigned og = xb_add(&bar[XB_TOP], 1u);
            const unsigned tg = og / nx;
            if (og + 1u == (tg + 1u) * nx) xb_add(&bar[XB_TOPGEN], 1u);
            else XB_SPIN(xb_ld(&bar[XB_TOPGEN]) == tg, bar);
            __builtin_amdgcn_fence(__ATOMIC_ACQUIRE, "agent");
            xb_add(&bar[XB_XGEN(b.x)], 1u);
            asm volatile("s_waitcnt vmcnt(0)" ::: "memory");
        } else {
            XB_SPIN(xb_ld(&bar[XB_XGEN(b.x)]) == gen, bar);
            __builtin_amdgcn_fence(__ATOMIC_ACQUIRE, "agent");
            asm volatile("s_waitcnt vmcnt(0)" ::: "memory");
        }
    }
    __syncthreads();
}

struct GrpBarrier { unsigned* cnt; unsigned* tmo; unsigned target, step; int fast, wv; };
__device__ __forceinline__ void grp_barrier(GrpBarrier& gb) {
    asm volatile("s_waitcnt vmcnt(0)" ::: "memory");
    __syncthreads();
    gb.target += gb.step;
    if (gb.wv == 0 && olane() == 0) {
        __builtin_amdgcn_s_waitcnt(0);
        if (!gb.fast) { __builtin_amdgcn_fence(__ATOMIC_RELEASE, "agent"); asm volatile("s_waitcnt vmcnt(0)" ::: "memory"); }
        (void)xb_add(gb.cnt, 1u);
        { unsigned _sp = 0; while (xb_ld(gb.cnt) < gb.target) { __builtin_amdgcn_s_sleep(1);
            if ((++_sp & 255u) == 0u) { if (xb_ld(gb.tmo)) break; if (_sp > XB_SPIN_CAP) { atomicAdd(gb.tmo, 1u); break; } } } }
        __builtin_amdgcn_fence(__ATOMIC_ACQUIRE, "agent");
        asm volatile("s_waitcnt vmcnt(0)" ::: "memory");
    }
    __syncthreads();
}

typedef float f32x16 __attribute__((ext_vector_type(16)));
typedef short s16x4 __attribute__((ext_vector_type(4)));
typedef float f32x2v __attribute__((ext_vector_type(2)));

constexpr int M = 16384, DM = 2048, SEQ = 2048, NB = 8, NPROJ = 5120, DFF = 5632, MEMR = 2048, NIN = 4932;
constexpr float EPS = 1e-6f;
constexpr float LOG2E = 1.4426950408889634f;
constexpr float QS128 = 0.08838834764831845f * LOG2E;
constexpr float QS192 = 0.07216878364870322f * LOG2E;
constexpr int NWAVES = 8;

constexpr int PC_FQ = 0, PC_FK = 512, PC_FV = 1024, PC_MCQ = 1536, PC_MCKV = 2048, PC_MKR = 2304, PC_FF = 2368,
              PC_GU = 2560, PC_GV = 3072, PC_BQ = 3584, PC_BK = 4096, PC_BV = 4608;

constexpr size_t MiB = 1u << 20;
constexpr size_t WS_CTL = 683 * MiB + 1536 * 1024;
constexpr size_t WS_W = 1 * MiB, WL_STRIDE = 104 * MiB;
constexpr size_t WO_IN = 0, WO_OUT = 20 * MiB, WO_XQ = 28 * MiB, WO_XKV = 30 * MiB, WO_XO = 34 * MiB, WO_GU = 36 * MiB, WO_D = 80 * MiB,
                 WO_UQ = 102 * MiB, WO_UKV = 102 * MiB + 768 * 1024;
constexpr size_t WS_XB = 209 * MiB, WS_PROJ = 273 * MiB, WS_OMIX = 449 * MiB, WS_CQN = 513 * MiB, WS_CKVN = 529 * MiB, WS_QM = 537 * MiB,
                 WS_KVM = 561 * MiB, WS_XQ = 593 * MiB, WS_XO = 609 * MiB, WS_XKV = 625 * MiB, WS_MEMB = 633 * MiB, WS_FKA = 641 * MiB,
                 WS_BQA = 643 * MiB, WS_BKA = 645 * MiB, WS_KPE = 646 * MiB, WS_LF = 648 * MiB, WS_LFSUM = 648 * MiB + 512 * 1024,
                 WS_ROPE = 649 * MiB, WS_FQA = 649 * MiB + 512 * 1024, WS_MEMSS = 649 * MiB + 768 * 1024, WS_GSTAT = 648 * MiB + 768 * 1024, WS_FBIAS = 648 * MiB + 256 * 1024  , WS_TRIL = 650 * MiB, WS_X8 = 651 * MiB, WS_ACC = 683 * MiB  , WS_END = 685 * MiB; constexpr size_t WS_X8_OLD_ALIAS = 513 * MiB  ;
constexpr int CW_TMO = 0, CW_BAR = 4096  , CW_Q = 8192  , CW_GB = 16384  , CW_COLO = 16384 + 512  ;

struct Params { const float* in[31]; float* out; unsigned char* ws; int ph_lo, ph_hi; };

typedef const float* const __attribute__((address_space(4)))* KIN;
struct Frame {
    LAS unsigned char* lds;
    int tid, lane, wave, vcu, G;
    KIN in; float* out; unsigned char* ws;
};

template <int CTRL> __device__ __forceinline__ float dppf(float v) { return __builtin_bit_cast(float, __builtin_amdgcn_update_dpp(0, __builtin_bit_cast(int, v), CTRL, 0xF, 0xF, true)); }
__device__ __forceinline__ float sum32(float v) { const unsigned x = __builtin_bit_cast(unsigned, v); auto r = __builtin_amdgcn_permlane32_swap(x, x, false, false); return __builtin_bit_cast(float, (unsigned)r[0]) + __builtin_bit_cast(float, (unsigned)r[1]); }
__device__ __forceinline__ float max32(float v) { const unsigned x = __builtin_bit_cast(unsigned, v); auto r = __builtin_amdgcn_permlane32_swap(x, x, false, false); return fmaxf(__builtin_bit_cast(float, (unsigned)r[0]), __builtin_bit_cast(float, (unsigned)r[1])); }
__device__ __forceinline__ float sum16(float v) { const unsigned x = __builtin_bit_cast(unsigned, v); auto r = __builtin_amdgcn_permlane16_swap(x, x, false, false); return __builtin_bit_cast(float, (unsigned)r[0]) + __builtin_bit_cast(float, (unsigned)r[1]); }
__device__ __forceinline__ float grp8_sum(float v) { v += dppf<0xB1>(v); v += dppf<0x4E>(v); v += dppf<0x141>(v); return v; }
__device__ __forceinline__ float grp16_sum(float v) { v = grp8_sum(v); v += dppf<0x140>(v); return v; }
__device__ __forceinline__ float wave_sum(float v) { return sum32(sum16(grp16_sum(v))); }
__device__ __forceinline__ float bf2f(unsigned short b) { return __uint_as_float(((unsigned)b) << 16); }
__device__ __forceinline__ float bflo(unsigned w) { return __uint_as_float(w << 16); }
__device__ __forceinline__ float bfhi(unsigned w) { return __uint_as_float(w & 0xffff0000u); }
__device__ __forceinline__ void unpack8(const v4u raw, float (&x)[8]) { x[0] = bflo(raw.x); x[1] = bfhi(raw.x); x[2] = bflo(raw.y); x[3] = bfhi(raw.y); x[4] = bflo(raw.z); x[5] = bfhi(raw.z); x[6] = bflo(raw.w); x[7] = bfhi(raw.w); }
__device__ __forceinline__ v4u pack8f(const float (&x)[8]) { v4u o; o.x = pk2(x[0], x[1]); o.y = pk2(x[2], x[3]); o.z = pk2(x[4], x[5]); o.w = pk2(x[6], x[7]); return o; }
__device__ __forceinline__ float fp8clamp(float v) { return __builtin_amdgcn_fmed3f(v, -448.f, 448.f); }
__device__ __forceinline__ uint2 pack8_fp8(const float (&x)[8], float sc) {
    unsigned a = 0, c = 0;
    a = __builtin_amdgcn_cvt_pk_fp8_f32(fp8clamp(x[0] * sc), fp8clamp(x[1] * sc), a, false); a = __builtin_amdgcn_cvt_pk_fp8_f32(fp8clamp(x[2] * sc), fp8clamp(x[3] * sc), a, true);
    c = __builtin_amdgcn_cvt_pk_fp8_f32(fp8clamp(x[4] * sc), fp8clamp(x[5] * sc), c, false); c = __builtin_amdgcn_cvt_pk_fp8_f32(fp8clamp(x[6] * sc), fp8clamp(x[7] * sc), c, true);
    uint2 r; r.x = a; r.y = c; return r;
}
__device__ __forceinline__ float gelu_tanh(float x) {
    const float u = 0.7978845608028654f * (x + 0.044715f * x * x * x);
    const float e = __builtin_amdgcn_exp2f(u * 2.8853900817779268f);
    return x * (1.f - __builtin_amdgcn_rcpf(e + 1.f));
}
__device__ __forceinline__ float silu_f(float x) { return x * __builtin_amdgcn_rcpf(1.f + __builtin_amdgcn_exp2f(x * -1.4426950408889634f)); }
__device__ __forceinline__ float log_sigmoid_f(float x) { return fminf(x, 0.f) - log1pf(expf(-fabsf(x))); }

__device__ __forceinline__ bf16* wptr(unsigned char* ws, int l, size_t off) { return (bf16*)(ws + WS_W + (size_t)l * WL_STRIDE + off); }
typedef unsigned long long u64;
constexpr float SS_FIX = 1048576.f, SS_INV = 1.f / 1048576.f, KM_FIX = 1073741824.f, KM_INV = 1.f / 1073741824.f;
__device__ __forceinline__ u64* ss_ptr(unsigned char* ws, int k) { return (u64*)(ws + WS_ACC) + (size_t)k * M; }

__device__ __forceinline__ int queue_next(gu32* ctr, LAS unsigned* slot, const int wv) {
    __syncthreads();
    if (wv == 0 && olane() == 0) *slot = __hip_atomic_fetch_add(ctr, 1u, __ATOMIC_RELAXED, __HIP_MEMORY_SCOPE_AGENT);
    __syncthreads();
    return (int)*slot;
}

#ifndef REP_EPI_SCALE
#define REP_EPI_SCALE 0
#endif
#ifndef REP_EPI_SWIGLU
#define REP_EPI_SWIGLU 0
#endif
struct EpiScale {
    static constexpr bool PERM = true, AFTER_DRAIN = false, REP = REP_EPI_SCALE;
    __device__ __forceinline__ EpiScale rep() const { return *this; }
    bf16* O; int ldc; const u64* ss; float inv_kn; float oscale;
    __device__ __forceinline__ void operator()(const pg8::f32x4 (&acc)[2][2][4][2], const pg8::Unit& u, int wr_, int wc_, int fr_, int fq_) const {
        const int ot_ = olane(), wr = wr_, wc = wc_, fr = ot_ & 15, fq = ot_ >> 4;
        const int row0 = u.pm * 256 + wr * 64 + fr, col0 = u.pn * 256 + wc * 32 + 8 * fq;
        float scv[2][4];
#pragma unroll
        for (int ai = 0; ai < 2; ++ai)
#pragma unroll
            for (int m = 0; m < 4; ++m) scv[ai][m] = ss ? (float)ss[row0 + ai * 128 + m * 16] : 0.f;
#pragma unroll
        for (int ai = 0; ai < 2; ++ai)
#pragma unroll
            for (int m = 0; m < 4; ++m) {
                const int row = row0 + ai * 128 + m * 16;
                const float sc = ss ? rsqrtf(scv[ai][m] * (SS_INV * inv_kn) + EPS) * oscale : oscale;
                bf16* rowp = O + (size_t)row * ldc + col0;
#pragma unroll
                for (int bj = 0; bj < 2; ++bj) {
                    const pg8::f32x4 v0 = acc[ai][bj][m][0] * sc, v1 = acc[ai][bj][m][1] * sc;
                    v4u w; w.x = pg8::cvt_pk_bf16(v0[0], v0[1]); w.y = pg8::cvt_pk_bf16(v0[2], v0[3]); w.z = pg8::cvt_pk_bf16(v1[0], v1[1]); w.w = pg8::cvt_pk_bf16(v1[2], v1[3]);
                    *(v4u*)(rowp + bj * 128) = w;
                }
            }
    }
};
struct EpiScale2 {
    static constexpr bool PERM = true, AFTER_DRAIN = false, REP = false;
    EpiScale e0, e1;
    __device__ __forceinline__ void operator()(const pg8::f32x4 (&acc)[2][2][4][2], const pg8::Unit& u, int wr, int wc, int fr, int fq) const { const EpiScale e = (u.pn >> 16) ? e1 : e0; pg8::Unit v; v.pm = u.pm; v.pn = u.pn & 0xffff; e(acc, v, wr, wc, fr, fq); }
};
#ifndef XATT_FP8
#define XATT_FP8 1
#endif
#ifndef FFN_FP8
#define FFN_FP8 3
#endif
constexpr float X8_SCALE = 4.f;
#ifndef REP_EPI_RESID
#define REP_EPI_RESID 0
#endif
struct EpiResid2 {
    static constexpr bool PERM = true, AFTER_DRAIN = false, REP = REP_EPI_RESID != 0;
    bf16* xb; u64* ssn; unsigned char* x8; float* outf; float ascale;
    __device__ __forceinline__ EpiResid2 rep() const { EpiResid2 e = *this; if (!outf) { e.ascale = 0.f; e.ssn = nullptr; } return e; }
    __device__ __forceinline__ void operator()(const pg8::f32x4 (&acc)[2][2][4][2], const pg8::Unit& u, int wr_, int wc_, int fr_, int fq_) const {
        const int ot_ = olane(), wr = wr_, wc = wc_, fr = ot_ & 15, fq = ot_ >> 4;
        const int row0 = u.pm * 256 + wr * 64 + fr, col0 = u.pn * 256 + wc * 32 + 8 * fq;
        v4u xin[2][2][2];
#define RESID_LOAD(b_) do { _Pragma("unroll") for (int mm = 0; mm < 2; ++mm) _Pragma("unroll") for (int bj = 0; bj < 2; ++bj) \
            xin[(b_) & 1][mm][bj] = *(const v4u*)(xb + (size_t)(row0 + ((b_) >> 1) * 128 + (2 * ((b_) & 1) + mm) * 16) * DM + col0 + bj * 128); } while (0)
        RESID_LOAD(0);
#pragma unroll
        for (int b = 0; b < 4; ++b) {
            if (b + 1 < 4) RESID_LOAD(b + 1);
            const int ai = b >> 1;
#pragma unroll
            for (int mm = 0; mm < 2; ++mm) {
                const int m = 2 * (b & 1) + mm;
                const int row = row0 + ai * 128 + m * 16; float q = 0.f;
#pragma unroll
                for (int bj = 0; bj < 2; ++bj) {
                    const size_t idx = (size_t)row * DM + col0 + bj * 128;
                    float x[8]; unpack8(xin[b & 1][mm][bj], x);
#pragma unroll
                    for (int e = 0; e < 4; ++e) { x[e] += acc[ai][bj][m][0][e] * ascale; x[4 + e] += acc[ai][bj][m][1][e] * ascale; }
                    if (!outf) *(v4u*)(xb + idx) = pack8f(x);
                    if (outf) { __builtin_nontemporal_store((pg8::f32x4){x[0], x[1], x[2], x[3]}, (pg8::f32x4*)(outf + idx)); __builtin_nontemporal_store((pg8::f32x4){x[4], x[5], x[6], x[7]}, (pg8::f32x4*)(outf + idx + 4)); }
                    if (x8) *(uint2*)(x8 + idx) = pack8_fp8(x, X8_SCALE);
#pragma unroll
                    for (int e = 0; e < 8; ++e) q += x[e] * x[e];
                }
                q = sum32(sum16(q));
                if (fq == 0 && !outf && ssn) atomicAdd(ssn + row, (u64)(q * SS_FIX));
            }
        }
#undef RESID_LOAD
    }
};

constexpr float W8_SCALE = 256.f, ACT8_SCALE = 8.f, XO8_SCALE = 32.f;
template <bool OUT8> struct EpiSwiGLUx {
    static constexpr bool PERM = true, AFTER_DRAIN = false, REP = REP_EPI_SWIGLU;
    __device__ __forceinline__ EpiSwiGLUx rep() const { return *this; }
    void* O; const u64* ss; float insc;
    __device__ __forceinline__ void operator()(const pg8::f32x4 (&acc)[2][2][4][2], const pg8::Unit& u, int wr_, int wc_, int fr_, int fq_) const {
        typedef float f2 __attribute__((ext_vector_type(2)));
        const int ot_ = olane(), wr = wr_, wc = wc_, fr = ot_ & 15, fq = ot_ >> 4;
        const int row0 = u.pm * 256 + wr * 64 + fr, col0 = u.pn * 128 + wc * 32 + 8 * fq;
        float scv[2][4];
#pragma unroll
        for (int ai = 0; ai < 2; ++ai)
#pragma unroll
            for (int m = 0; m < 4; ++m) scv[ai][m] = (float)ss[row0 + ai * 128 + m * 16];
#pragma unroll
        for (int ai = 0; ai < 2; ++ai)
#pragma unroll
            for (int m = 0; m < 4; ++m) {
                const int row = row0 + ai * 128 + m * 16;
                const float sc = rsqrtf(scv[ai][m] * (SS_INV / DM) + EPS) * insc;
                const float nsl = sc * -1.4426950408889634f, c2 = OUT8 ? sc * sc * ACT8_SCALE : sc * sc;
                float o[8];
#pragma unroll
                for (int n = 0; n < 2; ++n)
#pragma unroll
                    for (int p = 0; p < 2; ++p) {
                        const f2 ga = {acc[ai][0][m][n][2 * p], acc[ai][0][m][n][2 * p + 1]}, ua = {acc[ai][1][m][n][2 * p], acc[ai][1][m][n][2 * p + 1]};
                        const f2 pr = ga * ua, t = ga * nsl;
                        f2 ex; ex.x = __builtin_amdgcn_exp2f(t.x); ex.y = __builtin_amdgcn_exp2f(t.y);
                        const f2 d = ex + 1.f; f2 r; r.x = __builtin_amdgcn_rcpf(d.x); r.y = __builtin_amdgcn_rcpf(d.y);
                        const f2 out = (pr * r) * c2;
                        o[n * 4 + 2 * p] = out.x; o[n * 4 + 2 * p + 1] = out.y;
                    }
                if constexpr (OUT8) *(uint2*)((unsigned char*)O + (size_t)row * DFF + col0) = pack8_fp8(o, 1.f);
                else *(v4u*)((bf16*)O + (size_t)row * DFF + col0) = pack8f(o);
            }
    }
};
struct WItem { const float* W; const float* gain; bf16* WT; int Nsrc, K, k0, srcc, valid, R0, f8; };
constexpr int ITEMS_L = 5120 + 2048 + 512 + 1024 + 512 + 11264 + 5632 + 192 + 128;
__device__ __forceinline__ WItem p0_decode(Frame& F, int git) {
    const int l = git >= ITEMS_L ? 1 : 0; int r = git - l * ITEMS_L;
    WItem d; d.gain = nullptr; d.f8 = 0; int ND, mode = 0;
    if (r < 5120) { d.W = F.in[3] + (size_t)l * DM * NIN; d.K = DM; d.Nsrc = NIN; ND = NPROJ; d.WT = wptr(F.ws, l, WO_IN); d.gain = F.in[2] + l * DM; mode = 1; }
    else if ((r -= 5120) < 2048) { d.W = F.in[20] + (size_t)l * DM * DM; d.K = DM; d.Nsrc = DM; ND = DM; d.WT = wptr(F.ws, l, WO_OUT); }
    else if ((r -= 2048) < 512) { d.W = F.in[23] + (size_t)l * DM * 512; d.K = DM; d.Nsrc = 512; ND = 512; d.WT = wptr(F.ws, l, WO_XQ); d.gain = F.in[21] + l * DM; d.f8 = XATT_FP8; }
    else if ((r -= 512) < 1024) { d.W = F.in[24] + (size_t)l * DM * 1024; d.K = DM; d.Nsrc = 1024; ND = 1024; d.WT = wptr(F.ws, l, WO_XKV); d.gain = F.in[22] + l * DM; d.f8 = XATT_FP8; }
    else if ((r -= 1024) < 512) { d.W = F.in[27] + (size_t)l * 512 * DM; d.K = 512; d.Nsrc = DM; ND = DM; d.WT = wptr(F.ws, l, WO_XO); d.f8 = XATT_FP8; }
    else if ((r -= 512) < 11264) { d.W = F.in[29] + (size_t)l * DM * 2 * DFF; d.K = DM; d.Nsrc = 2 * DFF; ND = 2 * DFF; d.WT = wptr(F.ws, l, WO_GU); d.gain = F.in[28] + l * DM; mode = 2; d.f8 = (FFN_FP8 & 1) != 0; }
    else if ((r -= 11264) < 5632) { d.W = F.in[30] + (size_t)l * DFF * DM; d.K = DFF; d.Nsrc = DM; ND = DM; d.WT = wptr(F.ws, l, WO_D); d.f8 = (FFN_FP8 & 2) != 0; }
    else if ((r -= 5632) < 192) { d.W = F.in[8] + (size_t)l * 512 * 768; d.K = 512; d.Nsrc = 768; ND = 768; d.WT = wptr(F.ws, l, WO_UQ); }
    else { r -= 192; d.W = F.in[10] + (size_t)l * 256 * 1024; d.K = 256; d.Nsrc = 1024; ND = 1024; d.WT = wptr(F.ws, l, WO_UKV); }
    const int nblk = ND / 32, kb = r / nblk, nb = r - kb * nblk, R0 = nb * 32;
    int srcc = R0, valid = 32;
    if (mode == 1) {
        if (R0 < 1536) srcc = R0; else if (R0 < 2368) srcc = R0 + 4; else if (R0 == 2368) { srcc = 1536; valid = 4; } else if (R0 < 2560) { srcc = 0; valid = 0; } else srcc = R0 - 188;
    } else if (mode == 2) { const int pn = R0 >> 8, within = R0 & 255, half = within >> 7, j = within & 127; srcc = half * DFF + 128 * pn + j; }
    d.k0 = kb * 64; d.srcc = srcc; d.valid = valid; d.R0 = R0;
    return d;
}
__device__ __forceinline__ void tr_load(const WItem& d, int lane, float (&v)[32]) {
    const int n = lane & 31, nn = n < d.valid ? n : 0, kh = lane >> 5;
    const float* src = d.W + (size_t)(d.k0 + kh) * d.Nsrc + d.srcc + nn;
#pragma unroll
    for (int i = 0; i < 32; ++i) v[i] = __builtin_nontemporal_load(src + (size_t)(2 * i) * d.Nsrc);
}
__device__ __forceinline__ void tr_store(const WItem& d, const float (&v)[32], LAS float* scr, int lane) {
    const int n = lane & 31, kh = lane >> 5;
    const bool ok = n < d.valid;
#pragma unroll
    for (int i = 0; i < 32; ++i) scr[(2 * i + kh) * 33 + n] = ok ? v[i] : 0.f;
    LDS_WAIT(); asm volatile("" ::: "memory");
    const int c = lane & 7;
    float gk[8];
#pragma unroll
    for (int j = 0; j < 8; ++j) gk[j] = d.gain ? d.gain[d.k0 + 8 * c + j] : 1.f;
#pragma unroll
    for (int j = 0; j < 4; ++j) {
        const int nr = (lane >> 3) + 8 * j; const LAS float* s = scr + (8 * c) * 33 + nr;
        float xv[8];
#pragma unroll
        for (int e = 0; e < 8; ++e) xv[e] = s[e * 33] * gk[e];
        if (d.f8) *(uint2*)((unsigned char*)d.WT + (size_t)(d.R0 + nr) * d.K + d.k0 + 8 * c) = pack8_fp8(xv, W8_SCALE);
        else *(GAS v4u*)(d.WT + (size_t)(d.R0 + nr) * d.K + d.k0 + 8 * c) = pack8f(xv);
    }
    LDS_WAIT(); asm volatile("" ::: "memory");
}
__device__ __forceinline__ void p0_weights(Frame& F, int gw, int NGW) {
    LAS float* scr = (LAS float*)(F.lds + F.wave * 16384);
    int it = gw; if (it >= 2 * ITEMS_L) return;
    WItem cur = p0_decode(F, it); float v[32]; tr_load(cur, F.lane, v);
#pragma unroll 1
    for (;;) {
        const int itn = it + NGW; const bool hn = itn < 2 * ITEMS_L;
        WItem nxt; float vn[32];
        if (hn) { nxt = p0_decode(F, itn); tr_load(nxt, F.lane, vn); }
        tr_store(cur, v, scr, F.lane);
        if (!hn) break;
        cur = nxt; it = itn;
#pragma unroll
        for (int i = 0; i < 32; ++i) v[i] = vn[i];
    }
}
__device__ __forceinline__ void p0_xrow_load(Frame& F, int m, f32x4 (&v)[8]) {
    const bool isx = m < M; const int r = isx ? m : m - M;
    const float* src = (isx ? F.in[0] : F.in[1]) + (size_t)r * DM;
#pragma unroll
    for (int j = 0; j < 8; ++j) v[j] = __builtin_nontemporal_load((const f32x4*)(src + (j * 64 + F.lane) * 4));
}
__device__ __forceinline__ void p0_prologue(Frame& F) {
    const int gw = F.vcu * NWAVES + F.wave, NGW = F.G * NWAVES;
    p0_weights(F, gw, NGW);
    if (gw < M + MEMR) {
        int m = gw; f32x4 v[8]; p0_xrow_load(F, m, v);
#pragma unroll 1
        for (;;) {
            const int mn = m + NGW; const bool hn = mn < M + MEMR;
            f32x4 vn[8];
            if (hn) p0_xrow_load(F, mn, vn);
            const bool isx = m < M; const int r = isx ? m : m - M;
            bf16* dst = (bf16*)(F.ws + (isx ? WS_XB : WS_MEMB)) + (size_t)r * DM;
            float s = 0.f;
#pragma unroll
            for (int j = 0; j < 8; ++j) {
                s += (v[j][0] * v[j][0] + v[j][1] * v[j][1]) + (v[j][2] * v[j][2] + v[j][3] * v[j][3]);
                if (XATT_FP8 && !isx) { unsigned a8 = 0; a8 = __builtin_amdgcn_cvt_pk_fp8_f32(fp8clamp(v[j][0] * X8_SCALE), fp8clamp(v[j][1] * X8_SCALE), a8, false); a8 = __builtin_amdgcn_cvt_pk_fp8_f32(fp8clamp(v[j][2] * X8_SCALE), fp8clamp(v[j][3] * X8_SCALE), a8, true);
                    *(unsigned*)(F.ws + WS_MEMB + (size_t)r * DM + (j * 64 + F.lane) * 4) = a8; }
                else { uint2 w; w.x = pk2(v[j][0], v[j][1]); w.y = pk2(v[j][2], v[j][3]);
                *(uint2*)(dst + (j * 64 + F.lane) * 4) = w; }
            }
            s = wave_sum(s);
            if (F.lane == 0) { if (isx) ss_ptr(F.ws, 0)[r] = (u64)(s * SS_FIX); else ((u64*)(F.ws + WS_MEMSS))[r] = (u64)(s * SS_FIX); }
            if (!hn) break;
            m = mn;
#pragma unroll
            for (int j = 0; j < 8; ++j) v[j] = vn[j];
        }
    }
    float* rope = (float*)(F.ws + WS_ROPE);
    const int gt = (F.vcu * NWAVES + F.wave) * 64 + F.lane, NGT = NGW * 64;
    for (int idx = gt; idx < SEQ * 32; idx += NGT) {
        const int pos = idx >> 5, i = idx & 31;
        const float inv = powf(10000.f, -(float)i * (1.f / 32.f)); const float ang = (float)pos * inv;
        rope[2 * idx] = cosf(ang); rope[2 * idx + 1] = sinf(ang);
    }
    bf16* tril = (bf16*)(F.ws + WS_TRIL);
    for (int idx = gt; idx < 2 * 4 * 128 * 128; idx += NGT) { const int s = idx & 127, t = (idx >> 7) & 127; tril[idx] = (bf16)(s <= t ? f2bf(F.in[15][idx]) : 0u); }
    if (blockIdx.x == 0 && F.tid < 16) ((bf16*)(F.ws + WS_FQA))[F.tid] = F.tid < 3 ? (bf16)0x3F80 : (bf16)0;
}

__device__ __forceinline__ v4u headnorm8(v4u raw, const float* g, int d0, float sc, float* keep) {
    float x[8]; unpack8(raw, x);
    float s = 0.f;
#pragma unroll
    for (int j = 0; j < 8; ++j) s += x[j] * x[j];
    s = grp16_sum(s);
    const float rs = rsqrtf(s * (1.f / 128.f) + EPS) * sc;
#pragma unroll
    for (int j = 0; j < 8; ++j) { x[j] = x[j] * rs * g[d0 + j]; if (keep) keep[j] = x[j]; }
    return pack8f(x);
}
struct PrepRow { v4u fk, mcq, bk, gv; uint2 mckv; unsigned short ff, mkr; };
__device__ __forceinline__ PrepRow prep_load(const bf16* pr, int lane) {
    PrepRow r;
    r.fk = *(const v4u*)(pr + PC_FK + lane * 8); r.mcq = *(const v4u*)(pr + PC_MCQ + lane * 8);
    r.bk = *(const v4u*)(pr + PC_BK + lane * 8); r.gv = *(const v4u*)(pr + PC_GV + lane * 8);
    r.mckv = *(const uint2*)(pr + PC_MCKV + lane * 4); r.ff = pr[PC_FF + (lane & 3)]; r.mkr = pr[PC_MKR + lane];
    return r;
}
__device__ __forceinline__ void prep_phase(Frame& F, int l) {
    bf16* PROJ = (bf16*)(F.ws + WS_PROJ);
    const float* g_fk = F.in[6] + l * 128; const float* b_f = F.in[4] + l * 4;
    const float* g_ql = F.in[7] + l * 512; const float* g_kvl = F.in[9] + l * 256; const float* g_mk = F.in[12] + l * 192;
    const float* g_bk = F.in[18] + l * 128;
    bf16* CQN = (bf16*)(F.ws + WS_CQN); bf16* CKVN = (bf16*)(F.ws + WS_CKVN); bf16* KPE = (bf16*)(F.ws + WS_KPE); bf16* BKA = (bf16*)(F.ws + WS_BKA);
    float* LF = (float*)(F.ws + WS_LF); float* LFSUM = (float*)(F.ws + WS_LFSUM); const float* rope = (const float*)(F.ws + WS_ROPE); float* GSTAT = (float*)(F.ws + WS_GSTAT);
    u64* KMQ = (u64*)(F.ws + WS_ACC + MiB) + (size_t)l * (8 * 4 * 8 * 128);
    LAS float* red = (LAS float*)F.lds;
    const int lane = F.lane, d0 = (lane & 15) * 8;
    for (int unit = F.vcu; unit < M / 64; unit += F.G) {
        float ksum[8]; float lfs = 0.f;
#pragma unroll
        for (int j = 0; j < 8; ++j) ksum[j] = 0.f;
        const int mbase = unit * 64 + F.wave * 8;
        PrepRow cur = prep_load(PROJ + (size_t)mbase * NPROJ, lane);
#pragma unroll 1
        for (int i = 0; i < 8; ++i) {
            const int m = mbase + i, t = m & (SEQ - 1);
            bf16* pr = PROJ + (size_t)m * NPROJ;
            PrepRow nxt = cur;
            if (i + 1 < 8) nxt = prep_load(pr + NPROJ, lane);
            const f32x2v cs = *(const f32x2v*)(rope + (t * 32 + (lane & 31)) * 2);
            *(v4u*)(pr + PC_FK + lane * 8) = headnorm8(cur.fk, g_fk, d0, 1.f, nullptr);
            if (lane < 4) { const float v = log_sigmoid_f(bf2f(cur.ff) + b_f[lane]); LF[(size_t)m * 4 + lane] = v; lfs += v; }
            { float x[8]; unpack8(cur.mcq, x); float s = 0.f;
#pragma unroll
              for (int j = 0; j < 8; ++j) s += x[j] * x[j];
              s = wave_sum(s); const float rs = rsqrtf(s * (1.f / 512.f) + EPS);
#pragma unroll
              for (int j = 0; j < 8; ++j) x[j] = x[j] * rs * g_ql[lane * 8 + j];
              *(v4u*)(CQN + (size_t)m * 512 + lane * 8) = pack8f(x); }
            { float x[4] = {bflo(cur.mckv.x), bfhi(cur.mckv.x), bflo(cur.mckv.y), bfhi(cur.mckv.y)}; float s = (x[0] * x[0] + x[1] * x[1]) + (x[2] * x[2] + x[3] * x[3]);
              s = wave_sum(s); const float rs = rsqrtf(s * (1.f / 256.f) + EPS);
#pragma unroll
              for (int j = 0; j < 4; ++j) x[j] = x[j] * rs * g_kvl[lane * 4 + j];
              uint2 o; o.x = pk2(x[0], x[1]); o.y = pk2(x[2], x[3]);
              *(uint2*)(CKVN + (size_t)m * 256 + lane * 4) = o; }
            { float x = bf2f(cur.mkr); const float s = wave_sum(x * x); x = x * rsqrtf(s * (1.f / 64.f) + EPS) * g_mk[128 + lane];
              const float other = __shfl_xor(x, 32);
              const float o = lane < 32 ? x * cs[0] - other * cs[1] : other * cs[1] + x * cs[0];
              KPE[(size_t)m * 64 + lane] = (bf16)f2bf(o); }
            { float kf[8]; *(v4u*)(pr + PC_BK + lane * 8) = headnorm8(cur.bk, g_bk, d0, 1.f, kf);
#pragma unroll
              for (int j = 0; j < 8; ++j) ksum[j] += kf[j]; }
            if (lane < 16) BKA[(size_t)m * 16 + lane] = (lane == (t >> 8)) ? (bf16)0x3F80 : (bf16)0;
            { float x[8]; unpack8(cur.gv, x); float sm = 0.f;
#pragma unroll
              for (int j = 0; j < 8; ++j) { x[j] = gelu_tanh(x[j]); sm += x[j]; }
              const float mean = wave_sum(sm) * (1.f / 512.f); float q = 0.f;
#pragma unroll
              for (int j = 0; j < 8; ++j) { const float d = x[j] - mean; q += d * d; }
              const float var = wave_sum(q) * (1.f / 512.f);
              if (lane == 0) { f32x2v st = {mean, rsqrtf(var + EPS)}; *(f32x2v*)(GSTAT + (size_t)m * 2) = st; } }
            cur = nxt;
        }
#pragma unroll
        for (int j = 0; j < 8; ++j) red[F.wave * 512 + lane * 8 + j] = ksum[j];
        if (lane < 4) red[4096 + F.wave * 4 + lane] = lfs;
        __syncthreads();
        {
            float s = 0.f;
#pragma unroll
            for (int w = 0; w < 8; ++w) s += red[w * 512 + F.tid];
            const int m0 = unit * 64, b = m0 >> 11, blk = (m0 & (SEQ - 1)) >> 8, h = F.tid >> 7, d = F.tid & 127;
            atomicAdd(KMQ + (((size_t)b * 4 + h) * 8 + blk) * 128 + d, (u64)(long long)(s * (KM_FIX / 256.f)));
            if (F.tid < 4) { float q = 0.f;
#pragma unroll
                for (int w = 0; w < 8; ++w) q += red[4096 + w * 4 + F.tid];
                LFSUM[unit * 4 + F.tid] = q; }
        }
        __syncthreads();
    }
}

constexpr int VNT_STRIDE = 272;
__device__ __forceinline__ void gmlp_unit(unsigned char* ws, KIN in, LAS unsigned char* lds, int l, int chunk, int g, const int wv) {
    const bf16* PROJ = (const bf16*)(ws + WS_PROJ); bf16* OMIX = (bf16*)(ws + WS_OMIX); const float* GSTAT = (const float*)(ws + WS_GSTAT);
    const float* ln_g = in[13] + l * 512; const float* ln_b = in[14] + l * 512; const float* b_s = in[16] + l * 4 * 128;
    const bf16* tril = (const bf16*)(ws + WS_TRIL) + ((size_t)l * 4 + g) * 128 * 128;
    LAS unsigned char* vnT = lds;
    const int tid = otid(wv), wave = wv, lane = tid & 63, r32 = lane & 31, hi = lane >> 5;
    const int m0 = chunk * 128;
    {
        const int s = tid >> 2, cq = tid & 3;
        const f32x2v st = *(const f32x2v*)(GSTAT + (size_t)(m0 + s) * 2);
        const bf16* src = PROJ + (size_t)(m0 + s) * NPROJ + PC_GV + g * 128 + cq * 32;
        v4u raw[4];
#pragma unroll
        for (int k = 0; k < 4; ++k) raw[k] = *(const v4u*)(src + k * 8);
#pragma unroll
        for (int k = 0; k < 4; ++k) {
            float x[8]; unpack8(raw[k], x);
#pragma unroll
            for (int j = 0; j < 8; ++j) {
                const int c = cq * 32 + k * 8 + j, ch = g * 128 + c;
                const float v = (gelu_tanh(x[j]) - st[0]) * st[1] * ln_g[ch] + ln_b[ch];
                *(LAS bf16*)(vnT + c * VNT_STRIDE + s * 2) = (bf16)f2bf(v);
            }
        }
    }
    __syncthreads();
    const int tb = wave >> 1, cb0 = (wave & 1) * 2;
    const int ch0 = g * 128 + 32 * cb0 + r32;
    unsigned short ur0[16], ur1[16];
#pragma unroll
    for (int i = 0; i < 16; ++i) {
        const int t = 32 * tb + (i & 3) + 8 * (i >> 2) + 4 * hi;
        const bf16* urow = PROJ + (size_t)(m0 + t) * NPROJ + PC_GU + ch0;
        ur0[i] = urow[0]; ur1[i] = urow[32];
    }
    f32x16 acc0 = {}, acc1 = {};
    const int trow = 32 * tb + r32;
    const bf16* wrow = tril + (size_t)trow * 128;
#pragma unroll 2
    for (int ks = 0; ks < 2 * (tb + 1); ++ks) {
        const int s0 = 16 * ks + 8 * hi;
        const bf16x8 afrag = *(const bf16x8*)(wrow + s0);
        const bf16x8 b0 = *(const LAS bf16x8*)(vnT + (32 * cb0 + r32) * VNT_STRIDE + s0 * 2);
        const bf16x8 b1 = *(const LAS bf16x8*)(vnT + (32 * (cb0 + 1) + r32) * VNT_STRIDE + s0 * 2);
        acc0 = __builtin_amdgcn_mfma_f32_32x32x16_bf16(afrag, b0, acc0, 0, 0, 0);
        acc1 = __builtin_amdgcn_mfma_f32_32x32x16_bf16(afrag, b1, acc1, 0, 0, 0);
    }
#pragma unroll
    for (int i = 0; i < 16; ++i) {
        const int t = 32 * tb + (i & 3) + 8 * (i >> 2) + 4 * hi;
        const float bs = b_s[g * 128 + t];
        bf16* op = OMIX + (size_t)(m0 + t) * DM + 1024 + ch0;
        op[0] = (bf16)f2bf(gelu_tanh(bf2f(ur0[i])) * (acc0[i] + bs));
        op[32] = (bf16)f2bf(gelu_tanh(bf2f(ur1[i])) * (acc1[i] + bs));
    }
    __syncthreads();
}

__device__ __forceinline__ void foxbias_phase(Frame& F) {
    const float* LF = (const float*)(F.ws + WS_LF); const float* LFSUM = (const float*)(F.ws + WS_LFSUM); bf16* FKA = (bf16*)(F.ws + WS_FKA);
    const int lane = F.lane;
    if (F.wave < 4)
    for (int unit = F.vcu; unit < M / 64; unit += F.G) {
        const int h = F.wave, u0 = unit & ~31, m = unit * 64 + lane;
        float pre = (u0 + lane < unit) ? LFSUM[(u0 + lane) * 4 + h] : 0.f;
        float v = LF[(size_t)m * 4 + h];
        pre = wave_sum(pre);
#pragma unroll
        for (int o = 1; o < 64; o <<= 1) { const float tt = __shfl_up(v, o); if (lane >= o) v += tt; }
        const float val = -(pre + v) * LOG2E;
        const unsigned b0 = f2bf(val); const float r1 = val - __uint_as_float(b0 << 16);
        const unsigned b1 = f2bf(r1); const float r2 = r1 - __uint_as_float(b1 << 16);
        const unsigned b2 = f2bf(r2);
        v4u w0 = {b0 | (b1 << 16), b2, 0u, 0u}, w1 = {0u, 0u, 0u, 0u};
        *(v4u*)(FKA + ((size_t)m * 4 + h) * 16) = w0; *(v4u*)(FKA + ((size_t)m * 4 + h) * 16 + 8) = w1;
        ((float*)(F.ws + WS_FBIAS))[(size_t)m * 4 + h] = val;
    }
}
__device__ __forceinline__ void gating_phase(Frame& F, int l, gu32* qctr, const int ubase, const int nunit) {
    const bf16* PROJ = (const bf16*)(F.ws + WS_PROJ); bf16* BQA = (bf16*)(F.ws + WS_BQA);
    const u64* KMQ = (const u64*)(F.ws + WS_ACC + MiB) + (size_t)l * (8 * 4 * 8 * 128);
    LAS float* km = (LAS float*)F.lds;
    const float* gbq = F.in[17] + l * 128;
    const int lane = F.lane, n = lane >> 3, dc = lane & 7;
    LAS unsigned* slot = (LAS unsigned*)(F.lds + 131072 + 320 + 64);
    for (;;) {
        const int qi_ = queue_next(qctr, slot, F.wave); if (qi_ >= nunit) break;
        const int unit = ubase + qi_;
        const int m0 = unit * 64, b = m0 >> 11, blk = (m0 & (SEQ - 1)) >> 8;
        for (int i = F.tid; i < 4 * 8 * 128; i += 512) km[(i >> 7) * 132 + (i & 127)] = (float)(long long)KMQ[(size_t)b * 4096 + i] * KM_INV * gbq[i & 127];
        __syncthreads();
        const int mb = m0 + F.wave * 8;
        v4u q[4][2], qn[4][2];
#pragma unroll
        for (int h = 0; h < 4; ++h) { const bf16* p = PROJ + (size_t)mb * NPROJ + PC_BQ + h * 128 + dc * 16; q[h][0] = *(const v4u*)p; q[h][1] = *(const v4u*)(p + 8); }
#pragma unroll 1
        for (int i = 0; i < 8; ++i) {
            const int m = mb + i;
            if (i + 1 < 8) {
#pragma unroll
                for (int h = 0; h < 4; ++h) { const bf16* p = PROJ + (size_t)(m + 1) * NPROJ + PC_BQ + h * 128 + dc * 16; qn[h][0] = *(const v4u*)p; qn[h][1] = *(const v4u*)(p + 8); }
            }
#pragma unroll
            for (int h = 0; h < 4; ++h) {
                float x[16]; { float a[8], c[8]; unpack8(q[h][0], a); unpack8(q[h][1], c);
#pragma unroll
                    for (int j = 0; j < 8; ++j) { x[j] = a[j]; x[8 + j] = c[j]; } }
                const LAS float* kp = km + (h * 8 + n) * 132 + dc * 16;
                float gsum = 0.f;
#pragma unroll
                for (int j4 = 0; j4 < 4; ++j4) { const f32x4 kv = *(const LAS f32x4*)(kp + j4 * 4); gsum += x[j4 * 4] * kv[0] + x[j4 * 4 + 1] * kv[1] + x[j4 * 4 + 2] * kv[2] + x[j4 * 4 + 3] * kv[3]; }
                gsum = grp8_sum(gsum);
                const float gate = n < blk ? gsum : -__builtin_inff();
                int rank = 0;
#pragma unroll
                for (int xo = 1; xo < 8; ++xo) { const float og = __shfl_xor(gate, 8 * xo); const int on = n ^ xo; rank += (og > gate || (og == gate && on < n)) ? 1 : 0; }
                const bool selected = n < blk && (blk <= 3 || rank < 3);
                const bool masked = n < blk && !selected;
                if (dc == 0) BQA[((size_t)m * 4 + h) * 16 + n] = masked ? (bf16)0xC700 : (bf16)0;
                if (dc == 1) BQA[((size_t)m * 4 + h) * 16 + 8 + n] = (bf16)0;
            }
#pragma unroll
            for (int h = 0; h < 4; ++h) { q[h][0] = qn[h][0]; q[h][1] = qn[h][1]; }
        }
    }
}
__device__ __forceinline__ void groupnorm_phase(Frame& F, int l) {
    bf16* OMIX = (bf16*)(F.ws + WS_OMIX); const float* gn = F.in[19] + l * 2048;
    const int lane = F.lane;
    f32x4 gg[4][2];
#pragma unroll
    for (int g = 0; g < 4; ++g) { gg[g][0] = *(const f32x4*)(gn + g * 512 + lane * 8); gg[g][1] = *(const f32x4*)(gn + g * 512 + lane * 8 + 4); }
#pragma unroll 1
    for (int unit = F.vcu; unit < M / 64; unit += F.G) {
        bf16* base = OMIX + (size_t)(unit * 64 + F.wave) * DM + lane * 8;
        v4u x4[8][4];
#pragma unroll
        for (int k = 0; k < 8; ++k)
#pragma unroll
            for (int g = 0; g < 4; ++g) x4[k][g] = *(const v4u*)(base + (size_t)(8 * k) * DM + g * 512);
#pragma unroll
        for (int k = 0; k < 8; ++k)
#pragma unroll
            for (int g = 0; g < 4; ++g) {
                float x[8]; unpack8(x4[k][g], x); float s = 0.f;
#pragma unroll
                for (int j = 0; j < 8; ++j) s += x[j] * x[j];
                const float rs = rsqrtf(wave_sum(s) * (1.f / 512.f) + EPS);
                x[0] *= rs * gg[g][0][0]; x[1] *= rs * gg[g][0][1]; x[2] *= rs * gg[g][0][2]; x[3] *= rs * gg[g][0][3]; x[4] *= rs * gg[g][1][0]; x[5] *= rs * gg[g][1][1]; x[6] *= rs * gg[g][1][2]; x[7] *= rs * gg[g][1][3];
                *(v4u*)(base + (size_t)(8 * k) * DM + g * 512) = pack8f(x);
            }
    }
}

struct AttnSpec {
    const bf16 *q0, *q1, *k0, *k1, *v; bf16* o;
    int pq0, pq1, pk0, pk1, pv, po;
    int hq0, hq1, hk0, hk1, hv, ho;
    int qrows, kvrows;
};
__device__ __forceinline__ int v_st(int k, int c) { const int kk = (k & ~0xC) | ((k & 4) << 1) | ((k & 8) >> 1); return ((kk >> 3) * 4 + (c >> 5)) * 512 + ((kk & 7) * 32 + (c & 31)) * 2; }
__device__ __forceinline__ int v_rd_base(int lane) { return ((lane & 3) << 3) | (((lane >> 2) & 3) << 6) | (((lane >> 4) & 1) << 5) | (((lane >> 5) & 1) << 8); }
__device__ __forceinline__ unsigned cvtpk(float lo, float hi) { unsigned r; asm volatile("v_cvt_pk_bf16_f32 %0, %1, %2" : "=v"(r) : "v"(lo), "v"(hi)); return r; }
#define SBAR() __builtin_amdgcn_sched_barrier(0)

template <int NKS, int NQ0, bool CAUSAL, int QMODE, bool KNORM, bool OUT8 = false>
__device__ __forceinline__ void attn_unit(LAS unsigned char* lds, const AttnSpec& S, int b, int h, int qb, const float* qgain, const float* kgain, const int wv, const float* rope = nullptr, const int t_lo = 0) {
    constexpr int NCH = 2 * NKS, KSTR = (NCH + 1) * 16, KBUF = 64 * KSTR, VBUF = 16384, NX = NCH - 16, NP = NX ? 3 : 2;
    const int tid = otid(wv), wid = wv, lane = tid & 63, r32 = lane & 31, hi = lane >> 5;
    LAS unsigned char* kbuf = lds; LAS unsigned char* vbuf = lds + 2 * KBUF;
    const int q_row0 = qb * 256, qlo = q_row0 + wid * 32, qpos = qlo + r32;
    const int NT = CAUSAL ? (q_row0 + 256) / 64 : S.kvrows / 64;
    const bf16* k0p = S.k0 + (size_t)b * S.kvrows * S.pk0 + h * S.hk0;
    const bf16* k1p = S.k1 + (size_t)b * S.kvrows * S.pk1 + h * S.hk1;
    const bf16* vp = S.v + (size_t)b * S.kvrows * S.pv + h * S.hv;
    bf16x8 qr[NKS];
    {
        const bf16* q0p = S.q0 + ((size_t)b * S.qrows + qpos) * S.pq0 + h * S.hq0;
        const bf16* q1p = S.q1 + ((size_t)b * S.qrows + qpos) * S.pq1 + h * S.hq1;
#pragma unroll
        for (int d0 = 0; d0 < NKS; ++d0) {
            if (2 * d0 < NQ0) qr[d0] = *(const bf16x8*)(q0p + (2 * d0 + hi) * 8);
            else qr[d0] = *(const bf16x8*)(q1p + (2 * d0 + hi - NQ0) * 8);
        }
    }
    v4u kst[NP], vst[2];
    int koff[NP], voff[2]; const bf16* ksrc[NP]; const bf16* vsrc[2]; int kpitch[NP];
#pragma unroll
    for (int i = 0; i < 2; ++i) { const int p = tid + 512 * i, row = p >> 4, ch = p & 15; koff[i] = row * KSTR + ch * 16; ksrc[i] = k0p + (size_t)row * S.pk0 + ch * 8; kpitch[i] = S.pk0; }
    if constexpr (NX > 0) { const int row = NX == 8 ? tid >> 3 : tid >> 1, ch = NX == 8 ? tid & 7 : tid & 1; koff[2] = row * KSTR + (16 + ch) * 16; ksrc[2] = k1p + (size_t)row * S.pk1 + ch * 8; kpitch[2] = S.pk1; }
    const bool xact = NX == 8 || tid < 128;
#pragma unroll
    for (int i = 0; i < 2; ++i) { const int idx = tid + 512 * i, k = idx >> 4, c8 = idx & 15; voff[i] = v_st(k, c8 * 8); vsrc[i] = vp + (size_t)k * S.pv + c8 * 8; }
#define ATT_LOAD(t) do { _Pragma("unroll") for (int i_ = 0; i_ < NP; ++i_) if (i_ < 2 || xact) kst[i_] = *(const v4u*)(ksrc[i_] + (size_t)(t) * 64 * kpitch[i_]); \
        _Pragma("unroll") for (int i_ = 0; i_ < 2; ++i_) vst[i_] = *(const v4u*)(vsrc[i_] + (size_t)(t) * 64 * S.pv); } while (0)
    ATT_LOAD(t_lo);
    {
        if constexpr (QMODE == 1) {
            float ssq = 0.f;
#pragma unroll
            for (int d0 = 0; d0 < 8; ++d0)
#pragma unroll
                for (int j = 0; j < 8; ++j) { const float x = bf2f((unsigned short)qr[d0][j]); ssq += x * x; }
            ssq = sum32(ssq);
            const float rs = rsqrtf(ssq * (1.f / 128.f) + EPS) * QS128;
#pragma unroll
            for (int d0 = 0; d0 < 8; ++d0) {
                float x[8];
#pragma unroll
                for (int j = 0; j < 8; ++j) x[j] = bf2f((unsigned short)qr[d0][j]) * rs * qgain[d0 * 16 + hi * 8 + j];
                v4u w; w.x = pk2(x[0], x[1]); w.y = pk2(x[2], x[3]); w.z = pk2(x[4], x[5]); w.w = pk2(x[6], x[7]);
                qr[d0] = __builtin_bit_cast(bf16x8, w);
            }
        }
        if constexpr (QMODE == 2) {
            float ssn = 0.f, ssp = 0.f;
#pragma unroll
            for (int d0 = 0; d0 < 8; ++d0)
#pragma unroll
                for (int j = 0; j < 8; ++j) { const float x = bf2f((unsigned short)qr[d0][j]); ssn += x * x; }
#pragma unroll
            for (int d0 = 8; d0 < 12; ++d0)
#pragma unroll
                for (int j = 0; j < 8; ++j) { const float x = bf2f((unsigned short)qr[d0][j]); ssp += x * x; }
            ssn = sum32(ssn); ssp = sum32(ssp);
            const float rsn = rsqrtf(ssn * (1.f / 128.f) + EPS) * QS192, rsp = rsqrtf(ssp * (1.f / 64.f) + EPS);
#pragma unroll
            for (int d0 = 0; d0 < 8; ++d0) {
                float x[8];
#pragma unroll
                for (int j = 0; j < 8; ++j) x[j] = bf2f((unsigned short)qr[d0][j]) * rsn * qgain[d0 * 16 + hi * 8 + j];
                qr[d0] = __builtin_bit_cast(bf16x8, pack8f(x));
            }
#pragma unroll
            for (int d0 = 8; d0 < 10; ++d0) {
                const int i0 = 16 * (d0 - 8) + 8 * hi;
                const float* rp = rope + ((size_t)qpos * 32 + i0) * 2;
                float o1[8], o2[8];
#pragma unroll
                for (int j = 0; j < 8; ++j) {
                    const float x1 = bf2f((unsigned short)qr[d0][j]) * rsp * qgain[128 + i0 + j], x2 = bf2f((unsigned short)qr[d0 + 2][j]) * rsp * qgain[160 + i0 + j];
                    const float c = rp[2 * j], sn = rp[2 * j + 1];
                    o1[j] = (x1 * c - x2 * sn) * QS192; o2[j] = (x1 * sn + x2 * c) * QS192;
                }
                qr[d0] = __builtin_bit_cast(bf16x8, pack8f(o1)); qr[d0 + 2] = __builtin_bit_cast(bf16x8, pack8f(o2));
            }
        }
    }
    float kg[8];
    if constexpr (KNORM) {
#pragma unroll
        for (int j = 0; j < 8; ++j) kg[j] = kgain[(tid & 15) * 8 + j];
    }
#define ATT_KNORM() do { if constexpr (KNORM) { _Pragma("unroll") for (int i_ = 0; i_ < 2; ++i_) { float x_[8]; unpack8(kst[i_], x_); float s_ = 0.f; \
        _Pragma("unroll") for (int j_ = 0; j_ < 8; ++j_) s_ += x_[j_] * x_[j_]; s_ = grp16_sum(s_); const float rs_ = rsqrtf(s_ * (1.f / 128.f) + EPS); \
        _Pragma("unroll") for (int j_ = 0; j_ < 8; ++j_) x_[j_] = x_[j_] * rs_ * kg[j_]; kst[i_] = pack8f(x_); } } } while (0)
#define ATT_WRITE(bf) do { ATT_KNORM(); _Pragma("unroll") for (int i_ = 0; i_ < NP; ++i_) if (i_ < 2 || xact) *(LAS v4u*)(kbuf + (bf) * KBUF + koff[i_]) = kst[i_]; \
        _Pragma("unroll") for (int i_ = 0; i_ < 2; ++i_) *(LAS v4u*)(vbuf + (bf) * VBUF + voff[i_]) = vst[i_]; } while (0)
    float m_run = -1e30f, l_run = 0.f; f32x16 o[4] = {};
    ATT_WRITE(t_lo & 1); __syncthreads();
    for (int t = t_lo; t < NT; ++t) {
        const int cur = t & 1, kb = t * 64;
        if (t + 1 < NT) ATT_LOAD(t + 1);
        const bool act = !CAUSAL || (kb <= qlo + 31);
        if (act) {
            f32x16 p0 = {}, p1 = {};
            const LAS unsigned char* ka = kbuf + cur * KBUF + r32 * KSTR + hi * 16;
#pragma unroll
            for (int d0 = 0; d0 < NKS; ++d0) {
                const bf16x8 b0 = *(const LAS bf16x8*)(ka + d0 * 32);
                const bf16x8 b1 = *(const LAS bf16x8*)(ka + 32 * KSTR + d0 * 32);
                p0 = __builtin_amdgcn_mfma_f32_32x32x16_bf16(b0, qr[d0], p0, 0, 0, 0);
                p1 = __builtin_amdgcn_mfma_f32_32x32x16_bf16(b1, qr[d0], p1, 0, 0, 0);
            }
            if (CAUSAL && kb + 63 > qlo) {
                const float NEG = -__builtin_inff();
#pragma unroll
                for (int i = 0; i < 16; ++i) {
                    const int key = kb + (i & 3) + 8 * (i >> 2) + 4 * hi;
                    if (key > qpos) p0[i] = NEG;
                    if (key + 32 > qpos) p1[i] = NEG;
                }
            }
            float pmax = p0[0];
#pragma unroll
            for (int i = 1; i < 16; ++i) pmax = fmaxf(pmax, p0[i]);
#pragma unroll
            for (int i = 0; i < 16; ++i) pmax = fmaxf(pmax, p1[i]);
            pmax = max32(pmax);
            const float mn = pmax > m_run + 8.f ? pmax : m_run, alpha = __builtin_amdgcn_exp2f(m_run - mn);
            m_run = mn;
            float ps = 0.f;
#pragma unroll
            for (int i = 0; i < 16; ++i) { p0[i] = __builtin_amdgcn_exp2f(p0[i] - mn); ps += p0[i]; }
#pragma unroll
            for (int i = 0; i < 16; ++i) { p1[i] = __builtin_amdgcn_exp2f(p1[i] - mn); ps += p1[i]; }
            ps = sum32(ps);
            l_run = l_run * alpha + ps;
            if (!__all(alpha == 1.f)) {
#pragma unroll
                for (int d = 0; d < 4; ++d)
#pragma unroll
                    for (int i = 0; i < 16; ++i) o[d][i] *= alpha;
            }
            bf16x8 pa0, pa1, pa2, pa3;
#define PK4(P, B_, OUT) do { unsigned a0 = cvtpk(P[B_ + 0], P[B_ + 1]), a1 = cvtpk(P[B_ + 2], P[B_ + 3]); \
        unsigned b0_ = cvtpk(P[B_ + 4], P[B_ + 5]), b1_ = cvtpk(P[B_ + 6], P[B_ + 7]); \
        auto r0 = __builtin_amdgcn_permlane32_swap(a0, b0_, false, false); auto r1 = __builtin_amdgcn_permlane32_swap(a1, b1_, false, false); \
        v4u w = {r0[0], r1[0], r0[1], r1[1]}; OUT = __builtin_bit_cast(bf16x8, w); } while (0)
            PK4(p0, 0, pa0); PK4(p0, 8, pa1); PK4(p1, 0, pa2); PK4(p1, 8, pa3);
#undef PK4
            const unsigned vb0 = (unsigned)(uintptr_t)(vbuf + cur * VBUF) + (unsigned)v_rd_base(lane);
#define TRRD(dst, off) asm volatile("ds_read_b64_tr_b16 %0, %1 offset:%2" : "=&v"(dst) : "v"(vb0), "i"(off) : "memory")
#define PV_D0(d0) do { s16x4 l0, l1, l2, l3, h0, h1, h2, h3; constexpr int b_ = (d0) * 512; \
        TRRD(l0, b_); TRRD(h0, b_ + 2048); TRRD(l1, b_ + 4096); TRRD(h1, b_ + 6144); TRRD(l2, b_ + 8192); TRRD(h2, b_ + 10240); TRRD(l3, b_ + 12288); TRRD(h3, b_ + 14336); \
        asm volatile("s_waitcnt lgkmcnt(0)" ::: "memory"); SBAR(); \
        o[d0] = __builtin_amdgcn_mfma_f32_32x32x16_bf16((bf16x8){l0[0], l0[1], l0[2], l0[3], h0[0], h0[1], h0[2], h0[3]}, pa0, o[d0], 0, 0, 0); \
        o[d0] = __builtin_amdgcn_mfma_f32_32x32x16_bf16((bf16x8){l1[0], l1[1], l1[2], l1[3], h1[0], h1[1], h1[2], h1[3]}, pa1, o[d0], 0, 0, 0); \
        o[d0] = __builtin_amdgcn_mfma_f32_32x32x16_bf16((bf16x8){l2[0], l2[1], l2[2], l2[3], h2[0], h2[1], h2[2], h2[3]}, pa2, o[d0], 0, 0, 0); \
        o[d0] = __builtin_amdgcn_mfma_f32_32x32x16_bf16((bf16x8){l3[0], l3[1], l3[2], l3[3], h3[0], h3[1], h3[2], h3[3]}, pa3, o[d0], 0, 0, 0); } while (0)
            PV_D0(0); PV_D0(1); PV_D0(2); PV_D0(3);
#undef PV_D0
#undef TRRD
        }
        if (t + 1 < NT) ATT_WRITE(cur ^ 1);
        __syncthreads();
    }
#undef ATT_LOAD
#undef ATT_WRITE
#undef ATT_KNORM
    const float inv = 1.f / l_run;
    if constexpr (OUT8) {
        constexpr int OSTR = 128 + 16;
        LAS unsigned char* ost = lds + wid * (32 * OSTR);
#pragma unroll
        for (int d0 = 0; d0 < 4; ++d0)
#pragma unroll
            for (int g = 0; g < 4; ++g) {
                const float sc8 = inv * XO8_SCALE; unsigned a8 = 0;
                a8 = __builtin_amdgcn_cvt_pk_fp8_f32(fp8clamp(o[d0][4 * g] * sc8), fp8clamp(o[d0][4 * g + 1] * sc8), a8, false);
                a8 = __builtin_amdgcn_cvt_pk_fp8_f32(fp8clamp(o[d0][4 * g + 2] * sc8), fp8clamp(o[d0][4 * g + 3] * sc8), a8, true);
                *(LAS unsigned*)(ost + r32 * OSTR + 32 * d0 + 8 * g + 4 * hi) = a8;
            }
        unsigned char* obase8 = (unsigned char*)S.o + ((size_t)b * S.qrows + qlo) * S.po + h * S.ho;
#pragma unroll
        for (int j = 0; j < 4; ++j) { const int row = (lane >> 3) + 8 * j, ch = lane & 7;
            *(v4u*)(obase8 + (size_t)row * S.po + ch * 16) = *(const LAS v4u*)(ost + row * OSTR + ch * 16); }
    } else {
        constexpr int OSTR = 256 + 16;
        LAS unsigned char* ost = lds + wid * (32 * OSTR);
#pragma unroll
        for (int d0 = 0; d0 < 4; ++d0)
#pragma unroll
            for (int g = 0; g < 4; ++g) {
                typedef unsigned v2u_t __attribute__((ext_vector_type(2)));
                v2u_t w; w.x = cvtpk(o[d0][4 * g] * inv, o[d0][4 * g + 1] * inv); w.y = cvtpk(o[d0][4 * g + 2] * inv, o[d0][4 * g + 3] * inv);
                *(LAS v2u_t*)(ost + r32 * OSTR + (32 * d0 + 8 * g + 4 * hi) * 2) = w;
            }
        bf16* obase = S.o + ((size_t)b * S.qrows + qlo) * S.po + h * S.ho;
#pragma unroll
        for (int j = 0; j < 8; ++j) { const int row = (lane >> 4) + 4 * j, ch = lane & 15;
            *(v4u*)(obase + (size_t)row * S.po + ch * 8) = *(const LAS v4u*)(ost + row * OSTR + ch * 16); }
    }
    __syncthreads();
}

constexpr int LDS_BYTES = 147456;
constexpr int MISC_OFF = 131072 + 320;
constexpr int NPH_L = 11, NPHASE = 1 + 2 * NPH_L;

__device__ __forceinline__ AttnSpec spec_fox(unsigned char* ws) {
    bf16* PROJ = (bf16*)(ws + WS_PROJ); AttnSpec S;
    S.q0 = PROJ + PC_FQ; S.pq0 = NPROJ; S.hq0 = 128; S.q1 = (const bf16*)(ws + WS_FQA); S.pq1 = 0; S.hq1 = 0;
    S.k0 = PROJ + PC_FK; S.pk0 = NPROJ; S.hk0 = 128; S.k1 = (const bf16*)(ws + WS_FKA); S.pk1 = 64; S.hk1 = 16;
    S.v = PROJ + PC_FV; S.pv = NPROJ; S.hv = 128; S.o = (bf16*)(ws + WS_OMIX); S.po = DM; S.ho = 128; S.qrows = SEQ; S.kvrows = SEQ; return S;
}
__device__ __forceinline__ AttnSpec spec_moba(unsigned char* ws) {
    bf16* PROJ = (bf16*)(ws + WS_PROJ); AttnSpec S;
    S.q0 = PROJ + PC_BQ; S.pq0 = NPROJ; S.hq0 = 128; S.q1 = (const bf16*)(ws + WS_BQA); S.pq1 = 64; S.hq1 = 16;
    S.k0 = PROJ + PC_BK; S.pk0 = NPROJ; S.hk0 = 128; S.k1 = (const bf16*)(ws + WS_BKA); S.pk1 = 16; S.hk1 = 0;
    S.v = PROJ + PC_BV; S.pv = NPROJ; S.hv = 128; S.o = (bf16*)(ws + WS_OMIX) + 1536; S.po = DM; S.ho = 128; S.qrows = SEQ; S.kvrows = SEQ; return S;
}
__device__ __forceinline__ AttnSpec spec_mla(unsigned char* ws) {
    AttnSpec S; bf16* QM = (bf16*)(ws + WS_QM); bf16* KVM = (bf16*)(ws + WS_KVM);
    S.q0 = QM; S.pq0 = 768; S.hq0 = 192; S.q1 = QM; S.pq1 = 0; S.hq1 = 0;
    S.k0 = KVM; S.pk0 = 1024; S.hk0 = 256; S.k1 = (const bf16*)(ws + WS_KPE); S.pk1 = 64; S.hk1 = 0;
    S.v = KVM + 128; S.pv = 1024; S.hv = 256; S.o = (bf16*)(ws + WS_OMIX) + 512; S.po = DM; S.ho = 128; S.qrows = SEQ; S.kvrows = SEQ; return S;
}
__device__ __forceinline__ AttnSpec spec_cross(unsigned char* ws, int l) {
    AttnSpec S; bf16* XQ = (bf16*)(ws + WS_XQ); bf16* XKV = (bf16*)(ws + WS_XKV) + (size_t)l * MEMR * 1024;
    S.q0 = XQ; S.pq0 = 512; S.hq0 = 128; S.q1 = XQ; S.pq1 = 0; S.hq1 = 0;
    S.k0 = XKV; S.pk0 = 1024; S.hk0 = 128; S.k1 = XKV; S.pk1 = 0; S.hk1 = 0;
    S.v = XKV + 512; S.pv = 1024; S.hv = 128; S.o = (bf16*)(ws + WS_XO); S.po = 512; S.ho = 128; S.qrows = SEQ; S.kvrows = 256; return S;
}

__global__ void __launch_bounds__(NWAVES * 64, 2) mega(Params P) {
    extern __shared__ __attribute__((aligned(16))) unsigned char lds_raw[];
    const int wv0 = __builtin_amdgcn_readfirstlane((int)threadIdx.x >> 6);
    Frame F;
    F.lds = (LAS unsigned char*)lds_raw;
    F.tid = otid(wv0); F.lane = F.tid & 63; F.wave = wv0;
    F.G = gridDim.x; { const int bx = blockIdx.x; F.vcu = (F.G % 8 == 0) ? (bx % 8) * (F.G / 8) + bx / 8 : bx; }
    F.in = (KIN)__builtin_amdgcn_kernarg_segment_ptr(); F.out = P.out; F.ws = P.ws;
    volatile LAS unsigned* MISC = (volatile LAS unsigned*)(F.lds + MISC_OFF);
    for (int u = F.tid; u < (LDS_BYTES - 131072) / 4; u += NWAVES * 64) ((LAS unsigned*)(F.lds + 131072))[u] = 0u;
    __syncthreads();
    gu32* ctl = (gu32*)(P.ws + WS_CTL);
    const int lo = P.ph_lo, hi = P.ph_hi;
    XcdBarrier bar; bar.bar = (unsigned*)ctl + CW_BAR; bar.x = 0; bar.st = nullptr; bar.wv = wv0;
    if (hi - lo > 1) bar = xcd_barrier_post((unsigned*)ctl + CW_BAR, MISC + 8, wv0);
    const int grp = (int)blockIdx.x & 7, gs = F.G >> 3, gj = (int)blockIdx.x >> 3;
    GrpBarrier gb; gb.cnt = (unsigned*)ctl + CW_GB + 64 * grp; gb.tmo = (unsigned*)ctl + CW_BAR + XB_TMO; gb.target = 0u; gb.step = (unsigned)gs; gb.fast = 0; gb.wv = wv0;
    if (hi - lo > 1 && wv0 == 0 && olane() == 0) (void)__hip_atomic_fetch_or((unsigned*)ctl + CW_COLO + 64 * grp, 1u << xb_xcc_id(), RLX_AGENT);
#define IN(k) (lo <= (k) && (k) < hi)
#ifndef PH_ENABLE
#define PH_ENABLE 0xFFFFF
#endif
#define PHEN(k) ((PH_ENABLE >> (k)) & 1)
#define REFRESH() do { F.tid = otid(wv0); F.lane = F.tid & 63; F.wave = wv0; F.in = (KIN)(unsigned long long)uni_launder((const char*)(unsigned long long)__builtin_amdgcn_kernarg_segment_ptr()); } while (0)
#if defined(DIAG_X8_PASS)
#define DIAG_X8_PASS_ON 1
#else
#define DIAG_X8_PASS_ON 0
#endif
#ifndef MULTI_GEMM
#define MULTI_GEMM 1
#endif
#ifndef REP_PHASE
#define REP_PHASE -1
#endif
#define REPS(k) ((REP_PHASE) == (k) ? 2 : 1)
#ifdef PROBE_STAMP
    typedef unsigned long long su64;
    volatile LAS su64* stamp = (volatile LAS su64*)(F.lds + 131072 + 1024);
#define STAMP_AT(l_, k_, w_) do { if ((l_) * 16 + (k_) == (PROBE_STAMP) && blockIdx.x == 0 && wv0 == 0) { const su64 c_ = __builtin_readcyclecounter(), r_ = __builtin_amdgcn_s_memrealtime(); if (olane() == 0) { stamp[2 * (w_)] = c_; stamp[2 * (w_) + 1] = r_; } } } while (0)
#else
#define STAMP_AT(l_, k_, w_) do { } while (0)
#endif
#define REPBAR(k) do { if (IN(k)) xcd_barrier(bar); } while (0)
#define SEAM(k) do { if (IN(k) && IN((k) + 1)) { if ((k) == 0) { xcd_barrier(bar); const unsigned cm_ = xb_ld((unsigned*)ctl + CW_COLO + 64 * grp); gb.fast = (cm_ & (cm_ - 1u)) == 0u; } else grp_barrier(gb); } } while (0)
    unsigned char* ws = P.ws;
    bf16* XB = (bf16*)(ws + WS_XB); bf16* PROJ = (bf16*)(ws + WS_PROJ); bf16* OMIX = (bf16*)(ws + WS_OMIX);

    _Pragma("unroll 1") for (int rep = 0; rep < REPS(16); ++rep) { if (rep) REPBAR(0); if (PHEN(16) && IN(0)) { STAMP_AT(6, 4, 0); REFRESH(); p0_prologue(F); STAMP_AT(6, 4, 1); } }
    SEAM(0); STAMP_AT(6, 4, 2);
    for (int l = 0; l < 2; ++l) {
        const int pb = 1 + NPH_L * l;
#define PHASE_BEGIN(k) _Pragma("unroll 1") for (int rep = 0; rep < REPS(k); ++rep) { if (rep) REPBAR(pb + (k)); if (PHEN(k) && IN(pb + (k))) { STAMP_AT(l, k, 0);
#define PHASE_END(k) STAMP_AT(l, k, 1); } } SEAM(pb + (k)); STAMP_AT(l, k, 2);
        PHASE_BEGIN(0)
            pg8::Gemm g{XB, wptr(ws, l, WO_IN), M, NPROJ, DM}; pg8::StaticOrder S; S.init(M, NPROJ, F.G, (int)blockIdx.x);
            EpiScale E{PROJ, NPROJ, ss_ptr(ws, 3 * l + 0), 1.f / DM, 1.f};
            pg8::gemm_phase<EpiScale, pg8::StaticOrder, true, true>(F.lds, g, S, E, wv0);
        PHASE_END(0)
        PHASE_BEGIN(1)
            REFRESH(); prep_phase(F, l);
        PHASE_END(1)
        PHASE_BEGIN(2)
#if MULTI_GEMM
            { pg8::Gemm g0{(bf16*)(ws + WS_CQN), wptr(ws, l, WO_UQ), M, 768, 512}, g1{(bf16*)(ws + WS_CKVN), wptr(ws, l, WO_UKV), M, 1024, 256};
              pg8::ListOrder2G S; S.init(8 * grp, 8, 3, 8 * grp, 8, 4, gs, gj);
              EpiScale2 E{EpiScale{(bf16*)(ws + WS_QM), 768, nullptr, 0.f, 1.f}, EpiScale{(bf16*)(ws + WS_KVM), 1024, nullptr, 0.f, 1.f}};
              pg8::gemm_phase<EpiScale2, pg8::ListOrder2G, true, true, false, true>(F.lds, g0, S, E, wv0, g1); }
#else
            { pg8::Gemm g{(bf16*)(ws + WS_CQN), wptr(ws, l, WO_UQ), M, 768, 512}; pg8::StaticOrder S; S.init(M, 768, F.G, (int)blockIdx.x);
              EpiScale E{(bf16*)(ws + WS_QM), 768, nullptr, 0.f, 1.f};
              pg8::gemm_phase<EpiScale, pg8::StaticOrder, true, true>(F.lds, g, S, E, wv0); }
            { pg8::Gemm g{(bf16*)(ws + WS_CKVN), wptr(ws, l, WO_UKV), M, 1024, 256}; pg8::StaticOrder S; S.init(M, 1024, F.G, (int)blockIdx.x);
              EpiScale E{(bf16*)(ws + WS_KVM), 1024, nullptr, 0.f, 1.f};
              pg8::gemm_phase<EpiScale, pg8::StaticOrder, true, true>(F.lds, g, S, E, wv0); }
#endif
            REFRESH(); foxbias_phase(F); REFRESH(); gating_phase(F, l, ctl + CW_Q + 64 * (32 * l + 24 + grp) + 4096 * rep, grp * 32, 32);
        PHASE_END(2)
        PHASE_BEGIN(3)
            LAS unsigned* slot = (LAS unsigned*)(F.lds + MISC_OFF + 64);
            REFRESH();
            {
                const AttnSpec SF = spec_fox(ws), SB = spec_moba(ws), SM = spec_mla(ws); const float* gq = F.in[11] + l * 192; const float* gk = F.in[12] + l * 192;
                const float* fbias = (const float*)(ws + WS_FBIAS);
                float fxB; { const float* g1 = F.in[5] + l * 128; const float* g2 = F.in[6] + l * 128; float a = fmaxf(fabsf(g1[F.lane]), fabsf(g1[F.lane + 64])), c = fmaxf(fabsf(g2[F.lane]), fabsf(g2[F.lane + 64]));
#pragma unroll
                    for (int o = 1; o < 64; o <<= 1) { a = fmaxf(a, __shfl_xor(a, o)); c = fmaxf(c, __shfl_xor(c, o)); }
                    fxB = 2.f * (128.f * QS128 * 1.01f) * a * c + 40.f; }
                gu32* ctr = ctl + CW_Q + 64 * (32 * l + grp) + 4096 * rep;
                int it = queue_next(ctr, slot, wv0);
                for (;;) { if (it >= 96) break;
                    unsigned nx_ = 0u; if (wv0 == 0 && olane() == 0) nx_ = __hip_atomic_fetch_add(ctr, 1u, __ATOMIC_RELAXED, __HIP_MEMORY_SCOPE_AGENT);
                    if (it < 64) { const int r = it & 7, qb = 7 - (it >> 3);
                        if (r < 4) attn_unit<12, 24, true, 2, true>(F.lds, SM, grp, r, qb, gq, gk, wv0, (const float*)(ws + WS_ROPE));
                        else attn_unit<9, 16, true, 1, false>(F.lds, SB, grp, r - 4, qb, F.in[17] + l * 128, nullptr, wv0); }
                    else { const int j = it - 64, qb = 7 - (j >> 2), b = grp, hh = j & 3;
                        int tlo = 0;
                        if (qb > 0) { const float ref = fbias[((size_t)b * SEQ + qb * 256) * 4 + hh];
                            const bool skip = F.lane < 4 * qb && (ref - fbias[((size_t)b * SEQ + F.lane * 64 + 63) * 4 + hh]) >= fxB;
                            const unsigned long long mk = __ballot(skip); tlo = mk == ~0ull ? 64 : __builtin_ctzll(~mk); tlo = __builtin_amdgcn_readfirstlane(tlo < 4 * qb ? tlo : 4 * qb); }
                        attn_unit<9, 16, true, 1, false>(F.lds, SF, b, hh, qb, F.in[5] + l * 128, nullptr, wv0, nullptr, tlo); }
                    if (wv0 == 0 && olane() == 0) *slot = nx_;
                    __syncthreads(); it = (int)*slot; } }
            STAMP_AT(l, 3, 3);
            REFRESH();
            { gu32* ctr = ctl + CW_Q + 64 * (32 * l + 16 + grp) + 4096 * rep;
              for (;;) { const int it = queue_next(ctr, slot, wv0); if (it >= 64) break; gmlp_unit(ws, F.in, F.lds, l, grp * 16 + (it >> 2), it & 3, wv0); } }
        PHASE_END(3)
        PHASE_BEGIN(4)
            REFRESH(); groupnorm_phase(F, l);
        PHASE_END(4)
        PHASE_BEGIN(5)
            pg8::Gemm g{OMIX, wptr(ws, l, WO_OUT), M, DM, DM}; pg8::StaticOrder S; S.init(M, DM, F.G, (int)blockIdx.x);
            EpiResid2 E{XB, ss_ptr(ws, 3 * l + 1), XATT_FP8 ? ws + WS_X8 : nullptr, nullptr, 1.f};
            pg8::gemm_phase<EpiResid2, pg8::StaticOrder, true, true>(F.lds, g, S, E, wv0);
        PHASE_END(5)
        PHASE_BEGIN(6)
#if MULTI_GEMM
            constexpr bool XF = XATT_FP8 != 0; constexpr float XOS = XF ? 1.f / (X8_SCALE * W8_SCALE) : 1.f;
            pg8::Gemm g0{XF ? (bf16*)(ws + WS_X8) : XB, wptr(ws, l, WO_XQ), M, 512, XF ? DM / 2 : DM}, g1{(bf16*)(ws + WS_MEMB), wptr(ws, l, WO_XKV), MEMR, 1024, XF ? DM / 2 : DM};
            pg8::ListOrder2G S; S.init(8 * grp, 8, 2, grp, 1, 4, gs, gj);
            EpiScale2 E{EpiScale{(bf16*)(ws + WS_XQ), 512, ss_ptr(ws, 3 * l + 1), 1.f / DM, XOS}, EpiScale{(bf16*)(ws + WS_XKV) + (size_t)l * MEMR * 1024, 1024, (const u64*)(ws + WS_MEMSS), 1.f / DM, XOS}};
            pg8::gemm_phase<EpiScale2, pg8::ListOrder2G, true, true, XF, true>(F.lds, g0, S, E, wv0, g1);
#else
            { pg8::Gemm g{XB, wptr(ws, l, WO_XQ), M, 512, DM}; pg8::StaticOrder S; S.init(M, 512, F.G, (int)blockIdx.x);
              EpiScale E{(bf16*)(ws + WS_XQ), 512, ss_ptr(ws, 3 * l + 1), 1.f / DM, 1.f};
              pg8::gemm_phase<EpiScale, pg8::StaticOrder, true, true>(F.lds, g, S, E, wv0); }
            { pg8::Gemm g{(bf16*)(ws + WS_MEMB), wptr(ws, l, WO_XKV), MEMR, 1024, DM}; pg8::StaticOrder S; S.init(MEMR, 1024, F.G, 255 - (int)blockIdx.x);
              EpiScale E{(bf16*)(ws + WS_XKV) + (size_t)l * MEMR * 1024, 1024, (const u64*)(ws + WS_MEMSS), 1.f / DM, 1.f};
              pg8::gemm_phase<EpiScale, pg8::StaticOrder, true, true>(F.lds, g, S, E, wv0); }
#endif
        PHASE_END(6)
        PHASE_BEGIN(7)
            REFRESH(); const AttnSpec SX = spec_cross(ws, l); const float* qg = F.in[25] + l * 128; const float* kg = F.in[26] + l * 128;
            for (int it = F.vcu; it < 256; it += F.G) { attn_unit<8, 16, false, 1, true, XATT_FP8 != 0>(F.lds, SX, it >> 5, (it >> 3) & 3, it & 7, qg, kg, wv0); }
        PHASE_END(7)
        PHASE_BEGIN(8)
            constexpr bool XF = XATT_FP8 != 0;
            pg8::Gemm g{(bf16*)(ws + WS_XO), wptr(ws, l, WO_XO), M, DM, XF ? 256 : 512}; pg8::StaticOrder S; S.init(M, DM, F.G, (int)blockIdx.x);
            EpiResid2 E{XB, ss_ptr(ws, 3 * l + 2), (FFN_FP8 & 1) ? ws + WS_X8 : nullptr, nullptr, XF ? 1.f / (XO8_SCALE * W8_SCALE) : 1.f};
            pg8::gemm_phase<EpiResid2, pg8::StaticOrder, true, true, XF>(F.lds, g, S, E, wv0);
        PHASE_END(8)
        PHASE_BEGIN(9)
            constexpr bool G8F = (FFN_FP8 & 1) != 0, G9F = (FFN_FP8 & 2) != 0;
            pg8::Gemm g{G8F ? (bf16*)(ws + WS_X8) : XB, wptr(ws, l, WO_GU), M, 2 * DFF, G8F ? DM / 2 : DM}; pg8::StaticOrder S; S.init(M, 2 * DFF, F.G, (int)blockIdx.x);
            EpiSwiGLUx<G9F> E{(void*)PROJ, ss_ptr(ws, 3 * l + 2), G8F ? 1.f / (X8_SCALE * W8_SCALE) : 1.f};
            pg8::gemm_phase<EpiSwiGLUx<G9F>, pg8::StaticOrder, true, true, G8F>(F.lds, g, S, E, wv0);
        PHASE_END(9)
        PHASE_BEGIN(10)
            constexpr bool G9F = (FFN_FP8 & 2) != 0;
            pg8::Gemm g{PROJ, wptr(ws, l, WO_D), M, DM, G9F ? DFF / 2 : DFF}; pg8::StaticOrder S; S.init(M, DM, F.G, (int)blockIdx.x);
            EpiResid2 E{XB, ss_ptr(ws, 3 * l + 3), nullptr, l == 1 ? P.out : nullptr, G9F ? 1.f / (ACT8_SCALE * W8_SCALE) : 1.f};
            pg8::gemm_phase<EpiResid2, pg8::StaticOrder, true, true, G9F>(F.lds, g, S, E, wv0);
        PHASE_END(10)
#undef PHASE_BEGIN
#undef PHASE_END
    }
#ifdef PROBE_STAMP
    if (blockIdx.x == 0 && wv0 == 0) {
        __builtin_amdgcn_s_waitcnt(0);
        const su64 c0 = stamp[0], r0 = stamp[1], c1 = stamp[2], r1 = stamp[3], r2 = stamp[5];
        su64 V;
        if (PROBE_STAMP_MODE == 0) V = (su64)((float)(c1 - c0) * 100.f / (float)(r1 - r0) * 100.f);
        else if (PROBE_STAMP_MODE == 1) V = (r1 - r0) * 10;
        else if (PROBE_STAMP_MODE == 3) V = (stamp[7] - r0) * 10;
        else V = (r2 - r0) * 10;
        const su64 t0 = __builtin_amdgcn_s_memrealtime();
        while (__builtin_amdgcn_s_memrealtime() - t0 < V) __builtin_amdgcn_s_sleep(64);
    }
#endif
#undef IN
#undef SEAM
}

#ifndef N_LAUNCH_MODE
#define N_LAUNCH_MODE 0
#endif
extern "C" void kernel_launch(void* const* d_in, const int* in_sizes, int n_in, void* d_out, int out_size, void* d_ws, size_t ws_size, hipStream_t stream) {
    static int grid = 0;
    if (grid == 0) {
        if (n_in != 31 || out_size != M * DM || ws_size < WS_END) { fprintf(stderr, "kernel_launch: unexpected shapes (n_in %d out %d ws %zu)\n", n_in, out_size, ws_size); grid = -1; return; }
        int dev = 0, cus = 0, per_cu = 0;
        if (hipGetDevice(&dev) != hipSuccess || hipDeviceGetAttribute(&cus, hipDeviceAttributeMultiprocessorCount, dev) != hipSuccess) { grid = -1; return; }
        if (hipFuncSetAttribute((const void*)mega, hipFuncAttributeMaxDynamicSharedMemorySize, LDS_BYTES) != hipSuccess) { fprintf(stderr, "kernel_launch: hipFuncSetAttribute failed\n"); grid = -1; return; }
        if (hipOccupancyMaxActiveBlocksPerMultiprocessor(&per_cu, (const void*)mega, NWAVES * 64, LDS_BYTES) != hipSuccess || per_cu < 1) fprintf(stderr, "kernel_launch: occupancy query says %d\n", per_cu);
        (void)hipGetLastError();
        grid = cus - cus % 8;
        if (grid < 8) { grid = -1; return; }
    }
    if (grid < 0) return;
    (void)hipMemsetAsync((char*)d_ws + WS_ACC, 0, 2 * MiB, stream);
    Params p{};
    for (int i = 0; i < 31; ++i) p.in[i] = (const float*)d_in[i];
    p.out = (float*)d_out; p.ws = (unsigned char*)d_ws;
#if N_LAUNCH_MODE == 1
    p.ph_lo = 0; p.ph_hi = NPHASE;
    hipLaunchKernelGGL(mega, dim3(grid), dim3(NWAVES * 64), LDS_BYTES, stream, p);
#else
    for (int ph = 0; ph < NPHASE; ++ph) {
        p.ph_lo = ph; p.ph_hi = ph + 1;
        hipLaunchKernelGGL(mega, dim3(grid), dim3(NWAVES * 64), LDS_BYTES, stream, p);
    }
#endif
}
```

```cpp
#include <hip/hip_runtime.h>
#include <cstdio>
#include <cstdint>
__device__ __forceinline__ int olane() { int l; asm volatile("v_mbcnt_lo_u32_b32 %0, -1, 0\n\tv_mbcnt_hi_u32_b32 %0, -1, %0" : "=v"(l)); return l; }
__device__ __forceinline__ int otid(int wv) { return (wv << 6) | olane(); }
template <class T> __device__ __forceinline__ T* uni_launder(T* p) {
    const unsigned z = (unsigned)olane() >> 7; const unsigned long long v = (unsigned long long)p;
    const unsigned lo = (unsigned)__builtin_amdgcn_readfirstlane((int)((unsigned)v + z)), hi = (unsigned)__builtin_amdgcn_readfirstlane((int)(unsigned)(v >> 32));
    return (T*)(((unsigned long long)hi << 32) | lo);
}
__device__ __forceinline__ const char* uni64(const char* p) { const unsigned long long v = (unsigned long long)p; const unsigned lo = (unsigned)__builtin_amdgcn_readfirstlane((int)(unsigned)v), hi = (unsigned)__builtin_amdgcn_readfirstlane((int)(unsigned)(v >> 32)); return (const char*)(((unsigned long long)hi << 32) | lo); }
__device__ __forceinline__ float shx(float v, int mask, int lane) { return __uint_as_float((unsigned)__builtin_amdgcn_ds_bpermute((lane ^ mask) << 2, (int)__float_as_uint(v))); }
__device__ __forceinline__ float shup(float v, int d, int lane) { return __uint_as_float((unsigned)__builtin_amdgcn_ds_bpermute((lane >= d ? lane - d : lane) << 2, (int)__float_as_uint(v))); }
#define N_LAUNCH_MODE 1
namespace pg8 {
#define PG8_LAS __attribute__((address_space(3)))
typedef unsigned short bf16_t;
typedef short bf16x8 __attribute__((ext_vector_type(8)));
typedef float f32x4 __attribute__((ext_vector_type(4)));
typedef unsigned u32x4 __attribute__((ext_vector_type(4)));
constexpr int BM = 256, BK = 64, HALF = 128, HTB = HALF * BK * 2  , STAGE_BYTES = 8 * HTB, NXCD = 8, WGM = 4;

__host__ __device__ __forceinline__ int lds_byte(int r, int c) { const int st = (r >> 4) * 2 + (c >> 5), rr = r & 15, cc = c & 31, ob = rr * 64 + cc * 2; return st * 1024 + (ob ^ (((ob >> 9) & 1) << 5)); }
__host__ __device__ __forceinline__ void stage_rc(int b, int& R, int& C) { const int st = b / 1024, sb = b % 1024, swz = sb ^ (((sb >> 9) & 1) << 5); R = (st >> 1) * 16 + swz / 64; C = (st & 1) * 32 + (swz % 64) / 2; }
__host__ __device__ __forceinline__ int perm32(int rho) { const int n = rho >> 4, i = rho & 15; return 8 * (i >> 2) + 4 * n + (i & 3); }

struct Unit { int pm, pn; };
struct Gemm { const bf16_t* A; const bf16_t* Bt; int M, N, K; };

struct StaticOrder {
    int nM, nN, nwg, G, c;
    __host__ __device__ void init(int M, int N, int G_, int c_) { nM = M / BM; nN = N / BM; nwg = nM * nN; G = G_; c = c_; }
    __host__ __device__ bool next(int i, Unit& u) const {
        const long L = (long)i * G + c; if (L >= nwg) return false;
        int wgid = (int)L; { const int q = nwg / NXCD, r = nwg % NXCD, xcd = wgid % NXCD, off = wgid / NXCD; wgid = (xcd < r ? xcd * (q + 1) : r * (q + 1) + (xcd - r) * q) + off; }
        const int nig = WGM * nN, gid = wgid / nig, fm = gid * WGM, gsz = (nM - fm) < WGM ? (nM - fm) : WGM;
        u.pm = fm + ((wgid % nig) % gsz); u.pn = (wgid % nig) / gsz; return true;
    }
    __device__ __forceinline__ void a_ready(const Unit&) const {}
    __device__ __forceinline__ void done(const Unit&) const {}
};

struct ListOrder2 {
    int nM0, n0, nM1, n1, G, c;
    __host__ __device__ void init(int M0, int N0, int M1, int N1, int G_, int c_) { nM0 = M0 / BM; n0 = nM0 * (N0 / BM); nM1 = M1 / BM; n1 = nM1 * (N1 / BM); G = G_; c = c_; }
    __host__ __device__ bool next(int i, Unit& u) const {
        int L = i * G + c; if (L >= n0 + n1) return false;
        if (L < n0) { u.pm = L % nM0; u.pn = L / nM0; } else { L -= n0; u.pm = L % nM1; u.pn = (L / nM1) | 0x10000; }
        return true;
    }
    __device__ __forceinline__ void a_ready(const Unit&) const {}
    __device__ __forceinline__ void done(const Unit&) const {}
};
struct ListOrder2G {
    int pb0, np0, n0, pb1, np1, n1, gs, j;
    __host__ __device__ void init(int pb0_, int np0_, int nN0, int pb1_, int np1_, int nN1, int gs_, int j_) { pb0 = pb0_; np0 = np0_; n0 = np0_ * nN0; pb1 = pb1_; np1 = np1_; n1 = np1_ * nN1; gs = gs_; j = j_; }
    __host__ __device__ bool next(int i, Unit& u) const {
        int L = i * gs + j; if (L >= n0 + n1) return false;
        if (L < n0) { u.pm = pb0 + L % np0; u.pn = L / np0; } else { L -= n0; u.pm = pb1 + L % np1; u.pn = (L / np1) | 0x10000; }
        return true;
    }
    __device__ __forceinline__ void a_ready(const Unit&) const {}
    __device__ __forceinline__ void done(const Unit&) const {}
};
__device__ __forceinline__ unsigned cvt_pk_bf16(float lo, float hi) { unsigned r; asm volatile("v_cvt_pk_bf16_f32 %0, %1, %2" : "=v"(r) : "v"(lo), "v"(hi)); return r; }
typedef float f32x2 __attribute__((ext_vector_type(2)));
#ifndef FP8_DIAG_NONSCALED
#define FP8_DIAG_NONSCALED 0
#endif
typedef int v4i_t __attribute__((ext_vector_type(4)));
typedef int v8i_t __attribute__((ext_vector_type(8)));
__device__ __forceinline__ v8i_t cat8(bf16x8 a, bf16x8 b) { return __builtin_shufflevector(__builtin_bit_cast(v4i_t, a), __builtin_bit_cast(v4i_t, b), 0, 1, 2, 3, 4, 5, 6, 7); }
template <class Epi, class Sched, bool ALIGN_EPI = false, bool SP2 = false, bool FP8 = false, bool MULTI = false>
__device__ __forceinline__ void gemm_phase(PG8_LAS unsigned char* lds, const Gemm g, const Sched& S, const Epi& E, const int wv, const Gemm g1 = Gemm{nullptr, nullptr, 0, 0, 0}) {
    const int tid = otid(wv), wid = wv, lane = tid & 63, wr = wid >> 2, wc = wid & 3, fr = lane & 15, fq = lane >> 4;
    unsigned voffA[2], voffB[2], vRA[2], vRB[2], vC[2];
#pragma unroll
    for (int i = 0; i < 2; ++i) { int R, C; stage_rc(tid * 16 + i * 8192, R, C); const int Rb = Epi::PERM ? ((R & ~31) + perm32(R & 31)) : R;
        vRA[i] = (unsigned)R * 2u; vRB[i] = (unsigned)Rb * 2u; vC[i] = (unsigned)C * 2u; }
    const size_t kstep = (size_t)(BK * 2);
#define PG8_VA(i) (MULTI ? vRA[i] * (unsigned)K + vC[i] : voffA[i])
#define PG8_VB(i) (MULTI ? vRB[i] * (unsigned)K + vC[i] : voffB[i])
#define PG8_VA2(i) (MULTI ? vRA[i] * (unsigned)K2 + vC[i] : voffA[i])
#define PG8_VB2(i) (MULTI ? vRB[i] * (unsigned)K2 + vC[i] : voffB[i])
#define PG8_GK(u) ((MULTI && ((u).pn >> 16)) ? g1.K : g.K)
#define PG8_GA(u) ((MULTI && ((u).pn >> 16)) ? (const char*)g1.A : (const char*)g.A)
#define PG8_GB(u) ((MULTI && ((u).pn >> 16)) ? (const char*)g1.Bt : (const char*)g.Bt)
    const unsigned ldsw = (unsigned)wid * 1024u; const unsigned ldsbase = (unsigned)__builtin_amdgcn_readfirstlane((int)((unsigned)(uintptr_t)lds + ldsw));
    const int aoff = lds_byte(wr * 64 + fr, fq * 8), boff = lds_byte(wc * 32 + fr, fq * 8);
#define PG8_SA(b, h) (((b) * 2 + (h)) * HTB)
#define PG8_SB(b, h) ((4 + (b) * 2 + (h)) * HTB)
#define PG8_STAGE(bufoff, gbase, voff) do { _Pragma("unroll") for (int _i = 0; _i < 2; ++_i) { unsigned keep_; \
        asm volatile("s_mov_b32 %0, m0\n\ts_add_u32 m0, %3, %4\n\ts_nop 2\n\tglobal_load_lds_dwordx4 %1, %2\n\ts_mov_b32 m0, %0"     \
            : "=&s"(keep_) : "v"(voff(_i)), "s"(uni64((const char*)(gbase))), "s"(ldsbase), "i"((bufoff) + _i * 8192) : "memory", "scc"); } } while (0)
#define PG8_LDA(dst, b, h) do { _Pragma("unroll") for (int m = 0; m < 4; ++m) { if constexpr (FP8) dst##8[m] = cat8(*(const PG8_LAS bf16x8*)(lds + PG8_SA(b, h) + aoff + m * 2048), *(const PG8_LAS bf16x8*)(lds + PG8_SA(b, h) + aoff + m * 2048 + 1024)); \
        else { _Pragma("unroll") for (int k = 0; k < 2; ++k) dst[m][k] = *(const PG8_LAS bf16x8*)(lds + PG8_SA(b, h) + aoff + m * 2048 + k * 1024); } } } while (0)
#define PG8_LDB(dst, b, h) do { _Pragma("unroll") for (int n = 0; n < 2; ++n) { if constexpr (FP8) dst##8[n] = cat8(*(const PG8_LAS bf16x8*)(lds + PG8_SB(b, h) + boff + n * 2048), *(const PG8_LAS bf16x8*)(lds + PG8_SB(b, h) + boff + n * 2048 + 1024)); \
        else { _Pragma("unroll") for (int k = 0; k < 2; ++k) dst[n][k] = *(const PG8_LAS bf16x8*)(lds + PG8_SB(b, h) + boff + n * 2048 + k * 1024); } } } while (0)
#define PG8_MMA(ai, bj, At, Bt) do { __builtin_amdgcn_s_setprio(1); _Pragma("unroll") for (int m = 0; m < 4; ++m) _Pragma("unroll") for (int n = 0; n < 2; ++n) { \
        if constexpr (FP8) { if constexpr (FP8_DIAG_NONSCALED) { _Pragma("unroll") for (int q_ = 0; q_ < 4; ++q_) { \
            const long bq_ = ((long)(unsigned)Bt##8[n][2 * q_ + 1] << 32) | (unsigned)Bt##8[n][2 * q_], aq_ = ((long)(unsigned)At##8[m][2 * q_ + 1] << 32) | (unsigned)At##8[m][2 * q_]; \
            acc[ai][bj][m][n] = __builtin_amdgcn_mfma_f32_16x16x32_fp8_fp8(bq_, aq_, acc[ai][bj][m][n], 0, 0, 0); } } \
          else asm volatile("v_mfma_scale_f32_16x16x128_f8f6f4 %0, %1, %2, %0, %3, %3 op_sel_hi:[0,0,0]" : "+v"(acc[ai][bj][m][n]) : "v"(Bt##8[n]), "v"(At##8[m]), "v"(scl1)); }   \
        else { _Pragma("unroll") for (int k = 0; k < 2; ++k) acc[ai][bj][m][n] = __builtin_amdgcn_mfma_f32_16x16x32_bf16(Bt[n][k], At[m][k], acc[ai][bj][m][n], 0, 0, 0); } } __builtin_amdgcn_s_setprio(0); } while (0)
#define PG8_WAIT_V(n) asm volatile("s_waitcnt vmcnt(" #n ")" ::: "memory")
#define PG8_WAIT_L(n) asm volatile("s_waitcnt lgkmcnt(" #n ")" ::: "memory")
#define PG8_BAR __builtin_amdgcn_s_barrier()
#define PG8_SCHED __builtin_amdgcn_sched_barrier(0)
    Unit cur, nxt; int ui = 0;
    if (!S.next(0, cur)) return;
    int K = PG8_GK(cur), nt = K / BK;
    size_t hstep = (size_t)HALF * K * 2;
#pragma unroll
    for (int i = 0; i < 2; ++i) { voffA[i] = vRA[i] * (unsigned)K + vC[i]; voffB[i] = vRB[i] * (unsigned)K + vC[i]; }
    f32x4 acc[2][2][4][2];
#pragma unroll
    for (int a = 0; a < 2; ++a)
#pragma unroll
        for (int b = 0; b < 2; ++b)
#pragma unroll
            for (int m = 0; m < 4; ++m)
#pragma unroll
                for (int n = 0; n < 2; ++n) acc[a][b][m][n] = (f32x4){0.f, 0.f, 0.f, 0.f};
    bf16x8 At[4][2], B0[2][2], B1[2][2]; v8i_t At8[4], B08[2], B18[2]; int scl1 = 0x7F7F7F7F; asm volatile("" : "+v"(scl1));
    const char* cA = PG8_GA(cur) + (size_t)cur.pm * 2 * hstep; const char* cB = PG8_GB(cur) + (size_t)(cur.pn & 0xffff) * 2 * hstep;
    S.a_ready(cur);
    if constexpr (SP2) {
        PG8_STAGE(PG8_SB(0, 0), cB, PG8_VB); PG8_STAGE(PG8_SB(0, 1), cB + hstep, PG8_VB); PG8_STAGE(PG8_SA(0, 0), cA, PG8_VA); PG8_STAGE(PG8_SA(0, 1), cA + hstep, PG8_VA);
        if (wr == 1) PG8_BAR;
        PG8_WAIT_V(2); PG8_BAR;
        PG8_STAGE(PG8_SB(1, 0), cB + kstep, PG8_VB); PG8_STAGE(PG8_SA(1, 0), cA + kstep, PG8_VA); PG8_STAGE(PG8_SB(1, 1), cB + hstep + kstep, PG8_VB);
        PG8_WAIT_V(6); PG8_BAR;
    } else {
        PG8_STAGE(PG8_SB(0, 0), cB, PG8_VB); PG8_STAGE(PG8_SA(0, 0), cA, PG8_VA); PG8_STAGE(PG8_SB(0, 1), cB + hstep, PG8_VB); PG8_STAGE(PG8_SA(0, 1), cA + hstep, PG8_VA);
        if (wr == 1) PG8_BAR;
        PG8_WAIT_V(4); PG8_BAR;
        PG8_STAGE(PG8_SB(1, 0), cB + kstep, PG8_VB); PG8_STAGE(PG8_SA(1, 0), cA + kstep, PG8_VA); PG8_STAGE(PG8_SB(1, 1), cB + hstep + kstep, PG8_VB);
        PG8_WAIT_V(6); PG8_BAR;
    }
    for (;;) {
        const bool has_next = S.next(ui + 1, nxt);
        int Kn = K; size_t hstepn = hstep;
        if constexpr (MULTI) { if (has_next) { Kn = PG8_GK(nxt); hstepn = (size_t)HALF * Kn * 2; } }
        const char* nA = has_next ? PG8_GA(nxt) + (size_t)nxt.pm * 2 * hstepn : cA; const char* nB = has_next ? PG8_GB(nxt) + (size_t)(nxt.pn & 0xffff) * 2 * hstepn : cB;
#pragma unroll 1
        for (int t = 0; t < nt; t += 2) {
            const bool last = (t == nt - 2);
            const char* a1 = cA + (size_t)(t + 1) * kstep;
            const char* a2 = last ? nA : cA + (size_t)(t + 2) * kstep; const char* b2 = last ? nB : cB + (size_t)(t + 2) * kstep;
            const char* a3 = a2 + kstep; const char* b3 = b2 + kstep;
            const int K2 = (MULTI && last) ? Kn : K; const size_t hs2 = (MULTI && last) ? hstepn : hstep;
            if (last && has_next) S.a_ready(nxt);
            if constexpr (SP2) {
            PG8_LDB(B0, 0, 0); PG8_LDB(B1, 0, 1); PG8_SCHED; PG8_LDA(At, 0, 0); PG8_STAGE(PG8_SA(1, 1), a1 + hstep, PG8_VA);
            PG8_WAIT_V(8); PG8_WAIT_L(0); PG8_BAR; PG8_MMA(0, 0, At, B0); PG8_MMA(0, 1, At, B1); PG8_BAR; PG8_SCHED;
            PG8_LDA(At, 0, 1); PG8_STAGE(PG8_SB(0, 0), b2, PG8_VB2); PG8_STAGE(PG8_SB(0, 1), b2 + hs2, PG8_VB2); PG8_STAGE(PG8_SA(0, 0), a2, PG8_VA2);
            PG8_WAIT_V(8); PG8_WAIT_L(0); PG8_BAR; PG8_MMA(1, 0, At, B0); PG8_MMA(1, 1, At, B1); PG8_BAR; PG8_SCHED;
            PG8_LDB(B0, 1, 0); PG8_LDB(B1, 1, 1); PG8_SCHED; PG8_LDA(At, 1, 0); PG8_STAGE(PG8_SA(0, 1), a2 + hs2, PG8_VA2);
            PG8_WAIT_V(8); PG8_WAIT_L(0); PG8_BAR; PG8_MMA(0, 0, At, B0); PG8_MMA(0, 1, At, B1); PG8_BAR; PG8_SCHED;
            PG8_LDA(At, 1, 1); PG8_STAGE(PG8_SB(1, 0), b3, PG8_VB2); PG8_STAGE(PG8_SB(1, 1), b3 + hs2, PG8_VB2); PG8_STAGE(PG8_SA(1, 0), a3, PG8_VA2);
            PG8_WAIT_V(8); PG8_WAIT_L(0); PG8_BAR; PG8_MMA(1, 0, At, B0); PG8_MMA(1, 1, At, B1); PG8_BAR; PG8_SCHED;
            } else {
            PG8_LDB(B0, 0, 0); PG8_SCHED; PG8_LDA(At, 0, 0); PG8_STAGE(PG8_SA(1, 1), a1 + hstep, PG8_VA);
            PG8_WAIT_L(8); PG8_BAR; PG8_WAIT_L(0); PG8_MMA(0, 0, At, B0); PG8_BAR; PG8_SCHED;
            PG8_LDB(B1, 0, 1); PG8_STAGE(PG8_SB(0, 0), b2, PG8_VB2);
            PG8_BAR; PG8_WAIT_L(0); PG8_MMA(0, 1, At, B1); PG8_BAR;
            PG8_LDA(At, 0, 1); PG8_STAGE(PG8_SA(0, 0), a2, PG8_VA2);
            PG8_BAR; PG8_WAIT_L(0); PG8_MMA(1, 0, At, B0); PG8_BAR; PG8_SCHED;
            PG8_STAGE(PG8_SB(0, 1), b2 + hs2, PG8_VB2);
            PG8_WAIT_V(6); PG8_BAR; PG8_MMA(1, 1, At, B1); PG8_BAR;
            PG8_LDB(B0, 1, 0); PG8_SCHED; PG8_LDA(At, 1, 0); PG8_STAGE(PG8_SA(0, 1), a2 + hs2, PG8_VA2);
            PG8_WAIT_L(8); PG8_BAR; PG8_WAIT_L(0); PG8_MMA(0, 0, At, B0); PG8_BAR; PG8_SCHED;
            PG8_LDB(B1, 1, 1); PG8_STAGE(PG8_SB(1, 0), b3, PG8_VB2);
            PG8_BAR; PG8_WAIT_L(0); PG8_MMA(0, 1, At, B1); PG8_BAR;
            PG8_LDA(At, 1, 1); PG8_STAGE(PG8_SA(1, 0), a3, PG8_VA2);
            PG8_BAR; PG8_WAIT_L(0); PG8_MMA(1, 0, At, B0); PG8_BAR; PG8_SCHED;
            PG8_STAGE(PG8_SB(1, 1), b3 + hs2, PG8_VB2);
            PG8_WAIT_V(6); PG8_BAR; PG8_MMA(1, 1, At, B1); PG8_BAR;
            }
        }
        if constexpr (FP8) asm volatile("s_nop 15\n\ts_nop 15" ::: "memory");
        if constexpr (ALIGN_EPI) { if (wr == 0) PG8_BAR; }
        if constexpr (!Epi::AFTER_DRAIN) { E(acc, cur, wr, wc, fr, fq); if constexpr (Epi::REP) { asm volatile("" ::: "memory"); const Epi E2_ = E.rep(); E2_(acc, cur, wr, wc, fr, fq); } S.done(cur); }
        if (!has_next) break;
#pragma unroll
        for (int a = 0; a < 2; ++a)
#pragma unroll
            for (int b = 0; b < 2; ++b)
#pragma unroll
                for (int m = 0; m < 4; ++m)
#pragma unroll
                    for (int n = 0; n < 2; ++n) acc[a][b][m][n] = (f32x4){0.f, 0.f, 0.f, 0.f};
        cur = nxt; cA = nA; cB = nB; ++ui;
        if constexpr (MULTI) { K = Kn; nt = K / BK; hstep = hstepn; }
        if constexpr (ALIGN_EPI) { if (wr == 1) PG8_BAR; }
    }
    PG8_WAIT_V(0);
    if constexpr (!ALIGN_EPI) { if (wr == 0) PG8_BAR; }
    PG8_BAR;
    if constexpr (Epi::AFTER_DRAIN) { E.fused(acc, cur, wr, wc, fr, fq, lds, wid, lane); S.done(cur); }
#undef PG8_VA
#undef PG8_VB
#undef PG8_VA2
#undef PG8_VB2
#undef PG8_GK
#undef PG8_GA
#undef PG8_GB
#undef PG8_SA
#undef PG8_SB
#undef PG8_STAGE
#undef PG8_LDA
#undef PG8_LDB
#undef PG8_MMA
#undef PG8_WAIT_V
#undef PG8_WAIT_L
#undef PG8_BAR
#undef PG8_SCHED
}
}
#define GAS __attribute__((address_space(1)))
#define LAS __attribute__((address_space(3)))
typedef unsigned short bf16;
typedef unsigned v4u __attribute__((ext_vector_type(4)));
typedef float f32x4 __attribute__((ext_vector_type(4)));
typedef short bf16x8 __attribute__((ext_vector_type(8)));
typedef GAS unsigned gu32;
typedef GAS unsigned long long gu64;
#define RLX_AGENT __ATOMIC_RELAXED, __HIP_MEMORY_SCOPE_AGENT
#define LDS_WAIT() asm volatile("s_waitcnt lgkmcnt(0)" ::: "memory")
#define VM_WAIT() asm volatile("s_waitcnt vmcnt(0)" ::: "memory")
__device__ __forceinline__ unsigned long long rt() { return __builtin_amdgcn_s_memrealtime(); }
__device__ __forceinline__ unsigned f2bf(float f) { unsigned u = __builtin_bit_cast(unsigned, f); return (u + 0x7fffu + ((u >> 16) & 1u)) >> 16; }
__device__ __forceinline__ unsigned pk2(float lo, float hi) { unsigned r; asm("v_cvt_pk_bf16_f32 %0, %1, %2" : "=v"(r) : "v"(lo), "v"(hi)); return r; }

#define XB_TMO      128
#define XB_XCNT(j)  (256  + 64 * (j))
#define XB_XSUB(j)  (1280 + 64 * (j))
#define XB_XGEN(j)  (2304 + 64 * (j))
#define XB_TOP      3328
#define XB_TOPGEN   3392
#define XCD_BAR_WORDS 3456
#define XB_SPIN_CAP (1u << 18)

__device__ __forceinline__ unsigned xb_ld(unsigned* p)              { return __hip_atomic_load(p, __ATOMIC_RELAXED, __HIP_MEMORY_SCOPE_AGENT); }
__device__ __forceinline__ unsigned xb_add(unsigned* p, unsigned v) { return __hip_atomic_fetch_add(p, v, __ATOMIC_RELAXED, __HIP_MEMORY_SCOPE_AGENT); }
__device__ __forceinline__ unsigned xb_xcc_id() { return (unsigned)__builtin_amdgcn_s_getreg((3 << 11) | 20) & 0xFu; }
#define XB_SPIN(cond, bar) do { unsigned _sp = 0; while (cond) { __builtin_amdgcn_s_sleep(1); \
    if ((++_sp & 255u) == 0u) { if (xb_ld(&(bar)[XB_TMO])) break; if (_sp > XB_SPIN_CAP) { atomicAdd(&(bar)[XB_TMO], 1u); break; } } } } while (0)

struct XcdBarrier {
    unsigned* bar; unsigned x; int wv;
    volatile LAS unsigned* st;
};

__device__ __forceinline__ XcdBarrier xcd_barrier_post(unsigned* bar, volatile LAS unsigned* st, const int wv) {
    XcdBarrier b; b.bar = bar; b.x = xb_xcc_id(); b.st = st; b.wv = wv;
    if (wv == 0 && olane() == 0) (void)xb_add(&bar[XB_XCNT(b.x)], 1u);
    return b;
}
__device__ __forceinline__ void xcd_barrier_complete(unsigned* bar, unsigned x, unsigned& nloc, unsigned& nx) {
    const unsigned G = gridDim.x * gridDim.y * gridDim.z;
    unsigned sum, cnt, mine, sp = 0u;
    for (;;) {
        sum = 0u; cnt = 0u; mine = 0u;
#pragma unroll
        for (unsigned j = 0; j < 16; ++j) { const unsigned c = xb_ld(&bar[XB_XCNT(j)]); sum += c; cnt += (c > 0u) ? 1u : 0u; mine = (j == x) ? c : mine; }
        if (sum == G) break;
        __builtin_amdgcn_s_sleep(1);
        if ((++sp & 255u) == 0u) { if (xb_ld(&bar[XB_TMO])) break; if (sp > XB_SPIN_CAP) { atomicAdd(&bar[XB_TMO], 1u); break; } }
    }
    nloc = mine > 0u ? mine : 1u; nx = cnt > 0u ? cnt : 1u;
}

__device__ __forceinline__ void xcd_barrier(const XcdBarrier& b) {
    asm volatile("s_waitcnt vmcnt(0)" ::: "memory");
    __syncthreads();
    if (b.wv == 0 && olane() == 0) {
        unsigned* bar = b.bar;
        __builtin_amdgcn_s_waitcnt(0);
        unsigned nloc = b.st[0], nx = b.st[1];
        if (nloc == 0u) { xcd_barrier_complete(bar, b.x, nloc, nx); b.st[0] = nloc; b.st[1] = nx; }
        const unsigned old = xb_add(&bar[XB_XSUB(b.x)], 1u);
        const unsigned gen = old / nloc;
        if (old + 1u == (gen + 1u) * nloc) {
            __builtin_amdgcn_fence(__ATOMIC_RELEASE, "agent");
            asm volatile("s_waitcnt vmcnt(0)" ::: "memory");
            const unsigned og = xb_add(&bar[XB_TOP], 1u);
            const unsigned tg = og / nx;
            if (og + 1u == (tg + 1u) * nx) xb_add(&bar[XB_TOPGEN], 1u);
            else XB_SPIN(xb_ld(&bar[XB_TOPGEN]) == tg, bar);
            __builtin_amdgcn_fence(__ATOMIC_ACQUIRE, "agent");
            xb_add(&bar[XB_XGEN(b.x)], 1u);
            asm volatile("s_waitcnt vmcnt(0)" ::: "memory");
        } else {
            XB_SPIN(xb_ld(&bar[XB_XGEN(b.x)]) == gen, bar);
            __builtin_amdgcn_fence(__ATOMIC_ACQUIRE, "agent");
            asm volatile("s_waitcnt vmcnt(0)" ::: "memory");
        }
    }
    __syncthreads();
}

struct GrpBarrier { unsigned* cnt; unsigned* tmo; unsigned target, step; int fast, wv; };
__device__ __forceinline__ void grp_barrier(GrpBarrier& gb) {
    asm volatile("s_waitcnt vmcnt(0)" ::: "memory");
    __syncthreads();
    gb.target += gb.step;
    if (gb.wv == 0 && olane() == 0) {
        __builtin_amdgcn_s_waitcnt(0);
        if (!gb.fast) { __builtin_amdgcn_fence(__ATOMIC_RELEASE, "agent"); asm volatile("s_waitcnt vmcnt(0)" ::: "memory"); }
        (void)xb_add(gb.cnt, 1u);
        { unsigned _sp = 0; while (xb_ld(gb.cnt) < gb.target) { __builtin_amdgcn_s_sleep(1);
            if ((++_sp & 255u) == 0u) { if (xb_ld(gb.tmo)) break; if (_sp > XB_SPIN_CAP) { atomicAdd(gb.tmo, 1u); break; } } } }
        __builtin_amdgcn_fence(__ATOMIC_ACQUIRE, "agent");
        asm volatile("s_waitcnt vmcnt(0)" ::: "memory");
    }
    __syncthreads();
}

typedef float f32x16 __attribute__((ext_vector_type(16)));
typedef short s16x4 __attribute__((ext_vector_type(4)));
typedef float f32x2v __attribute__((ext_vector_type(2)));

constexpr int M = 16384, DM = 2048, SEQ = 2048, NB = 8, NPROJ = 5120, DFF = 5632, MEMR = 2048, NIN = 4932;
constexpr float EPS = 1e-6f;
constexpr float LOG2E = 1.4426950408889634f;
constexpr float QS128 = 0.08838834764831845f * LOG2E;
constexpr float QS192 = 0.07216878364870322f * LOG2E;
constexpr int NWAVES = 8;

constexpr int PC_FQ = 0, PC_FK = 512, PC_FV = 1024, PC_MCQ = 1536, PC_MCKV = 2048, PC_MKR = 2304, PC_FF = 2368,
              PC_GU = 2560, PC_GV = 3072, PC_BQ = 3584, PC_BK = 4096, PC_BV = 4608;

constexpr size_t MiB = 1u << 20;
constexpr size_t WS_CTL = 683 * MiB + 1536 * 1024;
constexpr size_t WS_W = 1 * MiB, WL_STRIDE = 104 * MiB;
constexpr size_t WO_IN = 0, WO_OUT = 20 * MiB, WO_XQ = 28 * MiB, WO_XKV = 30 * MiB, WO_XO = 34 * MiB, WO_GU = 36 * MiB, WO_D = 80 * MiB,
                 WO_UQ = 102 * MiB, WO_UKV = 102 * MiB + 768 * 1024;
constexpr size_t WS_XB = 209 * MiB, WS_PROJ = 273 * MiB, WS_OMIX = 449 * MiB, WS_CQN = 513 * MiB, WS_CKVN = 529 * MiB, WS_QM = 537 * MiB,
                 WS_KVM = 561 * MiB, WS_XQ = 593 * MiB, WS_XO = 609 * MiB, WS_XKV = 625 * MiB, WS_MEMB = 633 * MiB, WS_FKA = 641 * MiB,
                 WS_BQA = 643 * MiB, WS_BKA = 645 * MiB, WS_KPE = 646 * MiB, WS_LF = 648 * MiB, WS_LFSUM = 648 * MiB + 512 * 1024,
                 WS_ROPE = 649 * MiB, WS_FQA = 649 * MiB + 512 * 1024, WS_MEMSS = 649 * MiB + 768 * 1024, WS_GSTAT = 648 * MiB + 768 * 1024, WS_FBIAS = 648 * MiB + 256 * 1024  , WS_TRIL = 650 * MiB, WS_X8 = 651 * MiB, WS_ACC = 683 * MiB  , WS_END = 685 * MiB; constexpr size_t WS_X8_OLD_ALIAS = 513 * MiB  ;
constexpr int CW_TMO = 0, CW_BAR = 4096  , CW_Q = 8192  , CW_GB = 16384  , CW_COLO = 16384 + 512  ;

struct Params { const float* in[31]; float* out; unsigned char* ws; int ph_lo, ph_hi; };

typedef const float* const __attribute__((address_space(4)))* KIN;
struct Frame {
    LAS unsigned char* lds;
    int tid, lane, wave, vcu, G;
    KIN in; float* out; unsigned char* ws;
};

template <int CTRL> __device__ __forceinline__ float dppf(float v) { return __builtin_bit_cast(float, __builtin_amdgcn_update_dpp(0, __builtin_bit_cast(int, v), CTRL, 0xF, 0xF, true)); }
__device__ __forceinline__ float sum32(float v) { const unsigned x = __builtin_bit_cast(unsigned, v); auto r = __builtin_amdgcn_permlane32_swap(x, x, false, false); return __builtin_bit_cast(float, (unsigned)r[0]) + __builtin_bit_cast(float, (unsigned)r[1]); }
__device__ __forceinline__ float max32(float v) { const unsigned x = __builtin_bit_cast(unsigned, v); auto r = __builtin_amdgcn_permlane32_swap(x, x, false, false); return fmaxf(__builtin_bit_cast(float, (unsigned)r[0]), __builtin_bit_cast(float, (unsigned)r[1])); }
__device__ __forceinline__ float sum16(float v) { const unsigned x = __builtin_bit_cast(unsigned, v); auto r = __builtin_amdgcn_permlane16_swap(x, x, false, false); return __builtin_bit_cast(float, (unsigned)r[0]) + __builtin_bit_cast(float, (unsigned)r[1]); }
__device__ __forceinline__ float grp8_sum(float v) { v += dppf<0xB1>(v); v += dppf<0x4E>(v); v += dppf<0x141>(v); return v; }
__device__ __forceinline__ float grp16_sum(float v) { v = grp8_sum(v); v += dppf<0x140>(v); return v; }
__device__ __forceinline__ float wave_sum(float v) { return sum32(sum16(grp16_sum(v))); }
__device__ __forceinline__ float bf2f(unsigned short b) { return __uint_as_float(((unsigned)b) << 16); }
__device__ __forceinline__ float bflo(unsigned w) { return __uint_as_float(w << 16); }
__device__ __forceinline__ float bfhi(unsigned w) { return __uint_as_float(w & 0xffff0000u); }
__device__ __forceinline__ void unpack8(const v4u raw, float (&x)[8]) { x[0] = bflo(raw.x); x[1] = bfhi(raw.x); x[2] = bflo(raw.y); x[3] = bfhi(raw.y); x[4] = bflo(raw.z); x[5] = bfhi(raw.z); x[6] = bflo(raw.w); x[7] = bfhi(raw.w); }
__device__ __forceinline__ v4u pack8f(const float (&x)[8]) { v4u o; o.x = pk2(x[0], x[1]); o.y = pk2(x[2], x[3]); o.z = pk2(x[4], x[5]); o.w = pk2(x[6], x[7]); return o; }
__device__ __forceinline__ float fp8clamp(float v) { return __builtin_amdgcn_fmed3f(v, -448.f, 448.f); }
__device__ __forceinline__ uint2 pack8_fp8(const float (&x)[8], float sc) {
    unsigned a = 0, c = 0;
    a = __builtin_amdgcn_cvt_pk_fp8_f32(fp8clamp(x[0] * sc), fp8clamp(x[1] * sc), a, false); a = __builtin_amdgcn_cvt_pk_fp8_f32(fp8clamp(x[2] * sc), fp8clamp(x[3] * sc), a, true);
    c = __builtin_amdgcn_cvt_pk_fp8_f32(fp8clamp(x[4] * sc), fp8clamp(x[5] * sc), c, false); c = __builtin_amdgcn_cvt_pk_fp8_f32(fp8clamp(x[6] * sc), fp8clamp(x[7] * sc), c, true);
    uint2 r; r.x = a; r.y = c; return r;
}
__device__ __forceinline__ float gelu_tanh(float x) {
    const float u = 0.7978845608028654f * (x + 0.044715f * x * x * x);
    const float e = __builtin_amdgcn_exp2f(u * 2.8853900817779268f);
    return x * (1.f - __builtin_amdgcn_rcpf(e + 1.f));
}
__device__ __forceinline__ float silu_f(float x) { return x * __builtin_amdgcn_rcpf(1.f + __builtin_amdgcn_exp2f(x * -1.4426950408889634f)); }
__device__ __forceinline__ float log_sigmoid_f(float x) { return fminf(x, 0.f) - log1pf(expf(-fabsf(x))); }

__device__ __forceinline__ bf16* wptr(unsigned char* ws, int l, size_t off) { return (bf16*)(ws + WS_W + (size_t)l * WL_STRIDE + off); }
typedef unsigned long long u64;
constexpr float SS_FIX = 1048576.f, SS_INV = 1.f / 1048576.f, KM_FIX = 1073741824.f, KM_INV = 1.f / 1073741824.f;
__device__ __forceinline__ u64* ss_ptr(unsigned char* ws, int k) { return (u64*)(ws + WS_ACC) + (size_t)k * M; }

__device__ __forceinline__ int queue_next(gu32* ctr, LAS unsigned* slot, const int wv) {
    __syncthreads();
    if (wv == 0 && olane() == 0) *slot = __hip_atomic_fetch_add(ctr, 1u, __ATOMIC_RELAXED, __HIP_MEMORY_SCOPE_AGENT);
    __syncthreads();
    return (int)*slot;
}

#ifndef REP_EPI_SCALE
#define REP_EPI_SCALE 0
#endif
#ifndef REP_EPI_SWIGLU
#define REP_EPI_SWIGLU 0
#endif
struct EpiScale {
    static constexpr bool PERM = true, AFTER_DRAIN = false, REP = REP_EPI_SCALE;
    __device__ __forceinline__ EpiScale rep() const { return *this; }
    bf16* O; int ldc; const u64* ss; float inv_kn; float oscale;
    __device__ __forceinline__ void operator()(const pg8::f32x4 (&acc)[2][2][4][2], const pg8::Unit& u, int wr_, int wc_, int fr_, int fq_) const {
        const int ot_ = olane(), wr = wr_, wc = wc_, fr = ot_ & 15, fq = ot_ >> 4;
        const int row0 = u.pm * 256 + wr * 64 + fr, col0 = u.pn * 256 + wc * 32 + 8 * fq;
        float scv[2][4];
#pragma unroll
        for (int ai = 0; ai < 2; ++ai)
#pragma unroll
            for (int m = 0; m < 4; ++m) scv[ai][m] = ss ? (float)ss[row0 + ai * 128 + m * 16] : 0.f;
#pragma unroll
        for (int ai = 0; ai < 2; ++ai)
#pragma unroll
            for (int m = 0; m < 4; ++m) {
                const int row = row0 + ai * 128 + m * 16;
                const float sc = ss ? rsqrtf(scv[ai][m] * (SS_INV * inv_kn) + EPS) * oscale : oscale;
                bf16* rowp = O + (size_t)row * ldc + col0;
#pragma unroll
                for (int bj = 0; bj < 2; ++bj) {
                    const pg8::f32x4 v0 = acc[ai][bj][m][0] * sc, v1 = acc[ai][bj][m][1] * sc;
                    v4u w; w.x = pg8::cvt_pk_bf16(v0[0], v0[1]); w.y = pg8::cvt_pk_bf16(v0[2], v0[3]); w.z = pg8::cvt_pk_bf16(v1[0], v1[1]); w.w = pg8::cvt_pk_bf16(v1[2], v1[3]);
                    *(v4u*)(rowp + bj * 128) = w;
                }
            }
    }
};
struct EpiScale2 {
    static constexpr bool PERM = true, AFTER_DRAIN = false, REP = false;
    EpiScale e0, e1;
    __device__ __forceinline__ void operator()(const pg8::f32x4 (&acc)[2][2][4][2], const pg8::Unit& u, int wr, int wc, int fr, int fq) const { const EpiScale e = (u.pn >> 16) ? e1 : e0; pg8::Unit v; v.pm = u.pm; v.pn = u.pn & 0xffff; e(acc, v, wr, wc, fr, fq); }
};
#ifndef XATT_FP8
#define XATT_FP8 1
#endif
#ifndef FFN_FP8
#define FFN_FP8 3
#endif
constexpr float X8_SCALE = 4.f;
#ifndef REP_EPI_RESID
#define REP_EPI_RESID 0
#endif
struct EpiResid2 {
    static constexpr bool PERM = true, AFTER_DRAIN = false, REP = REP_EPI_RESID != 0;
    bf16* xb; u64* ssn; unsigned char* x8; float* outf; float ascale;
    __device__ __forceinline__ EpiResid2 rep() const { EpiResid2 e = *this; if (!outf) { e.ascale = 0.f; e.ssn = nullptr; } return e; }
    __device__ __forceinline__ void operator()(const pg8::f32x4 (&acc)[2][2][4][2], const pg8::Unit& u, int wr_, int wc_, int fr_, int fq_) const {
        const int ot_ = olane(), wr = wr_, wc = wc_, fr = ot_ & 15, fq = ot_ >> 4;
        const int row0 = u.pm * 256 + wr * 64 + fr, col0 = u.pn * 256 + wc * 32 + 8 * fq;
        v4u xin[2][2][2];
#define RESID_LOAD(b_) do { _Pragma("unroll") for (int mm = 0; mm < 2; ++mm) _Pragma("unroll") for (int bj = 0; bj < 2; ++bj) \
            xin[(b_) & 1][mm][bj] = *(const v4u*)(xb + (size_t)(row0 + ((b_) >> 1) * 128 + (2 * ((b_) & 1) + mm) * 16) * DM + col0 + bj * 128); } while (0)
        RESID_LOAD(0);
#pragma unroll
        for (int b = 0; b < 4; ++b) {
            if (b + 1 < 4) RESID_LOAD(b + 1);
            const int ai = b >> 1;
#pragma unroll
            for (int mm = 0; mm < 2; ++mm) {
                const int m = 2 * (b & 1) + mm;
                const int row = row0 + ai * 128 + m * 16; float q = 0.f;
#pragma unroll
                for (int bj = 0; bj < 2; ++bj) {
                    const size_t idx = (size_t)row * DM + col0 + bj * 128;
                    float x[8]; unpack8(xin[b & 1][mm][bj], x);
#pragma unroll
                    for (int e = 0; e < 4; ++e) { x[e] += acc[ai][bj][m][0][e] * ascale; x[4 + e] += acc[ai][bj][m][1][e] * ascale; }
                    if (!outf) *(v4u*)(xb + idx) = pack8f(x);
                    if (outf) { __builtin_nontemporal_store((pg8::f32x4){x[0], x[1], x[2], x[3]}, (pg8::f32x4*)(outf + idx)); __builtin_nontemporal_store((pg8::f32x4){x[4], x[5], x[6], x[7]}, (pg8::f32x4*)(outf + idx + 4)); }
                    if (x8) *(uint2*)(x8 + idx) = pack8_fp8(x, X8_SCALE);
#pragma unroll
                    for (int e = 0; e < 8; ++e) q += x[e] * x[e];
                }
                q = sum32(sum16(q));
                if (fq == 0 && !outf && ssn) atomicAdd(ssn + row, (u64)(q * SS_FIX));
            }
        }
#undef RESID_LOAD
    }
};

constexpr float W8_SCALE = 256.f, ACT8_SCALE = 8.f, XO8_SCALE = 32.f;
template <bool OUT8> struct EpiSwiGLUx {
    static constexpr bool PERM = true, AFTER_DRAIN = false, REP = REP_EPI_SWIGLU;
    __device__ __forceinline__ EpiSwiGLUx rep() const { return *this; }
    void* O; const u64* ss; float insc;
    __device__ __forceinline__ void operator()(const pg8::f32x4 (&acc)[2][2][4][2], const pg8::Unit& u, int wr_, int wc_, int fr_, int fq_) const {
        typedef float f2 __attribute__((ext_vector_type(2)));
        const int ot_ = olane(), wr = wr_, wc = wc_, fr = ot_ & 15, fq = ot_ >> 4;
        const int row0 = u.pm * 256 + wr * 64 + fr, col0 = u.pn * 128 + wc * 32 + 8 * fq;
        float scv[2][4];
#pragma unroll
        for (int ai = 0; ai < 2; ++ai)
#pragma unroll
            for (int m = 0; m < 4; ++m) scv[ai][m] = (float)ss[row0 + ai * 128 + m * 16];
#pragma unroll
        for (int ai = 0; ai < 2; ++ai)
#pragma unroll
            for (int m = 0; m < 4; ++m) {
                const int row = row0 + ai * 128 + m * 16;
                const float sc = rsqrtf(scv[ai][m] * (SS_INV / DM) + EPS) * insc;
                const float nsl = sc * -1.4426950408889634f, c2 = OUT8 ? sc * sc * ACT8_SCALE : sc * sc;
                float o[8];
#pragma unroll
                for (int n = 0; n < 2; ++n)
#pragma unroll
                    for (int p = 0; p < 2; ++p) {
                        const f2 ga = {acc[ai][0][m][n][2 * p], acc[ai][0][m][n][2 * p + 1]}, ua = {acc[ai][1][m][n][2 * p], acc[ai][1][m][n][2 * p + 1]};
                        const f2 pr = ga * ua, t = ga * nsl;
                        f2 ex; ex.x = __builtin_amdgcn_exp2f(t.x); ex.y = __builtin_amdgcn_exp2f(t.y);
                        const f2 d = ex + 1.f; f2 r; r.x = __builtin_amdgcn_rcpf(d.x); r.y = __builtin_amdgcn_rcpf(d.y);
                        const f2 out = (pr * r) * c2;
                        o[n * 4 + 2 * p] = out.x; o[n * 4 + 2 * p + 1] = out.y;
                    }
                if constexpr (OUT8) *(uint2*)((unsigned char*)O + (size_t)row * DFF + col0) = pack8_fp8(o, 1.f);
                else *(v4u*)((bf16*)O + (size_t)row * DFF + col0) = pack8f(o);
            }
    }
};
struct WItem { const float* W; const float* gain; bf16* WT; int Nsrc, K, k0, srcc, valid, R0, f8; };
constexpr int ITEMS_L = 5120 + 2048 + 512 + 1024 + 512 + 11264 + 5632 + 192 + 128;
__device__ __forceinline__ WItem p0_decode(Frame& F, int git) {
    const int l = git >= ITEMS_L ? 1 : 0; int r = git - l * ITEMS_L;
    WItem d; d.gain = nullptr; d.f8 = 0; int ND, mode = 0;
    if (r < 5120) { d.W = F.in[3] + (size_t)l * DM * NIN; d.K = DM; d.Nsrc = NIN; ND = NPROJ; d.WT = wptr(F.ws, l, WO_IN); d.gain = F.in[2] + l * DM; mode = 1; }
    else if ((r -= 5120) < 2048) { d.W = F.in[20] + (size_t)l * DM * DM; d.K = DM; d.Nsrc = DM; ND = DM; d.WT = wptr(F.ws, l, WO_OUT); }
    else if ((r -= 2048) < 512) { d.W = F.in[23] + (size_t)l * DM * 512; d.K = DM; d.Nsrc = 512; ND = 512; d.WT = wptr(F.ws, l, WO_XQ); d.gain = F.in[21] + l * DM; d.f8 = XATT_FP8; }
    else if ((r -= 512) < 1024) { d.W = F.in[24] + (size_t)l * DM * 1024; d.K = DM; d.Nsrc = 1024; ND = 1024; d.WT = wptr(F.ws, l, WO_XKV); d.gain = F.in[22] + l * DM; d.f8 = XATT_FP8; }
    else if ((r -= 1024) < 512) { d.W = F.in[27] + (size_t)l * 512 * DM; d.K = 512; d.Nsrc = DM; ND = DM; d.WT = wptr(F.ws, l, WO_XO); d.f8 = XATT_FP8; }
    else if ((r -= 512) < 11264) { d.W = F.in[29] + (size_t)l * DM * 2 * DFF; d.K = DM; d.Nsrc = 2 * DFF; ND = 2 * DFF; d.WT = wptr(F.ws, l, WO_GU); d.gain = F.in[28] + l * DM; mode = 2; d.f8 = (FFN_FP8 & 1) != 0; }
    else if ((r -= 11264) < 5632) { d.W = F.in[30] + (size_t)l * DFF * DM; d.K = DFF; d.Nsrc = DM; ND = DM; d.WT = wptr(F.ws, l, WO_D); d.f8 = (FFN_FP8 & 2) != 0; }
    else if ((r -= 5632) < 192) { d.W = F.in[8] + (size_t)l * 512 * 768; d.K = 512; d.Nsrc = 768; ND = 768; d.WT = wptr(F.ws, l, WO_UQ); }
    else { r -= 192; d.W = F.in[10] + (size_t)l * 256 * 1024; d.K = 256; d.Nsrc = 1024; ND = 1024; d.WT = wptr(F.ws, l, WO_UKV); }
    const int nblk = ND / 32, kb = r / nblk, nb = r - kb * nblk, R0 = nb * 32;
    int srcc = R0, valid = 32;
    if (mode == 1) {
        if (R0 < 1536) srcc = R0; else if (R0 < 2368) srcc = R0 + 4; else if (R0 == 2368) { srcc = 1536; valid = 4; } else if (R0 < 2560) { srcc = 0; valid = 0; } else srcc = R0 - 188;
    } else if (mode == 2) { const int pn = R0 >> 8, within = R0 & 255, half = within >> 7, j = within & 127; srcc = half * DFF + 128 * pn + j; }
    d.k0 = kb * 64; d.srcc = srcc; d.valid = valid; d.R0 = R0;
    return d;
}
__device__ __forceinline__ void tr_load(const WItem& d, int lane, float (&v)[32]) {
    const int n = lane & 31, nn = n < d.valid ? n : 0, kh = lane >> 5;
    const float* src = d.W + (size_t)(d.k0 + kh) * d.Nsrc + d.srcc + nn;
#pragma unroll
    for (int i = 0; i < 32; ++i) v[i] = __builtin_nontemporal_load(src + (size_t)(2 * i) * d.Nsrc);
}
__device__ __forceinline__ void tr_store(const WItem& d, const float (&v)[32], LAS float* scr, int lane) {
    const int n = lane & 31, kh = lane >> 5;
    const bool ok = n < d.valid;
#pragma unroll
    for (int i = 0; i < 32; ++i) scr[(2 * i + kh) * 33 + n] = ok ? v[i] : 0.f;
    LDS_WAIT(); asm volatile("" ::: "memory");
    const int c = lane & 7;
    float gk[8];
#pragma unroll
    for (int j = 0; j < 8; ++j) gk[j] = d.gain ? d.gain[d.k0 + 8 * c + j] : 1.f;
#pragma unroll
    for (int j = 0; j < 4; ++j) {
        const int nr = (lane >> 3) + 8 * j; const LAS float* s = scr + (8 * c) * 33 + nr;
        float xv[8];
#pragma unroll
        for (int e = 0; e < 8; ++e) xv[e] = s[e * 33] * gk[e];
        if (d.f8) *(uint2*)((unsigned char*)d.WT + (size_t)(d.R0 + nr) * d.K + d.k0 + 8 * c) = pack8_fp8(xv, W8_SCALE);
        else *(GAS v4u*)(d.WT + (size_t)(d.R0 + nr) * d.K + d.k0 + 8 * c) = pack8f(xv);
    }
    LDS_WAIT(); asm volatile("" ::: "memory");
}
__device__ __forceinline__ void p0_weights(Frame& F, int gw, int NGW) {
    LAS float* scr = (LAS float*)(F.lds + F.wave * 16384);
    int it = gw; if (it >= 2 * ITEMS_L) return;
    WItem cur = p0_decode(F, it); float v[32]; tr_load(cur, F.lane, v);
#pragma unroll 1
    for (;;) {
        const int itn = it + NGW; const bool hn = itn < 2 * ITEMS_L;
        WItem nxt; float vn[32];
        if (hn) { nxt = p0_decode(F, itn); tr_load(nxt, F.lane, vn); }
        tr_store(cur, v, scr, F.lane);
        if (!hn) break;
        cur = nxt; it = itn;
#pragma unroll
        for (int i = 0; i < 32; ++i) v[i] = vn[i];
    }
}
__device__ __forceinline__ void p0_xrow_load(Frame& F, int m, f32x4 (&v)[8]) {
    const bool isx = m < M; const int r = isx ? m : m - M;
    const float* src = (isx ? F.in[0] : F.in[1]) + (size_t)r * DM;
#pragma unroll
    for (int j = 0; j < 8; ++j) v[j] = __builtin_nontemporal_load((const f32x4*)(src + (j * 64 + F.lane) * 4));
}
__device__ __forceinline__ void p0_prologue(Frame& F) {
    const int gw = F.vcu * NWAVES + F.wave, NGW = F.G * NWAVES;
    p0_weights(F, gw, NGW);
    if (gw < M + MEMR) {
        int m = gw; f32x4 v[8]; p0_xrow_load(F, m, v);
#pragma unroll 1
        for (;;) {
            const int mn = m + NGW; const bool hn = mn < M + MEMR;
            f32x4 vn[8];
            if (hn) p0_xrow_load(F, mn, vn);
            const bool isx = m < M; const int r = isx ? m : m - M;
            bf16* dst = (bf16*)(F.ws + (isx ? WS_XB : WS_MEMB)) + (size_t)r * DM;
            float s = 0.f;
#pragma unroll
            for (int j = 0; j < 8; ++j) {
                s += (v[j][0] * v[j][0] + v[j][1] * v[j][1]) + (v[j][2] * v[j][2] + v[j][3] * v[j][3]);
                if (XATT_FP8 && !isx) { unsigned a8 = 0; a8 = __builtin_amdgcn_cvt_pk_fp8_f32(fp8clamp(v[j][0] * X8_SCALE), fp8clamp(v[j][1] * X8_SCALE), a8, false); a8 = __builtin_amdgcn_cvt_pk_fp8_f32(fp8clamp(v[j][2] * X8_SCALE), fp8clamp(v[j][3] * X8_SCALE), a8, true);
                    *(unsigned*)(F.ws + WS_MEMB + (size_t)r * DM + (j * 64 + F.lane) * 4) = a8; }
                else { uint2 w; w.x = pk2(v[j][0], v[j][1]); w.y = pk2(v[j][2], v[j][3]);
                *(uint2*)(dst + (j * 64 + F.lane) * 4) = w; }
            }
            s = wave_sum(s);
            if (F.lane == 0) { if (isx) ss_ptr(F.ws, 0)[r] = (u64)(s * SS_FIX); else ((u64*)(F.ws + WS_MEMSS))[r] = (u64)(s * SS_FIX); }
            if (!hn) break;
            m = mn;
#pragma unroll
            for (int j = 0; j < 8; ++j) v[j] = vn[j];
        }
    }
    float* rope = (float*)(F.ws + WS_ROPE);
    const int gt = (F.vcu * NWAVES + F.wave) * 64 + F.lane, NGT = NGW * 64;
    for (int idx = gt; idx < SEQ * 32; idx += NGT) {
        const int pos = idx >> 5, i = idx & 31;
        const float inv = powf(10000.f, -(float)i * (1.f / 32.f)); const float ang = (float)pos * inv;
        rope[2 * idx] = cosf(ang); rope[2 * idx + 1] = sinf(ang);
    }
    bf16* tril = (bf16*)(F.ws + WS_TRIL);
    for (int idx = gt; idx < 2 * 4 * 128 * 128; idx += NGT) { const int s = idx & 127, t = (idx >> 7) & 127; tril[idx] = (bf16)(s <= t ? f2bf(F.in[15][idx]) : 0u); }
    if (blockIdx.x == 0 && F.tid < 16) ((bf16*)(F.ws + WS_FQA))[F.tid] = F.tid < 3 ? (bf16)0x3F80 : (bf16)0;
}

__device__ __forceinline__ v4u headnorm8(v4u raw, const float* g, int d0, float sc, float* keep) {
    float x[8]; unpack8(raw, x);
    float s = 0.f;
#pragma unroll
    for (int j = 0; j < 8; ++j) s += x[j] * x[j];
    s = grp16_sum(s);
    const float rs = rsqrtf(s * (1.f / 128.f) + EPS) * sc;
#pragma unroll
    for (int j = 0; j < 8; ++j) { x[j] = x[j] * rs * g[d0 + j]; if (keep) keep[j] = x[j]; }
    return pack8f(x);
}
struct PrepRow { v4u fk, mcq, bk, gv; uint2 mckv; unsigned short ff, mkr; };
__device__ __forceinline__ PrepRow prep_load(const bf16* pr, int lane) {
    PrepRow r;
    r.fk = *(const v4u*)(pr + PC_FK + lane * 8); r.mcq = *(const v4u*)(pr + PC_MCQ + lane * 8);
    r.bk = *(const v4u*)(pr + PC_BK + lane * 8); r.gv = *(const v4u*)(pr + PC_GV + lane * 8);
    r.mckv = *(const uint2*)(pr + PC_MCKV + lane * 4); r.ff = pr[PC_FF + (lane & 3)]; r.mkr = pr[PC_MKR + lane];
    return r;
}
__device__ __forceinline__ void prep_phase(Frame& F, int l) {
    bf16* PROJ = (bf16*)(F.ws + WS_PROJ);
    const float* g_fk = F.in[6] + l * 128; const float* b_f = F.in[4] + l * 4;
    const float* g_ql = F.in[7] + l * 512; const float* g_kvl = F.in[9] + l * 256; const float* g_mk = F.in[12] + l * 192;
    const float* g_bk = F.in[18] + l * 128;
    bf16* CQN = (bf16*)(F.ws + WS_CQN); bf16* CKVN = (bf16*)(F.ws + WS_CKVN); bf16* KPE = (bf16*)(F.ws + WS_KPE); bf16* BKA = (bf16*)(F.ws + WS_BKA);
    float* LF = (float*)(F.ws + WS_LF); float* LFSUM = (float*)(F.ws + WS_LFSUM); const float* rope = (const float*)(F.ws + WS_ROPE); float* GSTAT = (float*)(F.ws + WS_GSTAT);
    u64* KMQ = (u64*)(F.ws + WS_ACC + MiB) + (size_t)l * (8 * 4 * 8 * 128);
    LAS float* red = (LAS float*)F.lds;
    const int lane = F.lane, d0 = (lane & 15) * 8;
    for (int unit = F.vcu; unit < M / 64; unit += F.G) {
        float ksum[8]; float lfs = 0.f;
#pragma unroll
        for (int j = 0; j < 8; ++j) ksum[j] = 0.f;
        const int mbase = unit * 64 + F.wave * 8;
        PrepRow cur = prep_load(PROJ + (size_t)mbase * NPROJ, lane);
#pragma unroll 1
        for (int i = 0; i < 8; ++i) {
            const int m = mbase + i, t = m & (SEQ - 1);
            bf16* pr = PROJ + (size_t)m * NPROJ;
            PrepRow nxt = cur;
            if (i + 1 < 8) nxt = prep_load(pr + NPROJ, lane);
            const f32x2v cs = *(const f32x2v*)(rope + (t * 32 + (lane & 31)) * 2);
            *(v4u*)(pr + PC_FK + lane * 8) = headnorm8(cur.fk, g_fk, d0, 1.f, nullptr);
            if (lane < 4) { const float v = log_sigmoid_f(bf2f(cur.ff) + b_f[lane]); LF[(size_t)m * 4 + lane] = v; lfs += v; }
            { float x[8]; unpack8(cur.mcq, x); float s = 0.f;
#pragma unroll
              for (int j = 0; j < 8; ++j) s += x[j] * x[j];
              s = wave_sum(s); const float rs = rsqrtf(s * (1.f / 512.f) + EPS);
#pragma unroll
              for (int j = 0; j < 8; ++j) x[j] = x[j] * rs * g_ql[lane * 8 + j];
              *(v4u*)(CQN + (size_t)m * 512 + lane * 8) = pack8f(x); }
            { float x[4] = {bflo(cur.mckv.x), bfhi(cur.mckv.x), bflo(cur.mckv.y), bfhi(cur.mckv.y)}; float s = (x[0] * x[0] + x[1] * x[1]) + (x[2] * x[2] + x[3] * x[3]);
              s = wave_sum(s); const float rs = rsqrtf(s * (1.f / 256.f) + EPS);
#pragma unroll
              for (int j = 0; j < 4; ++j) x[j] = x[j] * rs * g_kvl[lane * 4 + j];
              uint2 o; o.x = pk2(x[0], x[1]); o.y = pk2(x[2], x[3]);
              *(uint2*)(CKVN + (size_t)m * 256 + lane * 4) = o; }
            { float x = bf2f(cur.mkr); const float s = wave_sum(x * x); x = x * rsqrtf(s * (1.f / 64.f) + EPS) * g_mk[128 + lane];
              const float other = __shfl_xor(x, 32);
              const float o = lane < 32 ? x * cs[0] - other * cs[1] : other * cs[1] + x * cs[0];
              KPE[(size_t)m * 64 + lane] = (bf16)f2bf(o); }
            { float kf[8]; *(v4u*)(pr + PC_BK + lane * 8) = headnorm8(cur.bk, g_bk, d0, 1.f, kf);
#pragma unroll
              for (int j = 0; j < 8; ++j) ksum[j] += kf[j]; }
            if (lane < 16) BKA[(size_t)m * 16 + lane] = (lane == (t >> 8)) ? (bf16)0x3F80 : (bf16)0;
            { float x[8]; unpack8(cur.gv, x); float sm = 0.f;
#pragma unroll
              for (int j = 0; j < 8; ++j) { x[j] = gelu_tanh(x[j]); sm += x[j]; }
              const float mean = wave_sum(sm) * (1.f / 512.f); float q = 0.f;
#pragma unroll
              for (int j = 0; j < 8; ++j) { const float d = x[j] - mean; q += d * d; }
              const float var = wave_sum(q) * (1.f / 512.f);
              if (lane == 0) { f32x2v st = {mean, rsqrtf(var + EPS)}; *(f32x2v*)(GSTAT + (size_t)m * 2) = st; } }
            cur = nxt;
        }
#pragma unroll
        for (int j = 0; j < 8; ++j) red[F.wave * 512 + lane * 8 + j] = ksum[j];
        if (lane < 4) red[4096 + F.wave * 4 + lane] = lfs;
        __syncthreads();
        {
            float s = 0.f;
#pragma unroll
            for (int w = 0; w < 8; ++w) s += red[w * 512 + F.tid];
            const int m0 = unit * 64, b = m0 >> 11, blk = (m0 & (SEQ - 1)) >> 8, h = F.tid >> 7, d = F.tid & 127;
            atomicAdd(KMQ + (((size_t)b * 4 + h) * 8 + blk) * 128 + d, (u64)(long long)(s * (KM_FIX / 256.f)));
            if (F.tid < 4) { float q = 0.f;
#pragma unroll
                for (int w = 0; w < 8; ++w) q += red[4096 + w * 4 + F.tid];
                LFSUM[unit * 4 + F.tid] = q; }
        }
        __syncthreads();
    }
}

constexpr int VNT_STRIDE = 272;
__device__ __forceinline__ void gmlp_unit(unsigned char* ws, KIN in, LAS unsigned char* lds, int l, int chunk, int g, const int wv) {
    const bf16* PROJ = (const bf16*)(ws + WS_PROJ); bf16* OMIX = (bf16*)(ws + WS_OMIX); const float* GSTAT = (const float*)(ws + WS_GSTAT);
    const float* ln_g = in[13] + l * 512; const float* ln_b = in[14] + l * 512; const float* b_s = in[16] + l * 4 * 128;
    const bf16* tril = (const bf16*)(ws + WS_TRIL) + ((size_t)l * 4 + g) * 128 * 128;
    LAS unsigned char* vnT = lds;
    const int tid = otid(wv), wave = wv, lane = tid & 63, r32 = lane & 31, hi = lane >> 5;
    const int m0 = chunk * 128;
    {
        const int s = tid >> 2, cq = tid & 3;
        const f32x2v st = *(const f32x2v*)(GSTAT + (size_t)(m0 + s) * 2);
        const bf16* src = PROJ + (size_t)(m0 + s) * NPROJ + PC_GV + g * 128 + cq * 32;
        v4u raw[4];
#pragma unroll
        for (int k = 0; k < 4; ++k) raw[k] = *(const v4u*)(src + k * 8);
#pragma unroll
        for (int k = 0; k < 4; ++k) {
            float x[8]; unpack8(raw[k], x);
#pragma unroll
            for (int j = 0; j < 8; ++j) {
                const int c = cq * 32 + k * 8 + j, ch = g * 128 + c;
                const float v = (gelu_tanh(x[j]) - st[0]) * st[1] * ln_g[ch] + ln_b[ch];
                *(LAS bf16*)(vnT + c * VNT_STRIDE + s * 2) = (bf16)f2bf(v);
            }
        }
    }
    __syncthreads();
    const int tb = wave >> 1, cb0 = (wave & 1) * 2;
    const int ch0 = g * 128 + 32 * cb0 + r32;
    unsigned short ur0[16], ur1[16];
#pragma unroll
    for (int i = 0; i < 16; ++i) {
        const int t = 32 * tb + (i & 3) + 8 * (i >> 2) + 4 * hi;
        const bf16* urow = PROJ + (size_t)(m0 + t) * NPROJ + PC_GU + ch0;
        ur0[i] = urow[0]; ur1[i] = urow[32];
    }
    f32x16 acc0 = {}, acc1 = {};
    const int trow = 32 * tb + r32;
    const bf16* wrow = tril + (size_t)trow * 128;
#pragma unroll 2
    for (int ks = 0; ks < 2 * (tb + 1); ++ks) {
        const int s0 = 16 * ks + 8 * hi;
        const bf16x8 afrag = *(const bf16x8*)(wrow + s0);
        const bf16x8 b0 = *(const LAS bf16x8*)(vnT + (32 * cb0 + r32) * VNT_STRIDE + s0 * 2);
        const bf16x8 b1 = *(const LAS bf16x8*)(vnT + (32 * (cb0 + 1) + r32) * VNT_STRIDE + s0 * 2);
        acc0 = __builtin_amdgcn_mfma_f32_32x32x16_bf16(afrag, b0, acc0, 0, 0, 0);
        acc1 = __builtin_amdgcn_mfma_f32_32x32x16_bf16(afrag, b1, acc1, 0, 0, 0);
    }
#pragma unroll
    for (int i = 0; i < 16; ++i) {
        const int t = 32 * tb + (i & 3) + 8 * (i >> 2) + 4 * hi;
        const float bs = b_s[g * 128 + t];
        bf16* op = OMIX + (size_t)(m0 + t) * DM + 1024 + ch0;
        op[0] = (bf16)f2bf(gelu_tanh(bf2f(ur0[i])) * (acc0[i] + bs));
        op[32] = (bf16)f2bf(gelu_tanh(bf2f(ur1[i])) * (acc1[i] + bs));
    }
    __syncthreads();
}

__device__ __forceinline__ void foxbias_phase(Frame& F) {
    const float* LF = (const float*)(F.ws + WS_LF); const float* LFSUM = (const float*)(F.ws + WS_LFSUM); bf16* FKA = (bf16*)(F.ws + WS_FKA);
    const int lane = F.lane;
    if (F.wave < 4)
    for (int unit = F.vcu; unit < M / 64; unit += F.G) {
        const int h = F.wave, u0 = unit & ~31, m = unit * 64 + lane;
        float pre = (u0 + lane < unit) ? LFSUM[(u0 + lane) * 4 + h] : 0.f;
        float v = LF[(size_t)m * 4 + h];
        pre = wave_sum(pre);
#pragma unroll
        for (int o = 1; o < 64; o <<= 1) { const float tt = __shfl_up(v, o); if (lane >= o) v += tt; }
        const float val = -(pre + v) * LOG2E;
        const unsigned b0 = f2bf(val); const float r1 = val - __uint_as_float(b0 << 16);
        const unsigned b1 = f2bf(r1); const float r2 = r1 - __uint_as_float(b1 << 16);
        const unsigned b2 = f2bf(r2);
        v4u w0 = {b0 | (b1 << 16), b2, 0u, 0u}, w1 = {0u, 0u, 0u, 0u};
        *(v4u*)(FKA + ((size_t)m * 4 + h) * 16) = w0; *(v4u*)(FKA + ((size_t)m * 4 + h) * 16 + 8) = w1;
        ((float*)(F.ws + WS_FBIAS))[(size_t)m * 4 + h] = val;
    }
}
__device__ __forceinline__ void gating_phase(Frame& F, int l, gu32* qctr, const int ubase, const int nunit) {
    const bf16* PROJ = (const bf16*)(F.ws + WS_PROJ); bf16* BQA = (bf16*)(F.ws + WS_BQA);
    const u64* KMQ = (const u64*)(F.ws + WS_ACC + MiB) + (size_t)l * (8 * 4 * 8 * 128);
    const float* gbq = F.in[17] + l * 128;
    constexpr int KMS = 256 + 16;
    LAS unsigned char* kmh = F.lds; LAS unsigned char* kml = F.lds + 32 * KMS;
    const int lane = F.lane, r32 = lane & 31, hi = lane >> 5;
    {   const int b = (ubase * 64) >> 11;
        for (int i = F.tid; i < 4 * 8 * 128; i += 512) {
            const float v = (float)(long long)KMQ[(size_t)b * 4096 + i] * KM_INV * gbq[i & 127];
            const unsigned h16 = f2bf(v); const unsigned l16 = f2bf(v - __uint_as_float(h16 << 16));
            *(LAS bf16*)(kmh + (i >> 7) * KMS + (i & 127) * 2) = (bf16)h16; *(LAS bf16*)(kml + (i >> 7) * KMS + (i & 127) * 2) = (bf16)l16;
        }
    }
    LAS unsigned* slot = (LAS unsigned*)(F.lds + 131072 + 320 + 64);
    const int h = F.wave & 3, rb = F.wave >> 2;
    for (;;) {
        const int qi_ = queue_next(qctr, slot, F.wave); if (qi_ >= nunit) break;
        const int unit = ubase + qi_;
        const int m0 = unit * 64, blk = (m0 & (SEQ - 1)) >> 8, m = m0 + 32 * rb + r32;
        const bf16* qp = PROJ + (size_t)m * NPROJ + PC_BQ + h * 128 + hi * 8;
        bf16x8 q[8];
#pragma unroll
        for (int d0 = 0; d0 < 8; ++d0) q[d0] = *(const bf16x8*)(qp + d0 * 16);
        f32x16 acc = {};
        const LAS unsigned char* ah = kmh + (h * 8 + (r32 & 7)) * KMS + hi * 16; const LAS unsigned char* al = kml + (h * 8 + (r32 & 7)) * KMS + hi * 16;
#pragma unroll
        for (int d0 = 0; d0 < 8; ++d0) {
            acc = __builtin_amdgcn_mfma_f32_32x32x16_bf16(*(const LAS bf16x8*)(ah + d0 * 32), q[d0], acc, 0, 0, 0);
            acc = __builtin_amdgcn_mfma_f32_32x32x16_bf16(*(const LAS bf16x8*)(al + d0 * 32), q[d0], acc, 0, 0, 0);
        }
        float g[8];
#pragma unroll
        for (int i = 0; i < 4; ++i) { float ai_ = acc[i]; asm volatile("" : "+v"(ai_)); const unsigned x = __builtin_bit_cast(unsigned, ai_); auto r = __builtin_amdgcn_permlane32_swap(x, x, false, false); g[i] = __builtin_bit_cast(float, (unsigned)r[0]); g[4 + i] = __builtin_bit_cast(float, (unsigned)r[1]); }
#pragma unroll
        for (int n = 0; n < 8; ++n) g[n] = n < blk ? g[n] : -__builtin_inff();
        unsigned w[4] = {0u, 0u, 0u, 0u};
#pragma unroll
        for (int n = 0; n < 8; ++n) {
            int rank = 0;
#pragma unroll
            for (int on = 0; on < 8; ++on) if (on != n) rank += (g[on] > g[n] || (g[on] == g[n] && on < n)) ? 1 : 0;
            const bool masked = n < blk && !(blk <= 3 || rank < 3);
            w[n >> 1] |= masked ? (0xC700u << (16 * (n & 1))) : 0u;
        }
        if (hi == 0) { bf16* op = BQA + ((size_t)m * 4 + h) * 16; *(v4u*)op = (v4u){w[0], w[1], w[2], w[3]}; *(v4u*)(op + 8) = (v4u){0u, 0u, 0u, 0u}; }
    }
}
__device__ __forceinline__ void groupnorm_phase(Frame& F, int l) {
    bf16* OMIX = (bf16*)(F.ws + WS_OMIX); const float* gn = F.in[19] + l * 2048;
    const int lane = F.lane;
    f32x4 gg[4][2];
#pragma unroll
    for (int g = 0; g < 4; ++g) { gg[g][0] = *(const f32x4*)(gn + g * 512 + lane * 8); gg[g][1] = *(const f32x4*)(gn + g * 512 + lane * 8 + 4); }
#pragma unroll 1
    for (int unit = F.vcu; unit < M / 64; unit += F.G) {
        bf16* base = OMIX + (size_t)(unit * 64 + F.wave) * DM + lane * 8;
        v4u x4[8][4];
#pragma unroll
        for (int k = 0; k < 8; ++k)
#pragma unroll
            for (int g = 0; g < 4; ++g) x4[k][g] = *(const v4u*)(base + (size_t)(8 * k) * DM + g * 512);
#pragma unroll
        for (int k = 0; k < 8; ++k)
#pragma unroll
            for (int g = 0; g < 4; ++g) {
                float x[8]; unpack8(x4[k][g], x); float s = 0.f;
#pragma unroll
                for (int j = 0; j < 8; ++j) s += x[j] * x[j];
                const float rs = rsqrtf(wave_sum(s) * (1.f / 512.f) + EPS);
                x[0] *= rs * gg[g][0][0]; x[1] *= rs * gg[g][0][1]; x[2] *= rs * gg[g][0][2]; x[3] *= rs * gg[g][0][3]; x[4] *= rs * gg[g][1][0]; x[5] *= rs * gg[g][1][1]; x[6] *= rs * gg[g][1][2]; x[7] *= rs * gg[g][1][3];
                *(v4u*)(base + (size_t)(8 * k) * DM + g * 512) = pack8f(x);
            }
    }
}

struct AttnSpec {
    const bf16 *q0, *q1, *k0, *k1, *v; bf16* o;
    int pq0, pq1, pk0, pk1, pv, po;
    int hq0, hq1, hk0, hk1, hv, ho;
    int qrows, kvrows;
};
__device__ __forceinline__ int v_st(int k, int c) { const int kk = (k & ~0xC) | ((k & 4) << 1) | ((k & 8) >> 1); return ((kk >> 3) * 4 + (c >> 5)) * 512 + ((kk & 7) * 32 + (c & 31)) * 2; }
__device__ __forceinline__ int v_rd_base(int lane) { return ((lane & 3) << 3) | (((lane >> 2) & 3) << 6) | (((lane >> 4) & 1) << 5) | (((lane >> 5) & 1) << 8); }
__device__ __forceinline__ unsigned cvtpk(float lo, float hi) { unsigned r; asm volatile("v_cvt_pk_bf16_f32 %0, %1, %2" : "=v"(r) : "v"(lo), "v"(hi)); return r; }
#define SBAR() __builtin_amdgcn_sched_barrier(0)

template <int NKS, int NQ0, bool CAUSAL, int QMODE, bool KNORM, bool OUT8 = false>
__device__ __forceinline__ void attn_unit(LAS unsigned char* lds, const AttnSpec& S, int b, int h, int qb, const float* qgain, const float* kgain, const int wv, const float* rope = nullptr, const int t_lo = 0) {
    constexpr int NCH = 2 * NKS, KSTR = (NCH + 1) * 16, KBUF = 64 * KSTR, VBUF = 16384, NX = NCH - 16, NP = NX ? 3 : 2;
    const int tid = otid(wv), wid = wv, lane = tid & 63, r32 = lane & 31, hi = lane >> 5;
    LAS unsigned char* kbuf = lds; LAS unsigned char* vbuf = lds + 2 * KBUF;
    const int q_row0 = qb * 256, qlo = q_row0 + wid * 32, qpos = qlo + r32;
    const int NT = CAUSAL ? (q_row0 + 256) / 64 : S.kvrows / 64;
    const bf16* k0p = S.k0 + (size_t)b * S.kvrows * S.pk0 + h * S.hk0;
    const bf16* k1p = S.k1 + (size_t)b * S.kvrows * S.pk1 + h * S.hk1;
    const bf16* vp = S.v + (size_t)b * S.kvrows * S.pv + h * S.hv;
    bf16x8 qr[NKS];
    {
        const bf16* q0p = S.q0 + ((size_t)b * S.qrows + qpos) * S.pq0 + h * S.hq0;
        const bf16* q1p = S.q1 + ((size_t)b * S.qrows + qpos) * S.pq1 + h * S.hq1;
#pragma unroll
        for (int d0 = 0; d0 < NKS; ++d0) {
            if (2 * d0 < NQ0) qr[d0] = *(const bf16x8*)(q0p + (2 * d0 + hi) * 8);
            else qr[d0] = *(const bf16x8*)(q1p + (2 * d0 + hi - NQ0) * 8);
        }
    }
    v4u kst[NP], vst[2];
    int koff[NP], voff[2]; const bf16* ksrc[NP]; const bf16* vsrc[2]; int kpitch[NP];
#pragma unroll
    for (int i = 0; i < 2; ++i) { const int p = tid + 512 * i, row = p >> 4, ch = p & 15; koff[i] = row * KSTR + ch * 16; ksrc[i] = k0p + (size_t)row * S.pk0 + ch * 8; kpitch[i] = S.pk0; }
    if constexpr (NX > 0) { const int row = NX == 8 ? tid >> 3 : tid >> 1, ch = NX == 8 ? tid & 7 : tid & 1; koff[2] = row * KSTR + (16 + ch) * 16; ksrc[2] = k1p + (size_t)row * S.pk1 + ch * 8; kpitch[2] = S.pk1; }
    const bool xact = NX == 8 || tid < 128;
#pragma unroll
    for (int i = 0; i < 2; ++i) { const int idx = tid + 512 * i, k = idx >> 4, c8 = idx & 15; voff[i] = v_st(k, c8 * 8); vsrc[i] = vp + (size_t)k * S.pv + c8 * 8; }
#define ATT_LOAD(t) do { _Pragma("unroll") for (int i_ = 0; i_ < NP; ++i_) if (i_ < 2 || xact) kst[i_] = *(const v4u*)(ksrc[i_] + (size_t)(t) * 64 * kpitch[i_]); \
        _Pragma("unroll") for (int i_ = 0; i_ < 2; ++i_) vst[i_] = *(const v4u*)(vsrc[i_] + (size_t)(t) * 64 * S.pv); } while (0)
    ATT_LOAD(t_lo);
    {
        if constexpr (QMODE == 1) {
            float ssq = 0.f;
#pragma unroll
            for (int d0 = 0; d0 < 8; ++d0)
#pragma unroll
                for (int j = 0; j < 8; ++j) { const float x = bf2f((unsigned short)qr[d0][j]); ssq += x * x; }
            ssq = sum32(ssq);
            const float rs = rsqrtf(ssq * (1.f / 128.f) + EPS) * QS128;
#pragma unroll
            for (int d0 = 0; d0 < 8; ++d0) {
                float x[8];
#pragma unroll
                for (int j = 0; j < 8; ++j) x[j] = bf2f((unsigned short)qr[d0][j]) * rs * qgain[d0 * 16 + hi * 8 + j];
                v4u w; w.x = pk2(x[0], x[1]); w.y = pk2(x[2], x[3]); w.z = pk2(x[4], x[5]); w.w = pk2(x[6], x[7]);
                qr[d0] = __builtin_bit_cast(bf16x8, w);
            }
        }
        if constexpr (QMODE == 2) {
            float ssn = 0.f, ssp = 0.f;
#pragma unroll
            for (int d0 = 0; d0 < 8; ++d0)
#pragma unroll
                for (int j = 0; j < 8; ++j) { const float x = bf2f((unsigned short)qr[d0][j]); ssn += x * x; }
#pragma unroll
            for (int d0 = 8; d0 < 12; ++d0)
#pragma unroll
                for (int j = 0; j < 8; ++j) { const float x = bf2f((unsigned short)qr[d0][j]); ssp += x * x; }
            ssn = sum32(ssn); ssp = sum32(ssp);
            const float rsn = rsqrtf(ssn * (1.f / 128.f) + EPS) * QS192, rsp = rsqrtf(ssp * (1.f / 64.f) + EPS);
#pragma unroll
            for (int d0 = 0; d0 < 8; ++d0) {
                float x[8];
#pragma unroll
                for (int j = 0; j < 8; ++j) x[j] = bf2f((unsigned short)qr[d0][j]) * rsn * qgain[d0 * 16 + hi * 8 + j];
                qr[d0] = __builtin_bit_cast(bf16x8, pack8f(x));
            }
#pragma unroll
            for (int d0 = 8; d0 < 10; ++d0) {
                const int i0 = 16 * (d0 - 8) + 8 * hi;
                const float* rp = rope + ((size_t)qpos * 32 + i0) * 2;
                float o1[8], o2[8];
#pragma unroll
                for (int j = 0; j < 8; ++j) {
                    const float x1 = bf2f((unsigned short)qr[d0][j]) * rsp * qgain[128 + i0 + j], x2 = bf2f((unsigned short)qr[d0 + 2][j]) * rsp * qgain[160 + i0 + j];
                    const float c = rp[2 * j], sn = rp[2 * j + 1];
                    o1[j] = (x1 * c - x2 * sn) * QS192; o2[j] = (x1 * sn + x2 * c) * QS192;
                }
                qr[d0] = __builtin_bit_cast(bf16x8, pack8f(o1)); qr[d0 + 2] = __builtin_bit_cast(bf16x8, pack8f(o2));
            }
        }
    }
    float kg[8];
    if constexpr (KNORM) {
#pragma unroll
        for (int j = 0; j < 8; ++j) kg[j] = kgain[(tid & 15) * 8 + j];
    }
#define ATT_KNORM() do { if constexpr (KNORM) { _Pragma("unroll") for (int i_ = 0; i_ < 2; ++i_) { float x_[8]; unpack8(kst[i_], x_); float s_ = 0.f; \
        _Pragma("unroll") for (int j_ = 0; j_ < 8; ++j_) s_ += x_[j_] * x_[j_]; s_ = grp16_sum(s_); const float rs_ = rsqrtf(s_ * (1.f / 128.f) + EPS); \
        _Pragma("unroll") for (int j_ = 0; j_ < 8; ++j_) x_[j_] = x_[j_] * rs_ * kg[j_]; kst[i_] = pack8f(x_); } } } while (0)
#define ATT_WRITE(bf) do { ATT_KNORM(); _Pragma("unroll") for (int i_ = 0; i_ < NP; ++i_) if (i_ < 2 || xact) *(LAS v4u*)(kbuf + (bf) * KBUF + koff[i_]) = kst[i_]; \
        _Pragma("unroll") for (int i_ = 0; i_ < 2; ++i_) *(LAS v4u*)(vbuf + (bf) * VBUF + voff[i_]) = vst[i_]; } while (0)
    float m_run = -1e30f, l_run = 0.f; f32x16 o[4] = {};
    ATT_WRITE(t_lo & 1); __syncthreads();
    for (int t = t_lo; t < NT; ++t) {
        const int cur = t & 1, kb = t * 64;
        if (t + 1 < NT) ATT_LOAD(t + 1);
        const bool act = !CAUSAL || (kb <= qlo + 31);
        if (act) {
            f32x16 p0 = {}, p1 = {};
            const LAS unsigned char* ka = kbuf + cur * KBUF + r32 * KSTR + hi * 16;
#pragma unroll
            for (int d0 = 0; d0 < NKS; ++d0) {
                const bf16x8 b0 = *(const LAS bf16x8*)(ka + d0 * 32);
                const bf16x8 b1 = *(const LAS bf16x8*)(ka + 32 * KSTR + d0 * 32);
                p0 = __builtin_amdgcn_mfma_f32_32x32x16_bf16(b0, qr[d0], p0, 0, 0, 0);
                p1 = __builtin_amdgcn_mfma_f32_32x32x16_bf16(b1, qr[d0], p1, 0, 0, 0);
            }
            if (CAUSAL && kb + 63 > qlo) {
                const float NEG = -__builtin_inff();
#pragma unroll
                for (int i = 0; i < 16; ++i) {
                    const int key = kb + (i & 3) + 8 * (i >> 2) + 4 * hi;
                    if (key > qpos) p0[i] = NEG;
                    if (key + 32 > qpos) p1[i] = NEG;
                }
            }
            float pmax = p0[0];
#pragma unroll
            for (int i = 1; i < 16; ++i) pmax = fmaxf(pmax, p0[i]);
#pragma unroll
            for (int i = 0; i < 16; ++i) pmax = fmaxf(pmax, p1[i]);
            pmax = max32(pmax);
            const float mn = pmax > m_run + 8.f ? pmax : m_run, alpha = __builtin_amdgcn_exp2f(m_run - mn);
            m_run = mn;
            float ps = 0.f;
#pragma unroll
            for (int i = 0; i < 16; ++i) { p0[i] = __builtin_amdgcn_exp2f(p0[i] - mn); ps += p0[i]; }
#pragma unroll
            for (int i = 0; i < 16; ++i) { p1[i] = __builtin_amdgcn_exp2f(p1[i] - mn); ps += p1[i]; }
            ps = sum32(ps);
            l_run = l_run * alpha + ps;
            if (!__all(alpha == 1.f)) {
#pragma unroll
                for (int d = 0; d < 4; ++d)
#pragma unroll
                    for (int i = 0; i < 16; ++i) o[d][i] *= alpha;
            }
            bf16x8 pa0, pa1, pa2, pa3;
#define PK4(P, B_, OUT) do { unsigned a0 = cvtpk(P[B_ + 0], P[B_ + 1]), a1 = cvtpk(P[B_ + 2], P[B_ + 3]); \
        unsigned b0_ = cvtpk(P[B_ + 4], P[B_ + 5]), b1_ = cvtpk(P[B_ + 6], P[B_ + 7]); \
        auto r0 = __builtin_amdgcn_permlane32_swap(a0, b0_, false, false); auto r1 = __builtin_amdgcn_permlane32_swap(a1, b1_, false, false); \
        v4u w = {r0[0], r1[0], r0[1], r1[1]}; OUT = __builtin_bit_cast(bf16x8, w); } while (0)
            PK4(p0, 0, pa0); PK4(p0, 8, pa1); PK4(p1, 0, pa2); PK4(p1, 8, pa3);
#undef PK4
            const unsigned vb0 = (unsigned)(uintptr_t)(vbuf + cur * VBUF) + (unsigned)v_rd_base(lane);
#define TRRD(dst, off) asm volatile("ds_read_b64_tr_b16 %0, %1 offset:%2" : "=&v"(dst) : "v"(vb0), "i"(off) : "memory")
#define PV_D0(d0) do { s16x4 l0, l1, l2, l3, h0, h1, h2, h3; constexpr int b_ = (d0) * 512; \
        TRRD(l0, b_); TRRD(h0, b_ + 2048); TRRD(l1, b_ + 4096); TRRD(h1, b_ + 6144); TRRD(l2, b_ + 8192); TRRD(h2, b_ + 10240); TRRD(l3, b_ + 12288); TRRD(h3, b_ + 14336); \
        asm volatile("s_waitcnt lgkmcnt(0)" ::: "memory"); SBAR(); \
        o[d0] = __builtin_amdgcn_mfma_f32_32x32x16_bf16((bf16x8){l0[0], l0[1], l0[2], l0[3], h0[0], h0[1], h0[2], h0[3]}, pa0, o[d0], 0, 0, 0); \
        o[d0] = __builtin_amdgcn_mfma_f32_32x32x16_bf16((bf16x8){l1[0], l1[1], l1[2], l1[3], h1[0], h1[1], h1[2], h1[3]}, pa1, o[d0], 0, 0, 0); \
        o[d0] = __builtin_amdgcn_mfma_f32_32x32x16_bf16((bf16x8){l2[0], l2[1], l2[2], l2[3], h2[0], h2[1], h2[2], h2[3]}, pa2, o[d0], 0, 0, 0); \
        o[d0] = __builtin_amdgcn_mfma_f32_32x32x16_bf16((bf16x8){l3[0], l3[1], l3[2], l3[3], h3[0], h3[1], h3[2], h3[3]}, pa3, o[d0], 0, 0, 0); } while (0)
            PV_D0(0); PV_D0(1); PV_D0(2); PV_D0(3);
#undef PV_D0
#undef TRRD
        }
        if (t + 1 < NT) ATT_WRITE(cur ^ 1);
        __syncthreads();
    }
#undef ATT_LOAD
#undef ATT_WRITE
#undef ATT_KNORM
    const float inv = 1.f / l_run;
    if constexpr (OUT8) {
        constexpr int OSTR = 128 + 16;
        LAS unsigned char* ost = lds + wid * (32 * OSTR);
#pragma unroll
        for (int d0 = 0; d0 < 4; ++d0)
#pragma unroll
            for (int g = 0; g < 4; ++g) {
                const float sc8 = inv * XO8_SCALE; unsigned a8 = 0;
                a8 = __builtin_amdgcn_cvt_pk_fp8_f32(fp8clamp(o[d0][4 * g] * sc8), fp8clamp(o[d0][4 * g + 1] * sc8), a8, false);
                a8 = __builtin_amdgcn_cvt_pk_fp8_f32(fp8clamp(o[d0][4 * g + 2] * sc8), fp8clamp(o[d0][4 * g + 3] * sc8), a8, true);
                *(LAS unsigned*)(ost + r32 * OSTR + 32 * d0 + 8 * g + 4 * hi) = a8;
            }
        unsigned char* obase8 = (unsigned char*)S.o + ((size_t)b * S.qrows + qlo) * S.po + h * S.ho;
#pragma unroll
        for (int j = 0; j < 4; ++j) { const int row = (lane >> 3) + 8 * j, ch = lane & 7;
            *(v4u*)(obase8 + (size_t)row * S.po + ch * 16) = *(const LAS v4u*)(ost + row * OSTR + ch * 16); }
    } else {
        constexpr int OSTR = 256 + 16;
        LAS unsigned char* ost = lds + wid * (32 * OSTR);
#pragma unroll
        for (int d0 = 0; d0 < 4; ++d0)
#pragma unroll
            for (int g = 0; g < 4; ++g) {
                typedef unsigned v2u_t __attribute__((ext_vector_type(2)));
                v2u_t w; w.x = cvtpk(o[d0][4 * g] * inv, o[d0][4 * g + 1] * inv); w.y = cvtpk(o[d0][4 * g + 2] * inv, o[d0][4 * g + 3] * inv);
                *(LAS v2u_t*)(ost + r32 * OSTR + (32 * d0 + 8 * g + 4 * hi) * 2) = w;
            }
        bf16* obase = S.o + ((size_t)b * S.qrows + qlo) * S.po + h * S.ho;
#pragma unroll
        for (int j = 0; j < 8; ++j) { const int row = (lane >> 4) + 4 * j, ch = lane & 15;
            *(v4u*)(obase + (size_t)row * S.po + ch * 8) = *(const LAS v4u*)(ost + row * OSTR + ch * 16); }
    }
    __syncthreads();
}

constexpr int LDS_BYTES = 147456;
constexpr int MISC_OFF = 131072 + 320;
constexpr int NPH_L = 11, NPHASE = 1 + 2 * NPH_L;

__device__ __forceinline__ AttnSpec spec_fox(unsigned char* ws) {
    bf16* PROJ = (bf16*)(ws + WS_PROJ); AttnSpec S;
    S.q0 = PROJ + PC_FQ; S.pq0 = NPROJ; S.hq0 = 128; S.q1 = (const bf16*)(ws + WS_FQA); S.pq1 = 0; S.hq1 = 0;
    S.k0 = PROJ + PC_FK; S.pk0 = NPROJ; S.hk0 = 128; S.k1 = (const bf16*)(ws + WS_FKA); S.pk1 = 64; S.hk1 = 16;
    S.v = PROJ + PC_FV; S.pv = NPROJ; S.hv = 128; S.o = (bf16*)(ws + WS_OMIX); S.po = DM; S.ho = 128; S.qrows = SEQ; S.kvrows = SEQ; return S;
}
__device__ __forceinline__ AttnSpec spec_moba(unsigned char* ws) {
    bf16* PROJ = (bf16*)(ws + WS_PROJ); AttnSpec S;
    S.q0 = PROJ + PC_BQ; S.pq0 = NPROJ; S.hq0 = 128; S.q1 = (const bf16*)(ws + WS_BQA); S.pq1 = 64; S.hq1 = 16;
    S.k0 = PROJ + PC_BK; S.pk0 = NPROJ; S.hk0 = 128; S.k1 = (const bf16*)(ws + WS_BKA); S.pk1 = 16; S.hk1 = 0;
    S.v = PROJ + PC_BV; S.pv = NPROJ; S.hv = 128; S.o = (bf16*)(ws + WS_OMIX) + 1536; S.po = DM; S.ho = 128; S.qrows = SEQ; S.kvrows = SEQ; return S;
}
__device__ __forceinline__ AttnSpec spec_mla(unsigned char* ws) {
    AttnSpec S; bf16* QM = (bf16*)(ws + WS_QM); bf16* KVM = (bf16*)(ws + WS_KVM);
    S.q0 = QM; S.pq0 = 768; S.hq0 = 192; S.q1 = QM; S.pq1 = 0; S.hq1 = 0;
    S.k0 = KVM; S.pk0 = 1024; S.hk0 = 256; S.k1 = (const bf16*)(ws + WS_KPE); S.pk1 = 64; S.hk1 = 0;
    S.v = KVM + 128; S.pv = 1024; S.hv = 256; S.o = (bf16*)(ws + WS_OMIX) + 512; S.po = DM; S.ho = 128; S.qrows = SEQ; S.kvrows = SEQ; return S;
}
__device__ __forceinline__ AttnSpec spec_cross(unsigned char* ws, int l) {
    AttnSpec S; bf16* XQ = (bf16*)(ws + WS_XQ); bf16* XKV = (bf16*)(ws + WS_XKV) + (size_t)l * MEMR * 1024;
    S.q0 = XQ; S.pq0 = 512; S.hq0 = 128; S.q1 = XQ; S.pq1 = 0; S.hq1 = 0;
    S.k0 = XKV; S.pk0 = 1024; S.hk0 = 128; S.k1 = XKV; S.pk1 = 0; S.hk1 = 0;
    S.v = XKV + 512; S.pv = 1024; S.hv = 128; S.o = (bf16*)(ws + WS_XO); S.po = 512; S.ho = 128; S.qrows = SEQ; S.kvrows = 256; return S;
}

__global__ void __launch_bounds__(NWAVES * 64, 2) mega(Params P) {
    extern __shared__ __attribute__((aligned(16))) unsigned char lds_raw[];
    const int wv0 = __builtin_amdgcn_readfirstlane((int)threadIdx.x >> 6);
    Frame F;
    F.lds = (LAS unsigned char*)lds_raw;
    F.tid = otid(wv0); F.lane = F.tid & 63; F.wave = wv0;
    F.G = gridDim.x; { const int bx = blockIdx.x; F.vcu = (F.G % 8 == 0) ? (bx % 8) * (F.G / 8) + bx / 8 : bx; }
    F.in = (KIN)__builtin_amdgcn_kernarg_segment_ptr(); F.out = P.out; F.ws = P.ws;
    volatile LAS unsigned* MISC = (volatile LAS unsigned*)(F.lds + MISC_OFF);
    for (int u = F.tid; u < (LDS_BYTES - 131072) / 4; u += NWAVES * 64) ((LAS unsigned*)(F.lds + 131072))[u] = 0u;
    __syncthreads();
    gu32* ctl = (gu32*)(P.ws + WS_CTL);
    const int lo = P.ph_lo, hi = P.ph_hi;
    XcdBarrier bar; bar.bar = (unsigned*)ctl + CW_BAR; bar.x = 0; bar.st = nullptr; bar.wv = wv0;
    if (hi - lo > 1) bar = xcd_barrier_post((unsigned*)ctl + CW_BAR, MISC + 8, wv0);
    const int grp = (int)blockIdx.x & 7, gs = F.G >> 3, gj = (int)blockIdx.x >> 3;
    GrpBarrier gb; gb.cnt = (unsigned*)ctl + CW_GB + 64 * grp; gb.tmo = (unsigned*)ctl + CW_BAR + XB_TMO; gb.target = 0u; gb.step = (unsigned)gs; gb.fast = 0; gb.wv = wv0;
    if (hi - lo > 1 && wv0 == 0 && olane() == 0) (void)__hip_atomic_fetch_or((unsigned*)ctl + CW_COLO + 64 * grp, 1u << xb_xcc_id(), RLX_AGENT);
#define IN(k) (lo <= (k) && (k) < hi)
#ifndef PH_ENABLE
#define PH_ENABLE 0xFFFFF
#endif
#define PHEN(k) ((PH_ENABLE >> (k)) & 1)
#define REFRESH() do { F.tid = otid(wv0); F.lane = F.tid & 63; F.wave = wv0; F.in = (KIN)(unsigned long long)uni_launder((const char*)(unsigned long long)__builtin_amdgcn_kernarg_segment_ptr()); } while (0)
#if defined(DIAG_X8_PASS)
#define DIAG_X8_PASS_ON 1
#else
#define DIAG_X8_PASS_ON 0
#endif
#ifndef MULTI_GEMM
#define MULTI_GEMM 1
#endif
#ifndef REP_PHASE
#define REP_PHASE -1
#endif
#define REPS(k) ((REP_PHASE) == (k) ? 2 : 1)
#ifdef PROBE_STAMP
    typedef unsigned long long su64;
    volatile LAS su64* stamp = (volatile LAS su64*)(F.lds + 131072 + 1024);
#define STAMP_AT(l_, k_, w_) do { if ((l_) * 16 + (k_) == (PROBE_STAMP) && blockIdx.x == 0 && wv0 == 0) { const su64 c_ = __builtin_readcyclecounter(), r_ = __builtin_amdgcn_s_memrealtime(); if (olane() == 0) { stamp[2 * (w_)] = c_; stamp[2 * (w_) + 1] = r_; } } } while (0)
#else
#define STAMP_AT(l_, k_, w_) do { } while (0)
#endif
#define REPBAR(k) do { if (IN(k)) xcd_barrier(bar); } while (0)
#define SEAM(k) do { if (IN(k) && IN((k) + 1)) { if ((k) == 0) { xcd_barrier(bar); const unsigned cm_ = xb_ld((unsigned*)ctl + CW_COLO + 64 * grp); gb.fast = (cm_ & (cm_ - 1u)) == 0u; } else grp_barrier(gb); } } while (0)
    unsigned char* ws = P.ws;
    bf16* XB = (bf16*)(ws + WS_XB); bf16* PROJ = (bf16*)(ws + WS_PROJ); bf16* OMIX = (bf16*)(ws + WS_OMIX);

    _Pragma("unroll 1") for (int rep = 0; rep < REPS(16); ++rep) { if (rep) REPBAR(0); if (PHEN(16) && IN(0)) { STAMP_AT(6, 4, 0); REFRESH(); p0_prologue(F); STAMP_AT(6, 4, 1); } }
    SEAM(0); STAMP_AT(6, 4, 2);
    for (int l = 0; l < 2; ++l) {
        const int pb = 1 + NPH_L * l;
#define PHASE_BEGIN(k) _Pragma("unroll 1") for (int rep = 0; rep < REPS(k); ++rep) { if (rep) REPBAR(pb + (k)); if (PHEN(k) && IN(pb + (k))) { STAMP_AT(l, k, 0);
#define PHASE_END(k) STAMP_AT(l, k, 1); } } SEAM(pb + (k)); STAMP_AT(l, k, 2);
        PHASE_BEGIN(0)
            pg8::Gemm g{XB, wptr(ws, l, WO_IN), M, NPROJ, DM}; pg8::StaticOrder S; S.init(M, NPROJ, F.G, (int)blockIdx.x);
            EpiScale E{PROJ, NPROJ, ss_ptr(ws, 3 * l + 0), 1.f / DM, 1.f};
            pg8::gemm_phase<EpiScale, pg8::StaticOrder, true, true>(F.lds, g, S, E, wv0);
        PHASE_END(0)
        PHASE_BEGIN(1)
            REFRESH(); prep_phase(F, l);
        PHASE_END(1)
        PHASE_BEGIN(2)
#if MULTI_GEMM
            { pg8::Gemm g0{(bf16*)(ws + WS_CQN), wptr(ws, l, WO_UQ), M, 768, 512}, g1{(bf16*)(ws + WS_CKVN), wptr(ws, l, WO_UKV), M, 1024, 256};
              pg8::ListOrder2G S; S.init(8 * grp, 8, 3, 8 * grp, 8, 4, gs, gj);
              EpiScale2 E{EpiScale{(bf16*)(ws + WS_QM), 768, nullptr, 0.f, 1.f}, EpiScale{(bf16*)(ws + WS_KVM), 1024, nullptr, 0.f, 1.f}};
              pg8::gemm_phase<EpiScale2, pg8::ListOrder2G, true, true, false, true>(F.lds, g0, S, E, wv0, g1); }
#else
            { pg8::Gemm g{(bf16*)(ws + WS_CQN), wptr(ws, l, WO_UQ), M, 768, 512}; pg8::StaticOrder S; S.init(M, 768, F.G, (int)blockIdx.x);
              EpiScale E{(bf16*)(ws + WS_QM), 768, nullptr, 0.f, 1.f};
              pg8::gemm_phase<EpiScale, pg8::StaticOrder, true, true>(F.lds, g, S, E, wv0); }
            { pg8::Gemm g{(bf16*)(ws + WS_CKVN), wptr(ws, l, WO_UKV), M, 1024, 256}; pg8::StaticOrder S; S.init(M, 1024, F.G, (int)blockIdx.x);
              EpiScale E{(bf16*)(ws + WS_KVM), 1024, nullptr, 0.f, 1.f};
              pg8::gemm_phase<EpiScale, pg8::StaticOrder, true, true>(F.lds, g, S, E, wv0); }
#endif
            REFRESH(); foxbias_phase(F); REFRESH(); gating_phase(F, l, ctl + CW_Q + 64 * (32 * l + 24 + grp) + 4096 * rep, grp * 32, 32);
        PHASE_END(2)
        PHASE_BEGIN(3)
            LAS unsigned* slot = (LAS unsigned*)(F.lds + MISC_OFF + 64);
            REFRESH();
            {
                const AttnSpec SF = spec_fox(ws), SB = spec_moba(ws), SM = spec_mla(ws); const float* gq = F.in[11] + l * 192; const float* gk = F.in[12] + l * 192;
                const float* fbias = (const float*)(ws + WS_FBIAS);
                float fxB; { const float* g1 = F.in[5] + l * 128; const float* g2 = F.in[6] + l * 128; float a = fmaxf(fabsf(g1[F.lane]), fabsf(g1[F.lane + 64])), c = fmaxf(fabsf(g2[F.lane]), fabsf(g2[F.lane + 64]));
#pragma unroll
                    for (int o = 1; o < 64; o <<= 1) { a = fmaxf(a, __shfl_xor(a, o)); c = fmaxf(c, __shfl_xor(c, o)); }
                    fxB = 2.f * (128.f * QS128 * 1.01f) * a * c + 40.f; }
                gu32* ctr = ctl + CW_Q + 64 * (32 * l + grp) + 4096 * rep;
                int it = queue_next(ctr, slot, wv0);
                for (;;) { if (it >= 96) break;
                    unsigned nx_ = 0u; if (wv0 == 0 && olane() == 0) nx_ = __hip_atomic_fetch_add(ctr, 1u, __ATOMIC_RELAXED, __HIP_MEMORY_SCOPE_AGENT);
                    if (it < 64) { const int r = it & 7, qb = 7 - (it >> 3);
                        if (r < 4) attn_unit<12, 24, true, 2, true>(F.lds, SM, grp, r, qb, gq, gk, wv0, (const float*)(ws + WS_ROPE));
                        else attn_unit<9, 16, true, 1, false>(F.lds, SB, grp, r - 4, qb, F.in[17] + l * 128, nullptr, wv0); }
                    else { const int j = it - 64, qb = 7 - (j >> 2), b = grp, hh = j & 3;
                        int tlo = 0;
                        if (qb > 0) { const float ref = fbias[((size_t)b * SEQ + qb * 256) * 4 + hh];
                            const bool skip = F.lane < 4 * qb && (ref - fbias[((size_t)b * SEQ + F.lane * 64 + 63) * 4 + hh]) >= fxB;
                            const unsigned long long mk = __ballot(skip); tlo = mk == ~0ull ? 64 : __builtin_ctzll(~mk); tlo = __builtin_amdgcn_readfirstlane(tlo < 4 * qb ? tlo : 4 * qb); }
                        attn_unit<9, 16, true, 1, false>(F.lds, SF, b, hh, qb, F.in[5] + l * 128, nullptr, wv0, nullptr, tlo); }
                    if (wv0 == 0 && olane() == 0) *slot = nx_;
                    __syncthreads(); it = (int)*slot; } }
            STAMP_AT(l, 3, 3);
            REFRESH();
            { gu32* ctr = ctl + CW_Q + 64 * (32 * l + 16 + grp) + 4096 * rep;
              for (;;) { const int it = queue_next(ctr, slot, wv0); if (it >= 64) break; gmlp_unit(ws, F.in, F.lds, l, grp * 16 + (it >> 2), it & 3, wv0); } }
        PHASE_END(3)
        PHASE_BEGIN(4)
            REFRESH(); groupnorm_phase(F, l);
        PHASE_END(4)
        PHASE_BEGIN(5)
            pg8::Gemm g{OMIX, wptr(ws, l, WO_OUT), M, DM, DM}; pg8::StaticOrder S; S.init(M, DM, F.G, (int)blockIdx.x);
            EpiResid2 E{XB, ss_ptr(ws, 3 * l + 1), XATT_FP8 ? ws + WS_X8 : nullptr, nullptr, 1.f};
            pg8::gemm_phase<EpiResid2, pg8::StaticOrder, true, true>(F.lds, g, S, E, wv0);
        PHASE_END(5)
        PHASE_BEGIN(6)
#if MULTI_GEMM
            constexpr bool XF = XATT_FP8 != 0; constexpr float XOS = XF ? 1.f / (X8_SCALE * W8_SCALE) : 1.f;
            pg8::Gemm g0{XF ? (bf16*)(ws + WS_X8) : XB, wptr(ws, l, WO_XQ), M, 512, XF ? DM / 2 : DM}, g1{(bf16*)(ws + WS_MEMB), wptr(ws, l, WO_XKV), MEMR, 1024, XF ? DM / 2 : DM};
            pg8::ListOrder2G S; S.init(8 * grp, 8, 2, grp, 1, 4, gs, gj);
            EpiScale2 E{EpiScale{(bf16*)(ws + WS_XQ), 512, ss_ptr(ws, 3 * l + 1), 1.f / DM, XOS}, EpiScale{(bf16*)(ws + WS_XKV) + (size_t)l * MEMR * 1024, 1024, (const u64*)(ws + WS_MEMSS), 1.f / DM, XOS}};
            pg8::gemm_phase<EpiScale2, pg8::ListOrder2G, true, true, XF, true>(F.lds, g0, S, E, wv0, g1);
#else
            { pg8::Gemm g{XB, wptr(ws, l, WO_XQ), M, 512, DM}; pg8::StaticOrder S; S.init(M, 512, F.G, (int)blockIdx.x);
              EpiScale E{(bf16*)(ws + WS_XQ), 512, ss_ptr(ws, 3 * l + 1), 1.f / DM, 1.f};
              pg8::gemm_phase<EpiScale, pg8::StaticOrder, true, true>(F.lds, g, S, E, wv0); }
            { pg8::Gemm g{(bf16*)(ws + WS_MEMB), wptr(ws, l, WO_XKV), MEMR, 1024, DM}; pg8::StaticOrder S; S.init(MEMR, 1024, F.G, 255 - (int)blockIdx.x);
              EpiScale E{(bf16*)(ws + WS_XKV) + (size_t)l * MEMR * 1024, 1024, (const u64*)(ws + WS_MEMSS), 1.f / DM, 1.f};
              pg8::gemm_phase<EpiScale, pg8::StaticOrder, true, true>(F.lds, g, S, E, wv0); }
#endif
        PHASE_END(6)
        PHASE_BEGIN(7)
            REFRESH(); const AttnSpec SX = spec_cross(ws, l); const float* qg = F.in[25] + l * 128; const float* kg = F.in[26] + l * 128;
            for (int it = F.vcu; it < 256; it += F.G) { attn_unit<8, 16, false, 1, true, XATT_FP8 != 0>(F.lds, SX, it >> 5, (it >> 3) & 3, it & 7, qg, kg, wv0); }
        PHASE_END(7)
        PHASE_BEGIN(8)
            constexpr bool XF = XATT_FP8 != 0;
            pg8::Gemm g{(bf16*)(ws + WS_XO), wptr(ws, l, WO_XO), M, DM, XF ? 256 : 512}; pg8::StaticOrder S; S.init(M, DM, F.G, (int)blockIdx.x);
            EpiResid2 E{XB, ss_ptr(ws, 3 * l + 2), (FFN_FP8 & 1) ? ws + WS_X8 : nullptr, nullptr, XF ? 1.f / (XO8_SCALE * W8_SCALE) : 1.f};
            pg8::gemm_phase<EpiResid2, pg8::StaticOrder, true, true, XF>(F.lds, g, S, E, wv0);
        PHASE_END(8)
        PHASE_BEGIN(9)
            constexpr bool G8F = (FFN_FP8 & 1) != 0, G9F = (FFN_FP8 & 2) != 0;
            pg8::Gemm g{G8F ? (bf16*)(ws + WS_X8) : XB, wptr(ws, l, WO_GU), M, 2 * DFF, G8F ? DM / 2 : DM}; pg8::StaticOrder S; S.init(M, 2 * DFF, F.G, (int)blockIdx.x);
            EpiSwiGLUx<G9F> E{(void*)PROJ, ss_ptr(ws, 3 * l + 2), G8F ? 1.f / (X8_SCALE * W8_SCALE) : 1.f};
            pg8::gemm_phase<EpiSwiGLUx<G9F>, pg8::StaticOrder, true, true, G8F>(F.lds, g, S, E, wv0);
        PHASE_END(9)
        PHASE_BEGIN(10)
            constexpr bool G9F = (FFN_FP8 & 2) != 0;
            pg8::Gemm g{PROJ, wptr(ws, l, WO_D), M, DM, G9F ? DFF / 2 : DFF}; pg8::StaticOrder S; S.init(M, DM, F.G, (int)blockIdx.x);
            EpiResid2 E{XB, ss_ptr(ws, 3 * l + 3), nullptr, l == 1 ? P.out : nullptr, G9F ? 1.f / (ACT8_SCALE * W8_SCALE) : 1.f};
            pg8::gemm_phase<EpiResid2, pg8::StaticOrder, true, true, G9F>(F.lds, g, S, E, wv0);
        PHASE_END(10)
#undef PHASE_BEGIN
#undef PHASE_END
    }
#ifdef PROBE_STAMP
    if (blockIdx.x == 0 && wv0 == 0) {
        __builtin_amdgcn_s_waitcnt(0);
        const su64 c0 = stamp[0], r0 = stamp[1], c1 = stamp[2], r1 = stamp[3], r2 = stamp[5];
        su64 V;
        if (PROBE_STAMP_MODE == 0) V = (su64)((float)(c1 - c0) * 100.f / (float)(r1 - r0) * 100.f);
        else if (PROBE_STAMP_MODE == 1) V = (r1 - r0) * 10;
        else if (PROBE_STAMP_MODE == 3) V = (stamp[7] - r0) * 10;
        else V = (r2 - r0) * 10;
        const su64 t0 = __builtin_amdgcn_s_memrealtime();
        while (__builtin_amdgcn_s_memrealtime() - t0 < V) __builtin_amdgcn_s_sleep(64);
    }
#endif
#undef IN
#undef SEAM
}

#ifndef N_LAUNCH_MODE
#define N_LAUNCH_MODE 0
#endif
extern "C" void kernel_launch(void* const* d_in, const int* in_sizes, int n_in, void* d_out, int out_size, void* d_ws, size_t ws_size, hipStream_t stream) {
    static int grid = 0;
    if (grid == 0) {
        if (n_in != 31 || out_size != M * DM || ws_size < WS_END) { fprintf(stderr, "kernel_launch: unexpected shapes (n_in %d out %d ws %zu)\n", n_in, out_size, ws_size); grid = -1; return; }
        int dev = 0, cus = 0, per_cu = 0;
        if (hipGetDevice(&dev) != hipSuccess || hipDeviceGetAttribute(&cus, hipDeviceAttributeMultiprocessorCount, dev) != hipSuccess) { grid = -1; return; }
        if (hipFuncSetAttribute((const void*)mega, hipFuncAttributeMaxDynamicSharedMemorySize, LDS_BYTES) != hipSuccess) { fprintf(stderr, "kernel_launch: hipFuncSetAttribute failed\n"); grid = -1; return; }
        if (hipOccupancyMaxActiveBlocksPerMultiprocessor(&per_cu, (const void*)mega, NWAVES * 64, LDS_BYTES) != hipSuccess || per_cu < 1) fprintf(stderr, "kernel_launch: occupancy query says %d\n", per_cu);
        (void)hipGetLastError();
        grid = cus - cus % 8;
        if (grid < 8) { grid = -1; return; }
    }
    if (grid < 0) return;
    (void)hipMemsetAsync((char*)d_ws + WS_ACC, 0, 2 * MiB, stream);
    Params p{};
    for (int i = 0; i < 31; ++i) p.in[i] = (const float*)d_in[i];
    p.out = (float*)d_out; p.ws = (unsigned char*)d_ws;
#if N_LAUNCH_MODE == 1
    p.ph_lo = 0; p.ph_hi = NPHASE;
    hipLaunchKernelGGL(mega, dim3(grid), dim3(NWAVES * 64), LDS_BYTES, stream, p);
#else
    for (int ph = 0; ph < NPHASE; ++ph) {
        p.ph_lo = ph; p.ph_hi = ph + 1;
        hipLaunchKernelGGL(mega, dim3(grid), dim3(NWAVES * 64), LDS_BYTES, stream, p);
    }
#endif
}
```

```cpp
#include <hip/hip_runtime.h>
#include <cstdio>
#include <cstdint>
__device__ __forceinline__ int olane() { int l; asm volatile("v_mbcnt_lo_u32_b32 %0, -1, 0\n\tv_mbcnt_hi_u32_b32 %0, -1, %0" : "=v"(l)); return l; }
__device__ __forceinline__ int otid(int wv) { return (wv << 6) | olane(); }
template <class T> __device__ __forceinline__ T* uni_launder(T* p) {
    const unsigned z = (unsigned)olane() >> 7; const unsigned long long v = (unsigned long long)p;
    const unsigned lo = (unsigned)__builtin_amdgcn_readfirstlane((int)((unsigned)v + z)), hi = (unsigned)__builtin_amdgcn_readfirstlane((int)(unsigned)(v >> 32));
    return (T*)(((unsigned long long)hi << 32) | lo);
}
__device__ __forceinline__ const char* uni64(const char* p) { const unsigned long long v = (unsigned long long)p; const unsigned lo = (unsigned)__builtin_amdgcn_readfirstlane((int)(unsigned)v), hi = (unsigned)__builtin_amdgcn_readfirstlane((int)(unsigned)(v >> 32)); return (const char*)(((unsigned long long)hi << 32) | lo); }
__device__ __forceinline__ float shx(float v, int mask, int lane) { return __uint_as_float((unsigned)__builtin_amdgcn_ds_bpermute((lane ^ mask) << 2, (int)__float_as_uint(v))); }
__device__ __forceinline__ float shup(float v, int d, int lane) { return __uint_as_float((unsigned)__builtin_amdgcn_ds_bpermute((lane >= d ? lane - d : lane) << 2, (int)__float_as_uint(v))); }
#define N_LAUNCH_MODE 1
namespace pg8 {
#define PG8_LAS __attribute__((address_space(3)))
typedef unsigned short bf16_t;
typedef short bf16x8 __attribute__((ext_vector_type(8)));
typedef float f32x4 __attribute__((ext_vector_type(4)));
typedef unsigned u32x4 __attribute__((ext_vector_type(4)));
constexpr int BM = 256, BK = 64, HALF = 128, HTB = HALF * BK * 2  , STAGE_BYTES = 8 * HTB, NXCD = 8, WGM = 4;

__host__ __device__ __forceinline__ int lds_byte(int r, int c) { const int st = (r >> 4) * 2 + (c >> 5), rr = r & 15, cc = c & 31, ob = rr * 64 + cc * 2; return st * 1024 + (ob ^ (((ob >> 9) & 1) << 5)); }
__host__ __device__ __forceinline__ void stage_rc(int b, int& R, int& C) { const int st = b / 1024, sb = b % 1024, swz = sb ^ (((sb >> 9) & 1) << 5); R = (st >> 1) * 16 + swz / 64; C = (st & 1) * 32 + (swz % 64) / 2; }
__host__ __device__ __forceinline__ int perm32(int rho) { const int n = rho >> 4, i = rho & 15; return 8 * (i >> 2) + 4 * n + (i & 3); }

struct Unit { int pm, pn; };
struct Gemm { const bf16_t* A; const bf16_t* Bt; int M, N, K; };

struct StaticOrder {
    int nM, nN, nwg, G, c;
    __host__ __device__ void init(int M, int N, int G_, int c_) { nM = M / BM; nN = N / BM; nwg = nM * nN; G = G_; c = c_; }
    __host__ __device__ bool next(int i, Unit& u) const {
        const long L = (long)i * G + c; if (L >= nwg) return false;
        int wgid = (int)L; { const int q = nwg / NXCD, r = nwg % NXCD, xcd = wgid % NXCD, off = wgid / NXCD; wgid = (xcd < r ? xcd * (q + 1) : r * (q + 1) + (xcd - r) * q) + off; }
        const int nig = WGM * nN, gid = wgid / nig, fm = gid * WGM, gsz = (nM - fm) < WGM ? (nM - fm) : WGM;
        u.pm = fm + ((wgid % nig) % gsz); u.pn = (wgid % nig) / gsz; return true;
    }
    __device__ __forceinline__ void a_ready(const Unit&) const {}
    __device__ __forceinline__ void done(const Unit&) const {}
};

struct ListOrder2 {
    int nM0, n0, nM1, n1, G, c;
    __host__ __device__ void init(int M0, int N0, int M1, int N1, int G_, int c_) { nM0 = M0 / BM; n0 = nM0 * (N0 / BM); nM1 = M1 / BM; n1 = nM1 * (N1 / BM); G = G_; c = c_; }
    __host__ __device__ bool next(int i, Unit& u) const {
        int L = i * G + c; if (L >= n0 + n1) return false;
        if (L < n0) { u.pm = L % nM0; u.pn = L / nM0; } else { L -= n0; u.pm = L % nM1; u.pn = (L / nM1) | 0x10000; }
        return true;
    }
    __device__ __forceinline__ void a_ready(const Unit&) const {}
    __device__ __forceinline__ void done(const Unit&) const {}
};
struct ListOrder2G {
    int pb0, np0, n0, pb1, np1, n1, gs, j;
    __host__ __device__ void init(int pb0_, int np0_, int nN0, int pb1_, int np1_, int nN1, int gs_, int j_) { pb0 = pb0_; np0 = np0_; n0 = np0_ * nN0; pb1 = pb1_; np1 = np1_; n1 = np1_ * nN1; gs = gs_; j = j_; }
    __host__ __device__ bool next(int i, Unit& u) const {
        int L = i * gs + j; if (L >= n0 + n1) return false;
        if (L < n0) { u.pm = pb0 + L % np0; u.pn = L / np0; } else { L -= n0; u.pm = pb1 + L % np1; u.pn = (L / np1) | 0x10000; }
        return true;
    }
    __device__ __forceinline__ void a_ready(const Unit&) const {}
    __device__ __forceinline__ void done(const Unit&) const {}
};
__device__ __forceinline__ unsigned cvt_pk_bf16(float lo, float hi) { unsigned r; asm volatile("v_cvt_pk_bf16_f32 %0, %1, %2" : "=v"(r) : "v"(lo), "v"(hi)); return r; }
typedef float f32x2 __attribute__((ext_vector_type(2)));
#ifndef FP8_DIAG_NONSCALED
#define FP8_DIAG_NONSCALED 0
#endif
typedef int v4i_t __attribute__((ext_vector_type(4)));
typedef int v8i_t __attribute__((ext_vector_type(8)));
__device__ __forceinline__ v8i_t cat8(bf16x8 a, bf16x8 b) { return __builtin_shufflevector(__builtin_bit_cast(v4i_t, a), __builtin_bit_cast(v4i_t, b), 0, 1, 2, 3, 4, 5, 6, 7); }
template <class Epi, class Sched, bool ALIGN_EPI = false, bool SP2 = false, bool FP8 = false, bool MULTI = false>
__device__ __forceinline__ void gemm_phase(PG8_LAS unsigned char* lds, const Gemm g, const Sched& S, const Epi& E, const int wv, const Gemm g1 = Gemm{nullptr, nullptr, 0, 0, 0}) {
    const int tid = otid(wv), wid = wv, lane = tid & 63, wr = wid >> 2, wc = wid & 3, fr = lane & 15, fq = lane >> 4;
    unsigned voffA[2], voffB[2], vRA[2], vRB[2], vC[2];
#pragma unroll
    for (int i = 0; i < 2; ++i) { int R, C; stage_rc(tid * 16 + i * 8192, R, C); const int Rb = Epi::PERM ? ((R & ~31) + perm32(R & 31)) : R;
        vRA[i] = (unsigned)R * 2u; vRB[i] = (unsigned)Rb * 2u; vC[i] = (unsigned)C * 2u; }
    const size_t kstep = (size_t)(BK * 2);
#define PG8_VA(i) (MULTI ? vRA[i] * (unsigned)K + vC[i] : voffA[i])
#define PG8_VB(i) (MULTI ? vRB[i] * (unsigned)K + vC[i] : voffB[i])
#define PG8_VA2(i) (MULTI ? vRA[i] * (unsigned)K2 + vC[i] : voffA[i])
#define PG8_VB2(i) (MULTI ? vRB[i] * (unsigned)K2 + vC[i] : voffB[i])
#define PG8_GK(u) ((MULTI && ((u).pn >> 16)) ? g1.K : g.K)
#define PG8_GA(u) ((MULTI && ((u).pn >> 16)) ? (const char*)g1.A : (const char*)g.A)
#define PG8_GB(u) ((MULTI && ((u).pn >> 16)) ? (const char*)g1.Bt : (const char*)g.Bt)
    const unsigned ldsw = (unsigned)wid * 1024u; const unsigned ldsbase = (unsigned)__builtin_amdgcn_readfirstlane((int)((unsigned)(uintptr_t)lds + ldsw));
    const int aoff = lds_byte(wr * 64 + fr, fq * 8), boff = lds_byte(wc * 32 + fr, fq * 8);
#define PG8_SA(b, h) (((b) * 2 + (h)) * HTB)
#define PG8_SB(b, h) ((4 + (b) * 2 + (h)) * HTB)
#define PG8_STAGE(bufoff, gbase, voff) do { _Pragma("unroll") for (int _i = 0; _i < 2; ++_i) { unsigned keep_; \
        asm volatile("s_mov_b32 %0, m0\n\ts_add_u32 m0, %3, %4\n\ts_nop 2\n\tglobal_load_lds_dwordx4 %1, %2\n\ts_mov_b32 m0, %0"     \
            : "=&s"(keep_) : "v"(voff(_i)), "s"(uni64((const char*)(gbase))), "s"(ldsbase), "i"((bufoff) + _i * 8192) : "memory", "scc"); } } while (0)
#define PG8_LDA(dst, b, h) do { _Pragma("unroll") for (int m = 0; m < 4; ++m) { if constexpr (FP8) dst##8[m] = cat8(*(const PG8_LAS bf16x8*)(lds + PG8_SA(b, h) + aoff + m * 2048), *(const PG8_LAS bf16x8*)(lds + PG8_SA(b, h) + aoff + m * 2048 + 1024)); \
        else { _Pragma("unroll") for (int k = 0; k < 2; ++k) dst[m][k] = *(const PG8_LAS bf16x8*)(lds + PG8_SA(b, h) + aoff + m * 2048 + k * 1024); } } } while (0)
#define PG8_LDB(dst, b, h) do { _Pragma("unroll") for (int n = 0; n < 2; ++n) { if constexpr (FP8) dst##8[n] = cat8(*(const PG8_LAS bf16x8*)(lds + PG8_SB(b, h) + boff + n * 2048), *(const PG8_LAS bf16x8*)(lds + PG8_SB(b, h) + boff + n * 2048 + 1024)); \
        else { _Pragma("unroll") for (int k = 0; k < 2; ++k) dst[n][k] = *(const PG8_LAS bf16x8*)(lds + PG8_SB(b, h) + boff + n * 2048 + k * 1024); } } } while (0)
#define PG8_MMA(ai, bj, At, Bt) do { __builtin_amdgcn_s_setprio(1); _Pragma("unroll") for (int m = 0; m < 4; ++m) _Pragma("unroll") for (int n = 0; n < 2; ++n) { \
        if constexpr (FP8) { if constexpr (FP8_DIAG_NONSCALED) { _Pragma("unroll") for (int q_ = 0; q_ < 4; ++q_) { \
            const long bq_ = ((long)(unsigned)Bt##8[n][2 * q_ + 1] << 32) | (unsigned)Bt##8[n][2 * q_], aq_ = ((long)(unsigned)At##8[m][2 * q_ + 1] << 32) | (unsigned)At##8[m][2 * q_]; \
            acc[ai][bj][m][n] = __builtin_amdgcn_mfma_f32_16x16x32_fp8_fp8(bq_, aq_, acc[ai][bj][m][n], 0, 0, 0); } } \
          else asm volatile("v_mfma_scale_f32_16x16x128_f8f6f4 %0, %1, %2, %0, %3, %3 op_sel_hi:[0,0,0]" : "+v"(acc[ai][bj][m][n]) : "v"(Bt##8[n]), "v"(At##8[m]), "v"(scl1)); }   \
        else { _Pragma("unroll") for (int k = 0; k < 2; ++k) acc[ai][bj][m][n] = __builtin_amdgcn_mfma_f32_16x16x32_bf16(Bt[n][k], At[m][k], acc[ai][bj][m][n], 0, 0, 0); } } __builtin_amdgcn_s_setprio(0); } while (0)
#define PG8_WAIT_V(n) asm volatile("s_waitcnt vmcnt(" #n ")" ::: "memory")
#define PG8_WAIT_L(n) asm volatile("s_waitcnt lgkmcnt(" #n ")" ::: "memory")
#define PG8_BAR __builtin_amdgcn_s_barrier()
#define PG8_SCHED __builtin_amdgcn_sched_barrier(0)
    Unit cur, nxt; int ui = 0;
    if (!S.next(0, cur)) return;
    int K = PG8_GK(cur), nt = K / BK;
    size_t hstep = (size_t)HALF * K * 2;
#pragma unroll
    for (int i = 0; i < 2; ++i) { voffA[i] = vRA[i] * (unsigned)K + vC[i]; voffB[i] = vRB[i] * (unsigned)K + vC[i]; }
    f32x4 acc[2][2][4][2];
#pragma unroll
    for (int a = 0; a < 2; ++a)
#pragma unroll
        for (int b = 0; b < 2; ++b)
#pragma unroll
            for (int m = 0; m < 4; ++m)
#pragma unroll
                for (int n = 0; n < 2; ++n) acc[a][b][m][n] = (f32x4){0.f, 0.f, 0.f, 0.f};
    bf16x8 At[4][2], B0[2][2], B1[2][2]; v8i_t At8[4], B08[2], B18[2]; int scl1 = 0x7F7F7F7F; asm volatile("" : "+v"(scl1));
    const char* cA = PG8_GA(cur) + (size_t)cur.pm * 2 * hstep; const char* cB = PG8_GB(cur) + (size_t)(cur.pn & 0xffff) * 2 * hstep;
    S.a_ready(cur);
    if constexpr (SP2) {
        PG8_STAGE(PG8_SB(0, 0), cB, PG8_VB); PG8_STAGE(PG8_SB(0, 1), cB + hstep, PG8_VB); PG8_STAGE(PG8_SA(0, 0), cA, PG8_VA); PG8_STAGE(PG8_SA(0, 1), cA + hstep, PG8_VA);
        if (wr == 1) PG8_BAR;
        PG8_WAIT_V(2); PG8_BAR;
        PG8_STAGE(PG8_SB(1, 0), cB + kstep, PG8_VB); PG8_STAGE(PG8_SA(1, 0), cA + kstep, PG8_VA); PG8_STAGE(PG8_SB(1, 1), cB + hstep + kstep, PG8_VB);
        PG8_WAIT_V(6); PG8_BAR;
    } else {
        PG8_STAGE(PG8_SB(0, 0), cB, PG8_VB); PG8_STAGE(PG8_SA(0, 0), cA, PG8_VA); PG8_STAGE(PG8_SB(0, 1), cB + hstep, PG8_VB); PG8_STAGE(PG8_SA(0, 1), cA + hstep, PG8_VA);
        if (wr == 1) PG8_BAR;
        PG8_WAIT_V(4); PG8_BAR;
        PG8_STAGE(PG8_SB(1, 0), cB + kstep, PG8_VB); PG8_STAGE(PG8_SA(1, 0), cA + kstep, PG8_VA); PG8_STAGE(PG8_SB(1, 1), cB + hstep + kstep, PG8_VB);
        PG8_WAIT_V(6); PG8_BAR;
    }
    for (;;) {
        const bool has_next = S.next(ui + 1, nxt);
        int Kn = K; size_t hstepn = hstep;
        if constexpr (MULTI) { if (has_next) { Kn = PG8_GK(nxt); hstepn = (size_t)HALF * Kn * 2; } }
        const char* nA = has_next ? PG8_GA(nxt) + (size_t)nxt.pm * 2 * hstepn : cA; const char* nB = has_next ? PG8_GB(nxt) + (size_t)(nxt.pn & 0xffff) * 2 * hstepn : cB;
#pragma unroll 1
        for (int t = 0; t < nt; t += 2) {
            const bool last = (t == nt - 2);
            const char* a1 = cA + (size_t)(t + 1) * kstep;
            const char* a2 = last ? nA : cA + (size_t)(t + 2) * kstep; const char* b2 = last ? nB : cB + (size_t)(t + 2) * kstep;
            const char* a3 = a2 + kstep; const char* b3 = b2 + kstep;
            const int K2 = (MULTI && last) ? Kn : K; const size_t hs2 = (MULTI && last) ? hstepn : hstep;
            if (last && has_next) S.a_ready(nxt);
            if constexpr (SP2) {
            PG8_LDB(B0, 0, 0); PG8_LDB(B1, 0, 1); PG8_SCHED; PG8_LDA(At, 0, 0); PG8_STAGE(PG8_SA(1, 1), a1 + hstep, PG8_VA);
            PG8_WAIT_V(8); PG8_WAIT_L(0); PG8_BAR; PG8_MMA(0, 0, At, B0); PG8_MMA(0, 1, At, B1); PG8_BAR; PG8_SCHED;
            PG8_LDA(At, 0, 1); PG8_STAGE(PG8_SB(0, 0), b2, PG8_VB2); PG8_STAGE(PG8_SB(0, 1), b2 + hs2, PG8_VB2); PG8_STAGE(PG8_SA(0, 0), a2, PG8_VA2);
            PG8_WAIT_V(8); PG8_WAIT_L(0); PG8_BAR; PG8_MMA(1, 0, At, B0); PG8_MMA(1, 1, At, B1); PG8_BAR; PG8_SCHED;
            PG8_LDB(B0, 1, 0); PG8_LDB(B1, 1, 1); PG8_SCHED; PG8_LDA(At, 1, 0); PG8_STAGE(PG8_SA(0, 1), a2 + hs2, PG8_VA2);
            PG8_WAIT_V(8); PG8_WAIT_L(0); PG8_BAR; PG8_MMA(0, 0, At, B0); PG8_MMA(0, 1, At, B1); PG8_BAR; PG8_SCHED;
            PG8_LDA(At, 1, 1); PG8_STAGE(PG8_SB(1, 0), b3, PG8_VB2); PG8_STAGE(PG8_SB(1, 1), b3 + hs2, PG8_VB2); PG8_STAGE(PG8_SA(1, 0), a3, PG8_VA2);
            PG8_WAIT_V(8); PG8_WAIT_L(0); PG8_BAR; PG8_MMA(1, 0, At, B0); PG8_MMA(1, 1, At, B1); PG8_BAR; PG8_SCHED;
            } else {
            PG8_LDB(B0, 0, 0); PG8_SCHED; PG8_LDA(At, 0, 0); PG8_STAGE(PG8_SA(1, 1), a1 + hstep, PG8_VA);
            PG8_WAIT_L(8); PG8_BAR; PG8_WAIT_L(0); PG8_MMA(0, 0, At, B0); PG8_BAR; PG8_SCHED;
            PG8_LDB(B1, 0, 1); PG8_STAGE(PG8_SB(0, 0), b2, PG8_VB2);
            PG8_BAR; PG8_WAIT_L(0); PG8_MMA(0, 1, At, B1); PG8_BAR;
            PG8_LDA(At, 0, 1); PG8_STAGE(PG8_SA(0, 0), a2, PG8_VA2);
            PG8_BAR; PG8_WAIT_L(0); PG8_MMA(1, 0, At, B0); PG8_BAR; PG8_SCHED;
            PG8_STAGE(PG8_SB(0, 1), b2 + hs2, PG8_VB2);
            PG8_WAIT_V(6); PG8_BAR; PG8_MMA(1, 1, At, B1); PG8_BAR;
            PG8_LDB(B0, 1, 0); PG8_SCHED; PG8_LDA(At, 1, 0); PG8_STAGE(PG8_SA(0, 1), a2 + hs2, PG8_VA2);
            PG8_WAIT_L(8); PG8_BAR; PG8_WAIT_L(0); PG8_MMA(0, 0, At, B0); PG8_BAR; PG8_SCHED;
            PG8_LDB(B1, 1, 1); PG8_STAGE(PG8_SB(1, 0), b3, PG8_VB2);
            PG8_BAR; PG8_WAIT_L(0); PG8_MMA(0, 1, At, B1); PG8_BAR;
            PG8_LDA(At, 1, 1); PG8_STAGE(PG8_SA(1, 0), a3, PG8_VA2);
            PG8_BAR; PG8_WAIT_L(0); PG8_MMA(1, 0, At, B0); PG8_BAR; PG8_SCHED;
            PG8_STAGE(PG8_SB(1, 1), b3 + hs2, PG8_VB2);
            PG8_WAIT_V(6); PG8_BAR; PG8_MMA(1, 1, At, B1); PG8_BAR;
            }
        }
        if constexpr (FP8) asm volatile("s_nop 15\n\ts_nop 15" ::: "memory");
        if constexpr (ALIGN_EPI) { if (wr == 0) PG8_BAR; }
        if constexpr (!Epi::AFTER_DRAIN) { E(acc, cur, wr, wc, fr, fq); if constexpr (Epi::REP) { asm volatile("" ::: "memory"); const Epi E2_ = E.rep(); E2_(acc, cur, wr, wc, fr, fq); } S.done(cur); }
        if (!has_next) break;
#pragma unroll
        for (int a = 0; a < 2; ++a)
#pragma unroll
            for (int b = 0; b < 2; ++b)
#pragma unroll
                for (int m = 0; m < 4; ++m)
#pragma unroll
                    for (int n = 0; n < 2; ++n) acc[a][b][m][n] = (f32x4){0.f, 0.f, 0.f, 0.f};
        cur = nxt; cA = nA; cB = nB; ++ui;
        if constexpr (MULTI) { K = Kn; nt = K / BK; hstep = hstepn; }
        if constexpr (ALIGN_EPI) { if (wr == 1) PG8_BAR; }
    }
    PG8_WAIT_V(0);
    if constexpr (!ALIGN_EPI) { if (wr == 0) PG8_BAR; }
    PG8_BAR;
    if constexpr (Epi::AFTER_DRAIN) { E.fused(acc, cur, wr, wc, fr, fq, lds, wid, lane); S.done(cur); }
#undef PG8_VA
#undef PG8_VB
#undef PG8_VA2
#undef PG8_VB2
#undef PG8_GK
#undef PG8_GA
#undef PG8_GB
#undef PG8_SA
#undef PG8_SB
#undef PG8_STAGE
#undef PG8_LDA
#undef PG8_LDB
#undef PG8_MMA
#undef PG8_WAIT_V
#undef PG8_WAIT_L
#undef PG8_BAR
#undef PG8_SCHED
}
}
#define GAS __attribute__((address_space(1)))
#define LAS __attribute__((address_space(3)))
typedef unsigned short bf16;
typedef unsigned v4u __attribute__((ext_vector_type(4)));
typedef float f32x4 __attribute__((ext_vector_type(4)));
typedef short bf16x8 __attribute__((ext_vector_type(8)));
typedef GAS unsigned gu32;
typedef GAS unsigned long long gu64;
#define RLX_AGENT __ATOMIC_RELAXED, __HIP_MEMORY_SCOPE_AGENT
#define LDS_WAIT() asm volatile("s_waitcnt lgkmcnt(0)" ::: "memory")
#define VM_WAIT() asm volatile("s_waitcnt vmcnt(0)" ::: "memory")
__device__ __forceinline__ unsigned long long rt() { return __builtin_amdgcn_s_memrealtime(); }
__device__ __forceinline__ unsigned f2bf(float f) { unsigned u = __builtin_bit_cast(unsigned, f); return (u + 0x7fffu + ((u >> 16) & 1u)) >> 16; }
__device__ __forceinline__ unsigned pk2(float lo, float hi) { unsigned r; asm("v_cvt_pk_bf16_f32 %0, %1, %2" : "=v"(r) : "v"(lo), "v"(hi)); return r; }

#define XB_TMO      128
#define XB_XCNT(j)  (256  + 64 * (j))
#define XB_XSUB(j)  (1280 + 64 * (j))
#define XB_XGEN(j)  (2304 + 64 * (j))
#define XB_TOP      3328
#define XB_TOPGEN   3392
#define XCD_BAR_WORDS 3456
#define XB_SPIN_CAP (1u << 18)

__device__ __forceinline__ unsigned xb_ld(unsigned* p)              { return __hip_atomic_load(p, __ATOMIC_RELAXED, __HIP_MEMORY_SCOPE_AGENT); }
__device__ __forceinline__ unsigned xb_add(unsigned* p, unsigned v) { return __hip_atomic_fetch_add(p, v, __ATOMIC_RELAXED, __HIP_MEMORY_SCOPE_AGENT); }
__device__ __forceinline__ unsigned xb_xcc_id() { return (unsigned)__builtin_amdgcn_s_getreg((3 << 11) | 20) & 0xFu; }
#define XB_SPIN(cond, bar) do { unsigned _sp = 0; while (cond) { __builtin_amdgcn_s_sleep(1); \
    if ((++_sp & 255u) == 0u) { if (xb_ld(&(bar)[XB_TMO])) break; if (_sp > XB_SPIN_CAP) { atomicAdd(&(bar)[XB_TMO], 1u); break; } } } } while (0)

struct XcdBarrier {
    unsigned* bar; unsigned x; int wv;
    volatile LAS unsigned* st;
};

__device__ __forceinline__ XcdBarrier xcd_barrier_post(unsigned* bar, volatile LAS unsigned* st, const int wv) {
    XcdBarrier b; b.bar = bar; b.x = xb_xcc_id(); b.st = st; b.wv = wv;
    if (wv == 0 && olane() == 0) (void)xb_add(&bar[XB_XCNT(b.x)], 1u);
    return b;
}
__device__ __forceinline__ void xcd_barrier_complete(unsigned* bar, unsigned x, unsigned& nloc, unsigned& nx) {
    const unsigned G = gridDim.x * gridDim.y * gridDim.z;
    unsigned sum, cnt, mine, sp = 0u;
    for (;;) {
        sum = 0u; cnt = 0u; mine = 0u;
#pragma unroll
        for (unsigned j = 0; j < 16; ++j) { const unsigned c = xb_ld(&bar[XB_XCNT(j)]); sum += c; cnt += (c > 0u) ? 1u : 0u; mine = (j == x) ? c : mine; }
        if (sum == G) break;
        __builtin_amdgcn_s_sleep(1);
        if ((++sp & 255u) == 0u) { if (xb_ld(&bar[XB_TMO])) break; if (sp > XB_SPIN_CAP) { atomicAdd(&bar[XB_TMO], 1u); break; } }
    }
    nloc = mine > 0u ? mine : 1u; nx = cnt > 0u ? cnt : 1u;
}

__device__ __forceinline__ void xcd_barrier(const XcdBarrier& b) {
    asm volatile("s_waitcnt vmcnt(0)" ::: "memory");
    __syncthreads();
    if (b.wv == 0 && olane() == 0) {
        unsigned* bar = b.bar;
        __builtin_amdgcn_s_waitcnt(0);
        unsigned nloc = b.st[0], nx = b.st[1];
        if (nloc == 0u) { xcd_barrier_complete(bar, b.x, nloc, nx); b.st[0] = nloc; b.st[1] = nx; }
        const unsigned old = xb_add(&bar[XB_XSUB(b.x)], 1u);
        const unsigned gen = old / nloc;
        if (old + 1u == (gen + 1u) * nloc) {
            __builtin_amdgcn_fence(__ATOMIC_RELEASE, "agent");
            asm volatile("s_waitcnt vmcnt(0)" ::: "memory");
            const unsigned og = xb_add(&bar[XB_TOP], 1u);
            const unsigned tg = og / nx;
            if (og + 1u == (tg + 1u) * nx) xb_add(&bar[XB_TOPGEN], 1u);
            else XB_SPIN(xb_ld(&bar[XB_TOPGEN]) == tg, bar);
            __builtin_amdgcn_fence(__ATOMIC_ACQUIRE, "agent");
            xb_add(&bar[XB_XGEN(b.x)], 1u);
            asm volatile("s_waitcnt vmcnt(0)" ::: "memory");
        } else {
            XB_SPIN(xb_ld(&bar[XB_XGEN(b.x)]) == gen, bar);
            __builtin_amdgcn_fence(__ATOMIC_ACQUIRE, "agent");
            asm volatile("s_waitcnt vmcnt(0)" ::: "memory");
        }
    }
    __syncthreads();
}

struct GrpBarrier { unsigned* cnt; unsigned* tmo; unsigned target, step; int fast, wv; };
__device__ __forceinline__ void grp_barrier(GrpBarrier& gb) {
    asm volatile("s_waitcnt vmcnt(0)" ::: "memory");
    __syncthreads();
    gb.target += gb.step;
    if (gb.wv == 0 && olane() == 0) {
        __builtin_amdgcn_s_waitcnt(0);
        if (!gb.fast) { __builtin_amdgcn_fence(__ATOMIC_RELEASE, "agent"); asm volatile("s_waitcnt vmcnt(0)" ::: "memory"); }
        (void)xb_add(gb.cnt, 1u);
        { unsigned _sp = 0; while (xb_ld(gb.cnt) < gb.target) { __builtin_amdgcn_s_sleep(1);
            if ((++_sp & 255u) == 0u) { if (xb_ld(gb.tmo)) break; if (_sp > XB_SPIN_CAP) { atomicAdd(gb.tmo, 1u); break; } } } }
        __builtin_amdgcn_fence(__ATOMIC_ACQUIRE, "agent");
        asm volatile("s_waitcnt vmcnt(0)" ::: "memory");
    }
    __syncthreads();
}

typedef float f32x16 __attribute__((ext_vector_type(16)));
typedef short s16x4 __attribute__((ext_vector_type(4)));
typedef float f32x2v __attribute__((ext_vector_type(2)));

constexpr int M = 16384, DM = 2048, SEQ = 2048, NB = 8, NPROJ = 5120, DFF = 5632, MEMR = 2048, NIN = 4932;
constexpr float EPS = 1e-6f;
constexpr float LOG2E = 1.4426950408889634f;
constexpr float QS128 = 0.08838834764831845f * LOG2E;
constexpr float QS192 = 0.07216878364870322f * LOG2E;
constexpr int NWAVES = 8;

constexpr int PC_FQ = 0, PC_FK = 512, PC_FV = 1024, PC_MCQ = 1536, PC_MCKV = 2048, PC_MKR = 2304, PC_FF = 2368,
              PC_GU = 2560, PC_GV = 3072, PC_BQ = 3584, PC_BK = 4096, PC_BV = 4608;

constexpr size_t MiB = 1u << 20;
constexpr size_t WS_CTL = 683 * MiB + 1536 * 1024;
constexpr size_t WS_W = 1 * MiB, WL_STRIDE = 104 * MiB;
constexpr size_t WO_IN = 0, WO_OUT = 20 * MiB, WO_XQ = 28 * MiB, WO_XKV = 30 * MiB, WO_XO = 34 * MiB, WO_GU = 36 * MiB, WO_D = 80 * MiB,
                 WO_UQ = 102 * MiB, WO_UKV = 102 * MiB + 768 * 1024;
constexpr size_t WS_XB = 209 * MiB, WS_PROJ = 273 * MiB, WS_OMIX = 449 * MiB, WS_CQN = 513 * MiB, WS_CKVN = 529 * MiB, WS_QM = 537 * MiB,
                 WS_KVM = 561 * MiB, WS_XQ = 593 * MiB, WS_XO = 609 * MiB, WS_XKV = 625 * MiB, WS_MEMB = 633 * MiB, WS_FKA = 641 * MiB,
                 WS_BQA = 643 * MiB, WS_BKA = 645 * MiB, WS_KPE = 646 * MiB, WS_LF = 648 * MiB, WS_LFSUM = 648 * MiB + 512 * 1024,
                 WS_ROPE = 649 * MiB, WS_FQA = 649 * MiB + 512 * 1024, WS_MEMSS = 649 * MiB + 768 * 1024, WS_GSTAT = 648 * MiB + 768 * 1024, WS_FBIAS = 648 * MiB + 256 * 1024  , WS_TRIL = 650 * MiB, WS_X8 = 651 * MiB, WS_ACC = 683 * MiB  , WS_END = 685 * MiB; constexpr size_t WS_X8_OLD_ALIAS = 513 * MiB  ;
constexpr int CW_TMO = 0, CW_BAR = 4096  , CW_Q = 8192  , CW_GB = 16384  , CW_COLO = 16384 + 512  ;

struct Params { const float* in[31]; float* out; unsigned char* ws; int ph_lo, ph_hi; };

typedef const float* const __attribute__((address_space(4)))* KIN;
struct Frame {
    LAS unsigned char* lds;
    int tid, lane, wave, vcu, G;
    KIN in; float* out; unsigned char* ws;
};

template <int CTRL> __device__ __forceinline__ float dppf(float v) { return __builtin_bit_cast(float, __builtin_amdgcn_update_dpp(0, __builtin_bit_cast(int, v), CTRL, 0xF, 0xF, true)); }
__device__ __forceinline__ float sum32(float v) { const unsigned x = __builtin_bit_cast(unsigned, v); auto r = __builtin_amdgcn_permlane32_swap(x, x, false, false); return __builtin_bit_cast(float, (unsigned)r[0]) + __builtin_bit_cast(float, (unsigned)r[1]); }
__device__ __forceinline__ float max32(float v) { const unsigned x = __builtin_bit_cast(unsigned, v); auto r = __builtin_amdgcn_permlane32_swap(x, x, false, false); return fmaxf(__builtin_bit_cast(float, (unsigned)r[0]), __builtin_bit_cast(float, (unsigned)r[1])); }
__device__ __forceinline__ float sum16(float v) { const unsigned x = __builtin_bit_cast(unsigned, v); auto r = __builtin_amdgcn_permlane16_swap(x, x, false, false); return __builtin_bit_cast(float, (unsigned)r[0]) + __builtin_bit_cast(float, (unsigned)r[1]); }
__device__ __forceinline__ float grp8_sum(float v) { v += dppf<0xB1>(v); v += dppf<0x4E>(v); v += dppf<0x141>(v); return v; }
__device__ __forceinline__ float grp16_sum(float v) { v = grp8_sum(v); v += dppf<0x140>(v); return v; }
__device__ __forceinline__ float wave_sum(float v) { return sum32(sum16(grp16_sum(v))); }
__device__ __forceinline__ float bf2f(unsigned short b) { return __uint_as_float(((unsigned)b) << 16); }
__device__ __forceinline__ float bflo(unsigned w) { return __uint_as_float(w << 16); }
__device__ __forceinline__ float bfhi(unsigned w) { return __uint_as_float(w & 0xffff0000u); }
__device__ __forceinline__ void unpack8(const v4u raw, float (&x)[8]) { x[0] = bflo(raw.x); x[1] = bfhi(raw.x); x[2] = bflo(raw.y); x[3] = bfhi(raw.y); x[4] = bflo(raw.z); x[5] = bfhi(raw.z); x[6] = bflo(raw.w); x[7] = bfhi(raw.w); }
__device__ __forceinline__ v4u pack8f(const float (&x)[8]) { v4u o; o.x = pk2(x[0], x[1]); o.y = pk2(x[2], x[3]); o.z = pk2(x[4], x[5]); o.w = pk2(x[6], x[7]); return o; }
__device__ __forceinline__ float fp8clamp(float v) { return __builtin_amdgcn_fmed3f(v, -448.f, 448.f); }
__device__ __forceinline__ uint2 pack8_fp8(const float (&x)[8], float sc) {
    unsigned a = 0, c = 0;
    a = __builtin_amdgcn_cvt_pk_fp8_f32(fp8clamp(x[0] * sc), fp8clamp(x[1] * sc), a, false); a = __builtin_amdgcn_cvt_pk_fp8_f32(fp8clamp(x[2] * sc), fp8clamp(x[3] * sc), a, true);
    c = __builtin_amdgcn_cvt_pk_fp8_f32(fp8clamp(x[4] * sc), fp8clamp(x[5] * sc), c, false); c = __builtin_amdgcn_cvt_pk_fp8_f32(fp8clamp(x[6] * sc), fp8clamp(x[7] * sc), c, true);
    uint2 r; r.x = a; r.y = c; return r;
}
__device__ __forceinline__ float gelu_tanh(float x) {
    const float u = 0.7978845608028654f * (x + 0.044715f * x * x * x);
    const float e = __builtin_amdgcn_exp2f(u * 2.8853900817779268f);
    return x * (1.f - __builtin_amdgcn_rcpf(e + 1.f));
}
__device__ __forceinline__ float silu_f(float x) { return x * __builtin_amdgcn_rcpf(1.f + __builtin_amdgcn_exp2f(x * -1.4426950408889634f)); }
__device__ __forceinline__ float log_sigmoid_f(float x) { return fminf(x, 0.f) - log1pf(expf(-fabsf(x))); }

__device__ __forceinline__ bf16* wptr(unsigned char* ws, int l, size_t off) { return (bf16*)(ws + WS_W + (size_t)l * WL_STRIDE + off); }
typedef unsigned long long u64;
constexpr float SS_FIX = 1048576.f, SS_INV = 1.f / 1048576.f, KM_FIX = 1073741824.f, KM_INV = 1.f / 1073741824.f;
__device__ __forceinline__ u64* ss_ptr(unsigned char* ws, int k) { return (u64*)(ws + WS_ACC) + (size_t)k * M; }

__device__ __forceinline__ int queue_next(gu32* ctr, LAS unsigned* slot, const int wv) {
    __syncthreads();
    if (wv == 0 && olane() == 0) *slot = __hip_atomic_fetch_add(ctr, 1u, __ATOMIC_RELAXED, __HIP_MEMORY_SCOPE_AGENT);
    __syncthreads();
    return (int)*slot;
}

#ifndef REP_EPI_SCALE
#define REP_EPI_SCALE 0
#endif
#ifndef REP_EPI_SWIGLU
#define REP_EPI_SWIGLU 0
#endif
struct EpiScale {
    static constexpr bool PERM = true, AFTER_DRAIN = false, REP = REP_EPI_SCALE;
    __device__ __forceinline__ EpiScale rep() const { return *this; }
    bf16* O; int ldc; const u64* ss; float inv_kn; float oscale;
    const float* kng; LAS float* knp;
    int hn_t0, hn_t1; const float* hn_g0; const float* hn_g1; int hw_t; const float* hw_g; bf16* hw_o; int cq_t; bf16* cq_o; u64* cq_ss; int hq_t0, hq_t1; const float* hq_g0; const float* hq_g1; float hq_mul;
    __device__ __forceinline__ void operator()(const pg8::f32x4 (&acc)[2][2][4][2], const pg8::Unit& u, int wr_, int wc_, int fr_, int fq_) const {
        const int ot_ = olane(), wr = wr_, wc = wc_, fr = ot_ & 15, fq = ot_ >> 4;
        const int row0 = u.pm * 256 + wr * 64 + fr, col0 = u.pn * 256 + wc * 32 + 8 * fq;
        if (kng) {
#pragma unroll
            for (int ai = 0; ai < 2; ++ai)
#pragma unroll
                for (int m = 0; m < 4; ++m) {
                    const pg8::f32x4 a0 = acc[ai][0][m][0], a1 = acc[ai][0][m][1];
                    float s = (a0[0] * a0[0] + a0[1] * a0[1]) + (a0[2] * a0[2] + a0[3] * a0[3]) + (a1[0] * a1[0] + a1[1] * a1[1]) + (a1[2] * a1[2] + a1[3] * a1[3]);
                    s = sum32(sum16(s));
                    if (fq == 0) knp[(ai * 128 + wr * 64 + m * 16 + fr) * 4 + wc] = s;
                }
            __syncthreads();
            float kg8[8];
#pragma unroll
            for (int e = 0; e < 8; ++e) kg8[e] = kng[wc * 32 + 8 * fq + e];
#pragma unroll
            for (int ai = 0; ai < 2; ++ai)
#pragma unroll
                for (int m = 0; m < 4; ++m) {
                    const int row = row0 + ai * 128 + m * 16;
                    const pg8::f32x4 pt = *(const LAS pg8::f32x4*)(knp + (ai * 128 + wr * 64 + m * 16 + fr) * 4);
                    const float rs = rsqrtf(((pt[0] + pt[1]) + (pt[2] + pt[3])) * (1.f / 128.f) + EPS);
                    bf16* rowp = O + (size_t)row * ldc + col0;
                    { const pg8::f32x4 v0 = acc[ai][0][m][0] * rs, v1 = acc[ai][0][m][1] * rs;
                      v4u w; w.x = pg8::cvt_pk_bf16(v0[0] * kg8[0], v0[1] * kg8[1]); w.y = pg8::cvt_pk_bf16(v0[2] * kg8[2], v0[3] * kg8[3]); w.z = pg8::cvt_pk_bf16(v1[0] * kg8[4], v1[1] * kg8[5]); w.w = pg8::cvt_pk_bf16(v1[2] * kg8[6], v1[3] * kg8[7]);
                      *(v4u*)rowp = w; }
                    { const pg8::f32x4 v0 = acc[ai][1][m][0], v1 = acc[ai][1][m][1];
                      v4u w; w.x = pg8::cvt_pk_bf16(v0[0], v0[1]); w.y = pg8::cvt_pk_bf16(v0[2], v0[3]); w.z = pg8::cvt_pk_bf16(v1[0], v1[1]); w.w = pg8::cvt_pk_bf16(v1[2], v1[3]);
                      *(v4u*)(rowp + 128) = w; }
                }
            return;
        }
        if (cq_o && (u.pn == cq_t || u.pn == cq_t + 1)) {
            float scr_[2][4];
#pragma unroll
            for (int ai = 0; ai < 2; ++ai)
#pragma unroll
                for (int m = 0; m < 4; ++m) scr_[ai][m] = (float)ss[row0 + ai * 128 + m * 16];
#pragma unroll
            for (int ai = 0; ai < 2; ++ai)
#pragma unroll
                for (int m = 0; m < 4; ++m) {
                    const int row = row0 + ai * 128 + m * 16;
                    const float sc = rsqrtf(scr_[ai][m] * (SS_INV * inv_kn) + EPS) * oscale;
                    bf16* rowp = cq_o + (size_t)row * 512 + (u.pn - cq_t) * 256 + wc * 32 + 8 * fq;
                    float q = 0.f;
#pragma unroll
                    for (int bj = 0; bj < 2; ++bj) {
                        const pg8::f32x4 v0 = acc[ai][bj][m][0] * sc, v1 = acc[ai][bj][m][1] * sc;
                        q += (v0[0] * v0[0] + v0[1] * v0[1]) + (v0[2] * v0[2] + v0[3] * v0[3]) + (v1[0] * v1[0] + v1[1] * v1[1]) + (v1[2] * v1[2] + v1[3] * v1[3]);
                        v4u w; w.x = pg8::cvt_pk_bf16(v0[0], v0[1]); w.y = pg8::cvt_pk_bf16(v0[2], v0[3]); w.z = pg8::cvt_pk_bf16(v1[0], v1[1]); w.w = pg8::cvt_pk_bf16(v1[2], v1[3]);
                        *(v4u*)(rowp + bj * 128) = w;
                    }
                    q = sum32(sum16(q));
                    if (fq == 0) atomicAdd(cq_ss + row, (u64)(q * SS_FIX));
                }
            return;
        }
        { const bool wide = hw_g && u.pn == hw_t;
          const float* hgq = (hq_g0 && (u.pn == hq_t0 || u.pn == hq_t0 + 1)) ? hq_g0 : ((hq_g1 && (u.pn == hq_t1 || u.pn == hq_t1 + 1)) ? hq_g1 : nullptr);
          const float hmul = hgq ? hq_mul : 1.f;
          const float* hg = wide ? hw_g : (hgq ? hgq : ((hn_g0 && (u.pn == hn_t0 || u.pn == hn_t0 + 1)) ? hn_g0 : ((hn_g1 && (u.pn == hn_t1 || u.pn == hn_t1 + 1)) ? hn_g1 : nullptr)));
          if (hg) {
            float scr_[2][4];
#pragma unroll
            for (int ai = 0; ai < 2; ++ai)
#pragma unroll
                for (int m = 0; m < 4; ++m) scr_[ai][m] = (float)ss[row0 + ai * 128 + m * 16];
#pragma unroll
            for (int ai = 0; ai < 2; ++ai)
#pragma unroll
                for (int m = 0; m < 4; ++m)
#pragma unroll
                    for (int bj = 0; bj < 2; ++bj) {
                        const pg8::f32x4 a0 = acc[ai][bj][m][0], a1 = acc[ai][bj][m][1];
                        float s = (a0[0] * a0[0] + a0[1] * a0[1]) + (a0[2] * a0[2] + a0[3] * a0[3]) + (a1[0] * a1[0] + a1[1] * a1[1]) + (a1[2] * a1[2] + a1[3] * a1[3]);
                        s = sum32(sum16(s));
                        if (fq == 0) knp[((ai * 128 + wr * 64 + m * 16 + fr) * 2 + bj) * 4 + wc] = s;
                    }
            __syncthreads();
            float kg8[8], kg8b[8];
#pragma unroll
            for (int e = 0; e < 8; ++e) { kg8[e] = hg[wc * 32 + 8 * fq + e]; kg8b[e] = wide ? hg[128 + wc * 32 + 8 * fq + e] : kg8[e]; }
#pragma unroll
            for (int ai = 0; ai < 2; ++ai)
#pragma unroll
                for (int m = 0; m < 4; ++m) {
                    const int row = row0 + ai * 128 + m * 16;
                    const float sc = rsqrtf(scr_[ai][m] * (SS_INV * inv_kn) + EPS) * oscale;
                    bf16* rowp = wide ? hw_o + (size_t)row * 256 + wc * 32 + 8 * fq : O + (size_t)row * ldc + col0;
                    float totw = 0.f;
                    if (wide) { const pg8::f32x4 q0 = *(const LAS pg8::f32x4*)(knp + ((ai * 128 + wr * 64 + m * 16 + fr) * 2) * 4), q1 = *(const LAS pg8::f32x4*)(knp + ((ai * 128 + wr * 64 + m * 16 + fr) * 2 + 1) * 4); totw = ((q0[0] + q0[1]) + (q0[2] + q0[3])) + ((q1[0] + q1[1]) + (q1[2] + q1[3])); }
#pragma unroll
                    for (int bj = 0; bj < 2; ++bj) {
                        const pg8::f32x4 pt = *(const LAS pg8::f32x4*)(knp + ((ai * 128 + wr * 64 + m * 16 + fr) * 2 + bj) * 4);
                        const float rs = (wide ? rsqrtf(totw * (sc * sc) * (1.f / 256.f) + EPS) : rsqrtf(((pt[0] + pt[1]) + (pt[2] + pt[3])) * (sc * sc) * (1.f / 128.f) + EPS)) * sc * hmul;
                        const pg8::f32x4 v0 = acc[ai][bj][m][0] * rs, v1 = acc[ai][bj][m][1] * rs;
                        v4u w;
                        if (bj == 0) { w.x = pg8::cvt_pk_bf16(v0[0] * kg8[0], v0[1] * kg8[1]); w.y = pg8::cvt_pk_bf16(v0[2] * kg8[2], v0[3] * kg8[3]); w.z = pg8::cvt_pk_bf16(v1[0] * kg8[4], v1[1] * kg8[5]); w.w = pg8::cvt_pk_bf16(v1[2] * kg8[6], v1[3] * kg8[7]); }
                        else { w.x = pg8::cvt_pk_bf16(v0[0] * kg8b[0], v0[1] * kg8b[1]); w.y = pg8::cvt_pk_bf16(v0[2] * kg8b[2], v0[3] * kg8b[3]); w.z = pg8::cvt_pk_bf16(v1[0] * kg8b[4], v1[1] * kg8b[5]); w.w = pg8::cvt_pk_bf16(v1[2] * kg8b[6], v1[3] * kg8b[7]); }
                        *(v4u*)(rowp + bj * 128) = w;
                    }
                }
            return;
          } }
        float scv[2][4];
#pragma unroll
        for (int ai = 0; ai < 2; ++ai)
#pragma unroll
            for (int m = 0; m < 4; ++m) scv[ai][m] = ss ? (float)ss[row0 + ai * 128 + m * 16] : 0.f;
#pragma unroll
        for (int ai = 0; ai < 2; ++ai)
#pragma unroll
            for (int m = 0; m < 4; ++m) {
                const int row = row0 + ai * 128 + m * 16;
                const float sc = ss ? rsqrtf(scv[ai][m] * (SS_INV * inv_kn) + EPS) * oscale : oscale;
                bf16* rowp = O + (size_t)row * ldc + col0;
#pragma unroll
                for (int bj = 0; bj < 2; ++bj) {
                    const pg8::f32x4 v0 = acc[ai][bj][m][0] * sc, v1 = acc[ai][bj][m][1] * sc;
                    v4u w; w.x = pg8::cvt_pk_bf16(v0[0], v0[1]); w.y = pg8::cvt_pk_bf16(v0[2], v0[3]); w.z = pg8::cvt_pk_bf16(v1[0], v1[1]); w.w = pg8::cvt_pk_bf16(v1[2], v1[3]);
                    *(v4u*)(rowp + bj * 128) = w;
                }
            }
    }
};
struct EpiScale2 {
    static constexpr bool PERM = true, AFTER_DRAIN = false, REP = false;
    EpiScale e0, e1;
    __device__ __forceinline__ void operator()(const pg8::f32x4 (&acc)[2][2][4][2], const pg8::Unit& u, int wr, int wc, int fr, int fq) const { const EpiScale e = (u.pn >> 16) ? e1 : e0; pg8::Unit v; v.pm = u.pm; v.pn = u.pn & 0xffff; e(acc, v, wr, wc, fr, fq); }
};
#ifndef XATT_FP8
#define XATT_FP8 1
#endif
#ifndef FFN_FP8
#define FFN_FP8 3
#endif
constexpr float X8_SCALE = 4.f;
#ifndef REP_EPI_RESID
#define REP_EPI_RESID 0
#endif
struct EpiResid2 {
    static constexpr bool PERM = true, AFTER_DRAIN = false, REP = REP_EPI_RESID != 0;
    bf16* xb; u64* ssn; unsigned char* x8; float* outf; float ascale;
    __device__ __forceinline__ EpiResid2 rep() const { EpiResid2 e = *this; if (!outf) { e.ascale = 0.f; e.ssn = nullptr; } return e; }
    __device__ __forceinline__ void operator()(const pg8::f32x4 (&acc)[2][2][4][2], const pg8::Unit& u, int wr_, int wc_, int fr_, int fq_) const {
        const int ot_ = olane(), wr = wr_, wc = wc_, fr = ot_ & 15, fq = ot_ >> 4;
        const int row0 = u.pm * 256 + wr * 64 + fr, col0 = u.pn * 256 + wc * 32 + 8 * fq;
        v4u xin[2][2][2];
#define RESID_LOAD(b_) do { _Pragma("unroll") for (int mm = 0; mm < 2; ++mm) _Pragma("unroll") for (int bj = 0; bj < 2; ++bj) \
            xin[(b_) & 1][mm][bj] = *(const v4u*)(xb + (size_t)(row0 + ((b_) >> 1) * 128 + (2 * ((b_) & 1) + mm) * 16) * DM + col0 + bj * 128); } while (0)
        RESID_LOAD(0);
#pragma unroll
        for (int b = 0; b < 4; ++b) {
            if (b + 1 < 4) RESID_LOAD(b + 1);
            const int ai = b >> 1;
#pragma unroll
            for (int mm = 0; mm < 2; ++mm) {
                const int m = 2 * (b & 1) + mm;
                const int row = row0 + ai * 128 + m * 16; float q = 0.f;
#pragma unroll
                for (int bj = 0; bj < 2; ++bj) {
                    const size_t idx = (size_t)row * DM + col0 + bj * 128;
                    float x[8]; unpack8(xin[b & 1][mm][bj], x);
#pragma unroll
                    for (int e = 0; e < 4; ++e) { x[e] += acc[ai][bj][m][0][e] * ascale; x[4 + e] += acc[ai][bj][m][1][e] * ascale; }
                    if (!outf) *(v4u*)(xb + idx) = pack8f(x);
                    if (outf) { __builtin_nontemporal_store((pg8::f32x4){x[0], x[1], x[2], x[3]}, (pg8::f32x4*)(outf + idx)); __builtin_nontemporal_store((pg8::f32x4){x[4], x[5], x[6], x[7]}, (pg8::f32x4*)(outf + idx + 4)); }
                    if (x8) *(uint2*)(x8 + idx) = pack8_fp8(x, X8_SCALE);
#pragma unroll
                    for (int e = 0; e < 8; ++e) q += x[e] * x[e];
                }
                q = sum32(sum16(q));
                if (fq == 0 && !outf && ssn) atomicAdd(ssn + row, (u64)(q * SS_FIX));
#ifdef PROBE_DUP_ATOMICS
                if (fq == 0 && !outf && ssn) atomicAdd((u64*)((unsigned long long)ssn & ~0xFFFFFull) + 7 * M + row, (u64)(q * SS_FIX));
#endif
            }
        }
#undef RESID_LOAD
    }
};

constexpr float W8_SCALE = 256.f, ACT8_SCALE = 8.f, XO8_SCALE = 32.f;
template <bool OUT8> struct EpiSwiGLUx {
    static constexpr bool PERM = true, AFTER_DRAIN = false, REP = REP_EPI_SWIGLU;
    __device__ __forceinline__ EpiSwiGLUx rep() const { return *this; }
    void* O; const u64* ss; float insc;
    __device__ __forceinline__ void operator()(const pg8::f32x4 (&acc)[2][2][4][2], const pg8::Unit& u, int wr_, int wc_, int fr_, int fq_) const {
        typedef float f2 __attribute__((ext_vector_type(2)));
        const int ot_ = olane(), wr = wr_, wc = wc_, fr = ot_ & 15, fq = ot_ >> 4;
        const int row0 = u.pm * 256 + wr * 64 + fr, col0 = u.pn * 128 + wc * 32 + 8 * fq;
        float scv[2][4];
#pragma unroll
        for (int ai = 0; ai < 2; ++ai)
#pragma unroll
            for (int m = 0; m < 4; ++m) scv[ai][m] = (float)ss[row0 + ai * 128 + m * 16];
#pragma unroll
        for (int ai = 0; ai < 2; ++ai)
#pragma unroll
            for (int m = 0; m < 4; ++m) {
                const int row = row0 + ai * 128 + m * 16;
                const float sc = rsqrtf(scv[ai][m] * (SS_INV / DM) + EPS) * insc;
                const float nsl = sc * -1.4426950408889634f, c2 = OUT8 ? sc * sc * ACT8_SCALE : sc * sc;
                float o[8];
#pragma unroll
                for (int n = 0; n < 2; ++n)
#pragma unroll
                    for (int p = 0; p < 2; ++p) {
                        const f2 ga = {acc[ai][0][m][n][2 * p], acc[ai][0][m][n][2 * p + 1]}, ua = {acc[ai][1][m][n][2 * p], acc[ai][1][m][n][2 * p + 1]};
                        const f2 pr = ga * ua, t = ga * nsl;
                        f2 ex; ex.x = __builtin_amdgcn_exp2f(t.x); ex.y = __builtin_amdgcn_exp2f(t.y);
                        const f2 d = ex + 1.f; f2 r; r.x = __builtin_amdgcn_rcpf(d.x); r.y = __builtin_amdgcn_rcpf(d.y);
                        const f2 out = (pr * r) * c2;
                        o[n * 4 + 2 * p] = out.x; o[n * 4 + 2 * p + 1] = out.y;
                    }
                if constexpr (OUT8) *(uint2*)((unsigned char*)O + (size_t)row * DFF + col0) = pack8_fp8(o, 1.f);
                else *(v4u*)((bf16*)O + (size_t)row * DFF + col0) = pack8f(o);
            }
    }
};
struct WItem { const float* W; const float* gain; bf16* WT; int Nsrc, K, k0, srcc, valid, R0, f8; };
constexpr int ITEMS_L = 5120 + 2048 + 512 + 1024 + 512 + 11264 + 5632 + 192 + 128;
__device__ __forceinline__ WItem p0_decode(Frame& F, int git) {
    const int l = git >= ITEMS_L ? 1 : 0; int r = git - l * ITEMS_L;
    WItem d; d.gain = nullptr; d.f8 = 0; int ND, mode = 0;
    if (r < 5120) { d.W = F.in[3] + (size_t)l * DM * NIN; d.K = DM; d.Nsrc = NIN; ND = NPROJ; d.WT = wptr(F.ws, l, WO_IN); d.gain = F.in[2] + l * DM; mode = 1; }
    else if ((r -= 5120) < 2048) { d.W = F.in[20] + (size_t)l * DM * DM; d.K = DM; d.Nsrc = DM; ND = DM; d.WT = wptr(F.ws, l, WO_OUT); }
    else if ((r -= 2048) < 512) { d.W = F.in[23] + (size_t)l * DM * 512; d.K = DM; d.Nsrc = 512; ND = 512; d.WT = wptr(F.ws, l, WO_XQ); d.gain = F.in[21] + l * DM; d.f8 = XATT_FP8; }
    else if ((r -= 512) < 1024) { d.W = F.in[24] + (size_t)l * DM * 1024; d.K = DM; d.Nsrc = 1024; ND = 1024; d.WT = wptr(F.ws, l, WO_XKV); d.gain = F.in[22] + l * DM; d.f8 = XATT_FP8; }
    else if ((r -= 1024) < 512) { d.W = F.in[27] + (size_t)l * 512 * DM; d.K = 512; d.Nsrc = DM; ND = DM; d.WT = wptr(F.ws, l, WO_XO); d.f8 = XATT_FP8; }
    else if ((r -= 512) < 11264) { d.W = F.in[29] + (size_t)l * DM * 2 * DFF; d.K = DM; d.Nsrc = 2 * DFF; ND = 2 * DFF; d.WT = wptr(F.ws, l, WO_GU); d.gain = F.in[28] + l * DM; mode = 2; d.f8 = (FFN_FP8 & 1) != 0; }
    else if ((r -= 11264) < 5632) { d.W = F.in[30] + (size_t)l * DFF * DM; d.K = DFF; d.Nsrc = DM; ND = DM; d.WT = wptr(F.ws, l, WO_D); d.f8 = (FFN_FP8 & 2) != 0; }
    else if ((r -= 5632) < 192) { d.W = F.in[8] + (size_t)l * 512 * 768; d.K = 512; d.Nsrc = 768; ND = 768; d.WT = wptr(F.ws, l, WO_UQ); d.gain = F.in[7] + l * 512; }
    else { r -= 192; d.W = F.in[10] + (size_t)l * 256 * 1024; d.K = 256; d.Nsrc = 1024; ND = 1024; d.WT = wptr(F.ws, l, WO_UKV); }
    const int nblk = ND / 32, kb = r / nblk, nb = r - kb * nblk, R0 = nb * 32;
    int srcc = R0, valid = 32;
    if (mode == 1) {
        if (R0 < 1536) srcc = R0; else if (R0 < 2368) srcc = R0 + 4; else if (R0 == 2368) { srcc = 1536; valid = 4; } else if (R0 < 2560) { srcc = 0; valid = 0; } else srcc = R0 - 188;
    } else if (mode == 2) { const int pn = R0 >> 8, within = R0 & 255, half = within >> 7, j = within & 127; srcc = half * DFF + 128 * pn + j; }
    d.k0 = kb * 64; d.srcc = srcc; d.valid = valid; d.R0 = R0;
    return d;
}
__device__ __forceinline__ void tr_load(const WItem& d, int lane, float (&v)[32]) {
    const int n = lane & 31, nn = n < d.valid ? n : 0, kh = lane >> 5;
    const float* src = d.W + (size_t)(d.k0 + kh) * d.Nsrc + d.srcc + nn;
#pragma unroll
    for (int i = 0; i < 32; ++i) v[i] = __builtin_nontemporal_load(src + (size_t)(2 * i) * d.Nsrc);
}
__device__ __forceinline__ void tr_store(const WItem& d, const float (&v)[32], LAS float* scr, int lane) {
    const int n = lane & 31, kh = lane >> 5;
    const bool ok = n < d.valid;
#pragma unroll
    for (int i = 0; i < 32; ++i) scr[(2 * i + kh) * 33 + n] = ok ? v[i] : 0.f;
    LDS_WAIT(); asm volatile("" ::: "memory");
    const int c = lane & 7;
    float gk[8];
#pragma unroll
    for (int j = 0; j < 8; ++j) gk[j] = d.gain ? d.gain[d.k0 + 8 * c + j] : 1.f;
#pragma unroll
    for (int j = 0; j < 4; ++j) {
        const int nr = (lane >> 3) + 8 * j; const LAS float* s = scr + (8 * c) * 33 + nr;
        float xv[8];
#pragma unroll
        for (int e = 0; e < 8; ++e) xv[e] = s[e * 33] * gk[e];
        if (d.f8) *(uint2*)((unsigned char*)d.WT + (size_t)(d.R0 + nr) * d.K + d.k0 + 8 * c) = pack8_fp8(xv, W8_SCALE);
        else *(GAS v4u*)(d.WT + (size_t)(d.R0 + nr) * d.K + d.k0 + 8 * c) = pack8f(xv);
    }
    LDS_WAIT(); asm volatile("" ::: "memory");
}
__device__ __forceinline__ void p0_weights(Frame& F, int gw, int NGW) {
    LAS float* scr = (LAS float*)(F.lds + F.wave * 16384);
    int it = gw; if (it >= 2 * ITEMS_L) return;
    WItem cur = p0_decode(F, it); float v[32]; tr_load(cur, F.lane, v);
#pragma unroll 1
    for (;;) {
        const int itn = it + NGW; const bool hn = itn < 2 * ITEMS_L;
        WItem nxt; float vn[32];
        if (hn) { nxt = p0_decode(F, itn); tr_load(nxt, F.lane, vn); }
        tr_store(cur, v, scr, F.lane);
        if (!hn) break;
        cur = nxt; it = itn;
#pragma unroll
        for (int i = 0; i < 32; ++i) v[i] = vn[i];
    }
}
__device__ __forceinline__ void p0_xrow_load(Frame& F, int m, f32x4 (&v)[8]) {
    const bool isx = m < M; const int r = isx ? m : m - M;
    const float* src = (isx ? F.in[0] : F.in[1]) + (size_t)r * DM;
#pragma unroll
    for (int j = 0; j < 8; ++j) v[j] = __builtin_nontemporal_load((const f32x4*)(src + (j * 64 + F.lane) * 4));
}
__device__ __forceinline__ void p0_prologue(Frame& F) {
    const int gw = F.vcu * NWAVES + F.wave, NGW = F.G * NWAVES;
    p0_weights(F, gw, NGW);
    if (gw < M + MEMR) {
        int m = gw; f32x4 v[8]; p0_xrow_load(F, m, v);
#pragma unroll 1
        for (;;) {
            const int mn = m + NGW; const bool hn = mn < M + MEMR;
            f32x4 vn[8];
            if (hn) p0_xrow_load(F, mn, vn);
            const bool isx = m < M; const int r = isx ? m : m - M;
            bf16* dst = (bf16*)(F.ws + (isx ? WS_XB : WS_MEMB)) + (size_t)r * DM;
            float s = 0.f;
#pragma unroll
            for (int j = 0; j < 8; ++j) {
                s += (v[j][0] * v[j][0] + v[j][1] * v[j][1]) + (v[j][2] * v[j][2] + v[j][3] * v[j][3]);
                if (XATT_FP8 && !isx) { unsigned a8 = 0; a8 = __builtin_amdgcn_cvt_pk_fp8_f32(fp8clamp(v[j][0] * X8_SCALE), fp8clamp(v[j][1] * X8_SCALE), a8, false); a8 = __builtin_amdgcn_cvt_pk_fp8_f32(fp8clamp(v[j][2] * X8_SCALE), fp8clamp(v[j][3] * X8_SCALE), a8, true);
                    *(unsigned*)(F.ws + WS_MEMB + (size_t)r * DM + (j * 64 + F.lane) * 4) = a8; }
                else { uint2 w; w.x = pk2(v[j][0], v[j][1]); w.y = pk2(v[j][2], v[j][3]);
                *(uint2*)(dst + (j * 64 + F.lane) * 4) = w; }
            }
            s = wave_sum(s);
            if (F.lane == 0) { if (isx) ss_ptr(F.ws, 0)[r] = (u64)(s * SS_FIX); else ((u64*)(F.ws + WS_MEMSS))[r] = (u64)(s * SS_FIX); }
            if (!hn) break;
            m = mn;
#pragma unroll
            for (int j = 0; j < 8; ++j) v[j] = vn[j];
        }
    }
    float* rope = (float*)(F.ws + WS_ROPE);
    const int gt = (F.vcu * NWAVES + F.wave) * 64 + F.lane, NGT = NGW * 64;
    for (int idx = gt; idx < SEQ * 32; idx += NGT) {
        const int pos = idx >> 5, i = idx & 31;
        const float inv = powf(10000.f, -(float)i * (1.f / 32.f)); const float ang = (float)pos * inv;
        rope[2 * idx] = cosf(ang); rope[2 * idx + 1] = sinf(ang);
    }
    bf16* tril = (bf16*)(F.ws + WS_TRIL);
    for (int idx = gt; idx < 2 * 4 * 128 * 128; idx += NGT) { const int s = idx & 127, t = (idx >> 7) & 127; tril[idx] = (bf16)(s <= t ? f2bf(F.in[15][idx]) : 0u); }
    if (blockIdx.x == 0 && F.tid < 16) ((bf16*)(F.ws + WS_FQA))[F.tid] = F.tid < 3 ? (bf16)0x3F80 : (bf16)0;
}

__device__ __forceinline__ v4u headnorm8(v4u raw, const float* g, int d0, float sc, float* keep) {
    float x[8]; unpack8(raw, x);
    float s = 0.f;
#pragma unroll
    for (int j = 0; j < 8; ++j) s += x[j] * x[j];
    s = grp16_sum(s);
    const float rs = rsqrtf(s * (1.f / 128.f) + EPS) * sc;
#pragma unroll
    for (int j = 0; j < 8; ++j) { x[j] = x[j] * rs * g[d0 + j]; if (keep) keep[j] = x[j]; }
    return pack8f(x);
}
struct PrepRow { v4u bk, gv; unsigned short ff, mkr; };
__device__ __forceinline__ PrepRow prep_load(const bf16* pr, int lane) {
    PrepRow r;
    r.bk = *(const v4u*)(pr + PC_BK + lane * 8); r.gv = *(const v4u*)(pr + PC_GV + lane * 8);
    r.ff = pr[PC_FF + (lane & 3)]; r.mkr = pr[PC_MKR + lane];
    return r;
}
__device__ __forceinline__ void prep_phase(Frame& F, int l) {
    bf16* PROJ = (bf16*)(F.ws + WS_PROJ);
    const float* g_fk = F.in[6] + l * 128; const float* b_f = F.in[4] + l * 4;
    const float* g_ql = F.in[7] + l * 512; const float* g_kvl = F.in[9] + l * 256; const float* g_mk = F.in[12] + l * 192;
    const float* g_bk = F.in[18] + l * 128;
    bf16* CQN = (bf16*)(F.ws + WS_CQN); bf16* CKVN = (bf16*)(F.ws + WS_CKVN); bf16* KPE = (bf16*)(F.ws + WS_KPE); bf16* BKA = (bf16*)(F.ws + WS_BKA);
    float* LF = (float*)(F.ws + WS_LF); float* LFSUM = (float*)(F.ws + WS_LFSUM); const float* rope = (const float*)(F.ws + WS_ROPE); float* GSTAT = (float*)(F.ws + WS_GSTAT);
    u64* KMQ = (u64*)(F.ws + WS_ACC + MiB) + (size_t)l * (8 * 4 * 8 * 128);
    LAS float* red = (LAS float*)F.lds;
    const int lane = F.lane, d0 = (lane & 15) * 8;
    for (int unit = F.vcu; unit < M / 64; unit += F.G) {
        float ksum[8]; float lfs = 0.f;
#pragma unroll
        for (int j = 0; j < 8; ++j) ksum[j] = 0.f;
        const int mbase = unit * 64 + F.wave * 8;
        PrepRow cur = prep_load(PROJ + (size_t)mbase * NPROJ, lane);
#pragma unroll 1
        for (int i = 0; i < 8; ++i) {
            const int m = mbase + i, t = m & (SEQ - 1);
            bf16* pr = PROJ + (size_t)m * NPROJ;
            PrepRow nxt = cur;
            if (i + 1 < 8) nxt = prep_load(pr + NPROJ, lane);
            const f32x2v cs = *(const f32x2v*)(rope + (t * 32 + (lane & 31)) * 2);
            if (lane < 4) { const float v = log_sigmoid_f(bf2f(cur.ff) + b_f[lane]); LF[(size_t)m * 4 + lane] = v; lfs += v; }
            { float x = bf2f(cur.mkr); const float s = wave_sum(x * x); x = x * rsqrtf(s * (1.f / 64.f) + EPS) * g_mk[128 + lane];
              const float other = __shfl_xor(x, 32);
              const float o = lane < 32 ? x * cs[0] - other * cs[1] : other * cs[1] + x * cs[0];
              KPE[(size_t)m * 64 + lane] = (bf16)f2bf(o); }
            { float kf[8]; unpack8(cur.bk, kf);
#pragma unroll
              for (int j = 0; j < 8; ++j) ksum[j] += kf[j]; }
            if (lane < 16) BKA[(size_t)m * 16 + lane] = (lane == (t >> 8)) ? (bf16)0x3F80 : (bf16)0;
            { float x[8]; unpack8(cur.gv, x); float sm = 0.f;
#pragma unroll
              for (int j = 0; j < 8; ++j) { x[j] = gelu_tanh(x[j]); sm += x[j]; }
              const float mean = wave_sum(sm) * (1.f / 512.f); float q = 0.f;
#pragma unroll
              for (int j = 0; j < 8; ++j) { const float d = x[j] - mean; q += d * d; }
              const float var = wave_sum(q) * (1.f / 512.f); const float rstd = rsqrtf(var + EPS);
              const f32x4 lg0 = *(const f32x4*)(F.in[13] + l * 512 + lane * 8), lg1 = *(const f32x4*)(F.in[13] + l * 512 + lane * 8 + 4), lb0 = *(const f32x4*)(F.in[14] + l * 512 + lane * 8), lb1 = *(const f32x4*)(F.in[14] + l * 512 + lane * 8 + 4);
              float y[8];
#pragma unroll
              for (int j = 0; j < 4; ++j) { y[j] = (x[j] - mean) * rstd * lg0[j] + lb0[j]; y[4 + j] = (x[4 + j] - mean) * rstd * lg1[j] + lb1[j]; }
              *(v4u*)(pr + PC_GV + lane * 8) = pack8f(y); }
            cur = nxt;
        }
#pragma unroll
        for (int j = 0; j < 8; ++j) red[F.wave * 512 + lane * 8 + j] = ksum[j];
        if (lane < 4) red[4096 + F.wave * 4 + lane] = lfs;
        __syncthreads();
        {
            float s = 0.f;
#pragma unroll
            for (int w = 0; w < 8; ++w) s += red[w * 512 + F.tid];
            const int m0 = unit * 64, b = m0 >> 11, blk = (m0 & (SEQ - 1)) >> 8, h = F.tid >> 7, d = F.tid & 127;
            atomicAdd(KMQ + (((size_t)b * 4 + h) * 8 + blk) * 128 + d, (u64)(long long)(s * (KM_FIX / 256.f)));
            if (F.tid < 4) { float q = 0.f;
#pragma unroll
                for (int w = 0; w < 8; ++w) q += red[4096 + w * 4 + F.tid];
                LFSUM[unit * 4 + F.tid] = q; }
        }
        __syncthreads();
    }
}

constexpr int VNT_STRIDE = 272;
__device__ __forceinline__ void gmlp_unit(unsigned char* ws, KIN in, LAS unsigned char* lds, int l, int chunk, int g, const int wv) {
    const bf16* PROJ = (const bf16*)(ws + WS_PROJ); bf16* OMIX = (bf16*)(ws + WS_OMIX); const float* GSTAT = (const float*)(ws + WS_GSTAT);
    const float* ln_g = in[13] + l * 512; const float* ln_b = in[14] + l * 512; const float* b_s = in[16] + l * 4 * 128;
    const bf16* tril = (const bf16*)(ws + WS_TRIL) + ((size_t)l * 4 + g) * 128 * 128;
    LAS unsigned char* vnT = lds;
    const int tid = otid(wv), wave = wv, lane = tid & 63, r32 = lane & 31, hi = lane >> 5;
    const int m0 = chunk * 128;
    {
        const int s = tid >> 2, cq = tid & 3;
        const bf16* src = PROJ + (size_t)(m0 + s) * NPROJ + PC_GV + g * 128 + cq * 32;
        v4u raw[4];
#pragma unroll
        for (int k = 0; k < 4; ++k) raw[k] = *(const v4u*)(src + k * 8);
#pragma unroll
        for (int k = 0; k < 4; ++k) {
            float x[8]; unpack8(raw[k], x);
#pragma unroll
            for (int j = 0; j < 8; ++j) {
                const int c = cq * 32 + k * 8 + j, ch = g * 128 + c;
                const int c_ = ch; (void)c_;
                *(LAS bf16*)(vnT + c * VNT_STRIDE + s * 2) = (bf16)f2bf(x[j]);
            }
        }
    }
    __syncthreads();
    const int tb = wave >> 1, cb0 = (wave & 1) * 2;
    const int ch0 = g * 128 + 32 * cb0 + r32;
    unsigned short ur0[16], ur1[16];
#pragma unroll
    for (int i = 0; i < 16; ++i) {
        const int t = 32 * tb + (i & 3) + 8 * (i >> 2) + 4 * hi;
        const bf16* urow = PROJ + (size_t)(m0 + t) * NPROJ + PC_GU + ch0;
        ur0[i] = urow[0]; ur1[i] = urow[32];
    }
    f32x16 acc0 = {}, acc1 = {};
    const int trow = 32 * tb + r32;
    const bf16* wrow = tril + (size_t)trow * 128;
#pragma unroll 2
    for (int ks = 0; ks < 2 * (tb + 1); ++ks) {
        const int s0 = 16 * ks + 8 * hi;
        const bf16x8 afrag = *(const bf16x8*)(wrow + s0);
        const bf16x8 b0 = *(const LAS bf16x8*)(vnT + (32 * cb0 + r32) * VNT_STRIDE + s0 * 2);
        const bf16x8 b1 = *(const LAS bf16x8*)(vnT + (32 * (cb0 + 1) + r32) * VNT_STRIDE + s0 * 2);
        acc0 = __builtin_amdgcn_mfma_f32_32x32x16_bf16(afrag, b0, acc0, 0, 0, 0);
        acc1 = __builtin_amdgcn_mfma_f32_32x32x16_bf16(afrag, b1, acc1, 0, 0, 0);
    }
#pragma unroll
    for (int i = 0; i < 16; ++i) {
        const int t = 32 * tb + (i & 3) + 8 * (i >> 2) + 4 * hi;
        const float bs = b_s[g * 128 + t];
        bf16* op = OMIX + (size_t)(m0 + t) * DM + 1024 + ch0;
        op[0] = (bf16)f2bf(gelu_tanh(bf2f(ur0[i])) * (acc0[i] + bs));
        op[32] = (bf16)f2bf(gelu_tanh(bf2f(ur1[i])) * (acc1[i] + bs));
    }
    __syncthreads();
}

__device__ __forceinline__ void foxbias_phase(Frame& F) {
    const float* LF = (const float*)(F.ws + WS_LF); const float* LFSUM = (const float*)(F.ws + WS_LFSUM); bf16* FKA = (bf16*)(F.ws + WS_FKA);
    const int lane = F.lane;
    if (F.wave < 4)
    for (int unit = F.vcu; unit < M / 64; unit += F.G) {
        const int h = F.wave, u0 = unit & ~31, m = unit * 64 + lane;
        float pre = (u0 + lane < unit) ? LFSUM[(u0 + lane) * 4 + h] : 0.f;
        float v = LF[(size_t)m * 4 + h];
        pre = wave_sum(pre);
#pragma unroll
        for (int o = 1; o < 64; o <<= 1) { const float tt = __shfl_up(v, o); if (lane >= o) v += tt; }
        const float val = -(pre + v) * LOG2E;
        const unsigned b0 = f2bf(val); const float r1 = val - __uint_as_float(b0 << 16);
        const unsigned b1 = f2bf(r1); const float r2 = r1 - __uint_as_float(b1 << 16);
        const unsigned b2 = f2bf(r2);
        v4u w0 = {b0 | (b1 << 16), b2, 0u, 0u}, w1 = {0u, 0u, 0u, 0u};
        *(v4u*)(FKA + ((size_t)m * 4 + h) * 16) = w0; *(v4u*)(FKA + ((size_t)m * 4 + h) * 16 + 8) = w1;
        ((float*)(F.ws + WS_FBIAS))[(size_t)m * 4 + h] = val;
    }
}
__device__ __forceinline__ void gating_phase(Frame& F, int l, gu32* qctr, const int ubase, const int nunit) {
    const bf16* PROJ = (const bf16*)(F.ws + WS_PROJ); bf16* BQA = (bf16*)(F.ws + WS_BQA);
    const u64* KMQ = (const u64*)(F.ws + WS_ACC + MiB) + (size_t)l * (8 * 4 * 8 * 128);
    const float* gbq = F.in[17] + l * 128;
    constexpr int KMS = 256 + 16;
    LAS unsigned char* kmh = F.lds; LAS unsigned char* kml = F.lds + 32 * KMS;
    const int lane = F.lane, r32 = lane & 31, hi = lane >> 5;
    {   const int b = (ubase * 64) >> 11;
        for (int i = F.tid; i < 4 * 8 * 128; i += 512) {
            const float v = (float)(long long)KMQ[(size_t)b * 4096 + i] * KM_INV;
            const unsigned h16 = f2bf(v); const unsigned l16 = f2bf(v - __uint_as_float(h16 << 16));
            *(LAS bf16*)(kmh + (i >> 7) * KMS + (i & 127) * 2) = (bf16)h16; *(LAS bf16*)(kml + (i >> 7) * KMS + (i & 127) * 2) = (bf16)l16;
        }
    }
    LAS unsigned* slot = (LAS unsigned*)(F.lds + 131072 + 320 + 64);
    const int h = F.wave & 3, rb = F.wave >> 2;
    for (;;) {
        const int qi_ = queue_next(qctr, slot, F.wave); if (qi_ >= nunit) break;
        const int unit = ubase + qi_;
        const int m0 = unit * 64, blk = (m0 & (SEQ - 1)) >> 8, m = m0 + 32 * rb + r32;
        const bf16* qp = PROJ + (size_t)m * NPROJ + PC_BQ + h * 128 + hi * 8;
        bf16x8 q[8];
#pragma unroll
        for (int d0 = 0; d0 < 8; ++d0) q[d0] = *(const bf16x8*)(qp + d0 * 16);
        f32x16 acc = {};
        const LAS unsigned char* ah = kmh + (h * 8 + (r32 & 7)) * KMS + hi * 16; const LAS unsigned char* al = kml + (h * 8 + (r32 & 7)) * KMS + hi * 16;
#pragma unroll
        for (int d0 = 0; d0 < 8; ++d0) {
            acc = __builtin_amdgcn_mfma_f32_32x32x16_bf16(*(const LAS bf16x8*)(ah + d0 * 32), q[d0], acc, 0, 0, 0);
            acc = __builtin_amdgcn_mfma_f32_32x32x16_bf16(*(const LAS bf16x8*)(al + d0 * 32), q[d0], acc, 0, 0, 0);
        }
        float g[8];
#pragma unroll
        for (int i = 0; i < 4; ++i) { float ai_ = acc[i]; asm volatile("" : "+v"(ai_)); const unsigned x = __builtin_bit_cast(unsigned, ai_); auto r = __builtin_amdgcn_permlane32_swap(x, x, false, false); g[i] = __builtin_bit_cast(float, (unsigned)r[0]); g[4 + i] = __builtin_bit_cast(float, (unsigned)r[1]); }
#pragma unroll
        for (int n = 0; n < 8; ++n) g[n] = n < blk ? g[n] : -__builtin_inff();
        unsigned w[4] = {0u, 0u, 0u, 0u};
#pragma unroll
        for (int n = 0; n < 8; ++n) {
            int rank = 0;
#pragma unroll
            for (int on = 0; on < 8; ++on) if (on != n) rank += (g[on] > g[n] || (g[on] == g[n] && on < n)) ? 1 : 0;
            const bool masked = n < blk && !(blk <= 3 || rank < 3);
            w[n >> 1] |= masked ? (0xC700u << (16 * (n & 1))) : 0u;
        }
        if (hi == 0) { bf16* op = BQA + ((size_t)m * 4 + h) * 16; *(v4u*)op = (v4u){w[0], w[1], w[2], w[3]}; *(v4u*)(op + 8) = (v4u){0u, 0u, 0u, 0u}; }
    }
}
__device__ __forceinline__ void groupnorm_phase(Frame& F, int l) {
    bf16* OMIX = (bf16*)(F.ws + WS_OMIX); const float* gn = F.in[19] + l * 2048;
    const int lane = F.lane;
    f32x4 gg[4][2];
#pragma unroll
    for (int g = 0; g < 4; ++g) { gg[g][0] = *(const f32x4*)(gn + g * 512 + lane * 8); gg[g][1] = *(const f32x4*)(gn + g * 512 + lane * 8 + 4); }
#pragma unroll 1
    for (int unit = F.vcu; unit < M / 64; unit += F.G) {
        bf16* base = OMIX + (size_t)(unit * 64 + F.wave) * DM + lane * 8;
        v4u x4[8][4];
#pragma unroll
        for (int k = 0; k < 8; ++k)
#pragma unroll
            for (int g = 0; g < 4; ++g) x4[k][g] = *(const v4u*)(base + (size_t)(8 * k) * DM + g * 512);
#pragma unroll
        for (int k = 0; k < 8; ++k)
#pragma unroll
            for (int g = 0; g < 4; ++g) {
                float x[8]; unpack8(x4[k][g], x); float s = 0.f;
#pragma unroll
                for (int j = 0; j < 8; ++j) s += x[j] * x[j];
                const float rs = rsqrtf(wave_sum(s) * (1.f / 512.f) + EPS);
                x[0] *= rs * gg[g][0][0]; x[1] *= rs * gg[g][0][1]; x[2] *= rs * gg[g][0][2]; x[3] *= rs * gg[g][0][3]; x[4] *= rs * gg[g][1][0]; x[5] *= rs * gg[g][1][1]; x[6] *= rs * gg[g][1][2]; x[7] *= rs * gg[g][1][3];
                *(v4u*)(base + (size_t)(8 * k) * DM + g * 512) = pack8f(x);
            }
    }
}

struct AttnSpec {
    const bf16 *q0, *q1, *k0, *k1, *v; bf16* o;
    int pq0, pq1, pk0, pk1, pv, po;
    int hq0, hq1, hk0, hk1, hv, ho;
    int qrows, kvrows;
};
__device__ __forceinline__ int v_st(int k, int c) { const int kk = (k & ~0xC) | ((k & 4) << 1) | ((k & 8) >> 1); return ((kk >> 3) * 4 + (c >> 5)) * 512 + ((kk & 7) * 32 + (c & 31)) * 2; }
__device__ __forceinline__ int v_rd_base(int lane) { return ((lane & 3) << 3) | (((lane >> 2) & 3) << 6) | (((lane >> 4) & 1) << 5) | (((lane >> 5) & 1) << 8); }
__device__ __forceinline__ unsigned cvtpk(float lo, float hi) { unsigned r; asm volatile("v_cvt_pk_bf16_f32 %0, %1, %2" : "=v"(r) : "v"(lo), "v"(hi)); return r; }
#define SBAR() __builtin_amdgcn_sched_barrier(0)

template <int NKS, int NQ0, bool CAUSAL, int QMODE, bool KNORM, bool OUT8 = false>
__device__ __forceinline__ void attn_unit(LAS unsigned char* lds, const AttnSpec& S, int b, int h, int qb, const float* qgain, const float* kgain, const int wv, const float* rope = nullptr, const int t_lo = 0) {
    constexpr int NCH = 2 * NKS, KSTR = (NCH + 1) * 16, KBUF = 64 * KSTR, VBUF = 16384, NX = NCH - 16, NP = NX ? 3 : 2;
    const int tid = otid(wv), wid = wv, lane = tid & 63, r32 = lane & 31, hi = lane >> 5;
    LAS unsigned char* kbuf = lds; LAS unsigned char* vbuf = lds + 2 * KBUF;
    const int q_row0 = qb * 256, qlo = q_row0 + wid * 32, qpos = qlo + r32;
    const int NT = CAUSAL ? (q_row0 + 256) / 64 : S.kvrows / 64;
    const bf16* k0p = S.k0 + (size_t)b * S.kvrows * S.pk0 + h * S.hk0;
    const bf16* k1p = S.k1 + (size_t)b * S.kvrows * S.pk1 + h * S.hk1;
    const bf16* vp = S.v + (size_t)b * S.kvrows * S.pv + h * S.hv;
    bf16x8 qr[NKS];
    {
        const bf16* q0p = S.q0 + ((size_t)b * S.qrows + qpos) * S.pq0 + h * S.hq0;
        const bf16* q1p = S.q1 + ((size_t)b * S.qrows + qpos) * S.pq1 + h * S.hq1;
#pragma unroll
        for (int d0 = 0; d0 < NKS; ++d0) {
            if (2 * d0 < NQ0) qr[d0] = *(const bf16x8*)(q0p + (2 * d0 + hi) * 8);
            else qr[d0] = *(const bf16x8*)(q1p + (2 * d0 + hi - NQ0) * 8);
        }
    }
    v4u kst[NP], vst[2];
    int koff[NP], voff[2]; const bf16* ksrc[NP]; const bf16* vsrc[2]; int kpitch[NP];
#pragma unroll
    for (int i = 0; i < 2; ++i) { const int p = tid + 512 * i, row = p >> 4, ch = p & 15; koff[i] = row * KSTR + ch * 16; ksrc[i] = k0p + (size_t)row * S.pk0 + ch * 8; kpitch[i] = S.pk0; }
    if constexpr (NX > 0) { const int row = NX == 8 ? tid >> 3 : tid >> 1, ch = NX == 8 ? tid & 7 : tid & 1; koff[2] = row * KSTR + (16 + ch) * 16; ksrc[2] = k1p + (size_t)row * S.pk1 + ch * 8; kpitch[2] = S.pk1; }
    const bool xact = NX == 8 || tid < 128;
#pragma unroll
    for (int i = 0; i < 2; ++i) { const int idx = tid + 512 * i, k = idx >> 4, c8 = idx & 15; voff[i] = v_st(k, c8 * 8); vsrc[i] = vp + (size_t)k * S.pv + c8 * 8; }
#define ATT_LOAD(t) do { _Pragma("unroll") for (int i_ = 0; i_ < NP; ++i_) if (i_ < 2 || xact) kst[i_] = *(const v4u*)(ksrc[i_] + (size_t)(t) * 64 * kpitch[i_]); \
        _Pragma("unroll") for (int i_ = 0; i_ < 2; ++i_) vst[i_] = *(const v4u*)(vsrc[i_] + (size_t)(t) * 64 * S.pv); } while (0)
    ATT_LOAD(t_lo);
    {
        if constexpr (QMODE == 1) {
            float ssq = 0.f;
#pragma unroll
            for (int d0 = 0; d0 < 8; ++d0)
#pragma unroll
                for (int j = 0; j < 8; ++j) { const float x = bf2f((unsigned short)qr[d0][j]); ssq += x * x; }
            ssq = sum32(ssq);
            const float rs = rsqrtf(ssq * (1.f / 128.f) + EPS) * QS128;
#pragma unroll
            for (int d0 = 0; d0 < 8; ++d0) {
                float x[8];
#pragma unroll
                for (int j = 0; j < 8; ++j) x[j] = bf2f((unsigned short)qr[d0][j]) * rs * qgain[d0 * 16 + hi * 8 + j];
                v4u w; w.x = pk2(x[0], x[1]); w.y = pk2(x[2], x[3]); w.z = pk2(x[4], x[5]); w.w = pk2(x[6], x[7]);
                qr[d0] = __builtin_bit_cast(bf16x8, w);
            }
        }
        if constexpr (QMODE == 2) {
            float ssn = 0.f, ssp = 0.f;
#pragma unroll
            for (int d0 = 0; d0 < 8; ++d0)
#pragma unroll
                for (int j = 0; j < 8; ++j) { const float x = bf2f((unsigned short)qr[d0][j]); ssn += x * x; }
#pragma unroll
            for (int d0 = 8; d0 < 12; ++d0)
#pragma unroll
                for (int j = 0; j < 8; ++j) { const float x = bf2f((unsigned short)qr[d0][j]); ssp += x * x; }
            ssn = sum32(ssn); ssp = sum32(ssp);
            const float rsn = rsqrtf(ssn * (1.f / 128.f) + EPS) * QS192, rsp = rsqrtf(ssp * (1.f / 64.f) + EPS);
#pragma unroll
            for (int d0 = 0; d0 < 8; ++d0) {
                float x[8];
#pragma unroll
                for (int j = 0; j < 8; ++j) x[j] = bf2f((unsigned short)qr[d0][j]) * rsn * qgain[d0 * 16 + hi * 8 + j];
                qr[d0] = __builtin_bit_cast(bf16x8, pack8f(x));
            }
#pragma unroll
            for (int d0 = 8; d0 < 10; ++d0) {
                const int i0 = 16 * (d0 - 8) + 8 * hi;
                const float* rp = rope + ((size_t)qpos * 32 + i0) * 2;
                float o1[8], o2[8];
#pragma unroll
                for (int j = 0; j < 8; ++j) {
                    const float x1 = bf2f((unsigned short)qr[d0][j]) * rsp * qgain[128 + i0 + j], x2 = bf2f((unsigned short)qr[d0 + 2][j]) * rsp * qgain[160 + i0 + j];
                    const float c = rp[2 * j], sn = rp[2 * j + 1];
                    o1[j] = (x1 * c - x2 * sn) * QS192; o2[j] = (x1 * sn + x2 * c) * QS192;
                }
                qr[d0] = __builtin_bit_cast(bf16x8, pack8f(o1)); qr[d0 + 2] = __builtin_bit_cast(bf16x8, pack8f(o2));
            }
        }
    }
    float kg[8];
    if constexpr (KNORM) {
#pragma unroll
        for (int j = 0; j < 8; ++j) kg[j] = kgain[(tid & 15) * 8 + j];
    }
#define ATT_KNORM() do { if constexpr (KNORM) { _Pragma("unroll") for (int i_ = 0; i_ < 2; ++i_) { float x_[8]; unpack8(kst[i_], x_); float s_ = 0.f; \
        _Pragma("unroll") for (int j_ = 0; j_ < 8; ++j_) s_ += x_[j_] * x_[j_]; s_ = grp16_sum(s_); const float rs_ = rsqrtf(s_ * (1.f / 128.f) + EPS); \
        _Pragma("unroll") for (int j_ = 0; j_ < 8; ++j_) x_[j_] = x_[j_] * rs_ * kg[j_]; kst[i_] = pack8f(x_); } } } while (0)
#define ATT_WRITE(bf) do { ATT_KNORM(); _Pragma("unroll") for (int i_ = 0; i_ < NP; ++i_) if (i_ < 2 || xact) *(LAS v4u*)(kbuf + (bf) * KBUF + koff[i_]) = kst[i_]; \
        _Pragma("unroll") for (int i_ = 0; i_ < 2; ++i_) *(LAS v4u*)(vbuf + (bf) * VBUF + voff[i_]) = vst[i_]; } while (0)
    float m_run = -1e30f, l_run = 0.f; f32x16 o[4] = {};
    ATT_WRITE(t_lo & 1); __syncthreads();
    for (int t = t_lo; t < NT; ++t) {
        const int cur = t & 1, kb = t * 64;
        if (t + 1 < NT) ATT_LOAD(t + 1);
        const bool act = !CAUSAL || (kb <= qlo + 31);
        if (act) {
            f32x16 p0 = {}, p1 = {};
            const LAS unsigned char* ka = kbuf + cur * KBUF + r32 * KSTR + hi * 16;
            bf16x8 kc0 = *(const LAS bf16x8*)ka, kc1 = *(const LAS bf16x8*)(ka + 32 * KSTR);
#pragma unroll
            for (int d0 = 0; d0 < NKS; ++d0) {
                bf16x8 kn0 = kc0, kn1 = kc1;
                if (d0 + 1 < NKS) { kn0 = *(const LAS bf16x8*)(ka + (d0 + 1) * 32); kn1 = *(const LAS bf16x8*)(ka + 32 * KSTR + (d0 + 1) * 32); }
                SBAR();
                p0 = __builtin_amdgcn_mfma_f32_32x32x16_bf16(kc0, qr[d0], p0, 0, 0, 0);
                p1 = __builtin_amdgcn_mfma_f32_32x32x16_bf16(kc1, qr[d0], p1, 0, 0, 0);
                SBAR();
                kc0 = kn0; kc1 = kn1;
            }
            if (CAUSAL && kb + 63 > qlo) {
                const float NEG = -__builtin_inff();
#pragma unroll
                for (int i = 0; i < 16; ++i) {
                    const int key = kb + (i & 3) + 8 * (i >> 2) + 4 * hi;
                    if (key > qpos) p0[i] = NEG;
                    if (key + 32 > qpos) p1[i] = NEG;
                }
            }
            float pmax = p0[0];
#pragma unroll
            for (int i = 1; i < 16; ++i) pmax = fmaxf(pmax, p0[i]);
#pragma unroll
            for (int i = 0; i < 16; ++i) pmax = fmaxf(pmax, p1[i]);
            pmax = max32(pmax);
            const float mn = pmax > m_run + 8.f ? pmax : m_run, alpha = __builtin_amdgcn_exp2f(m_run - mn);
            m_run = mn;
            float ps = 0.f;
#pragma unroll
            for (int i = 0; i < 16; ++i) { p0[i] = __builtin_amdgcn_exp2f(p0[i] - mn); ps += p0[i]; }
#pragma unroll
            for (int i = 0; i < 16; ++i) { p1[i] = __builtin_amdgcn_exp2f(p1[i] - mn); ps += p1[i]; }
            ps = sum32(ps);
            l_run = l_run * alpha + ps;
            if (!__all(alpha == 1.f)) {
#pragma unroll
                for (int d = 0; d < 4; ++d)
#pragma unroll
                    for (int i = 0; i < 16; ++i) o[d][i] *= alpha;
            }
            bf16x8 pa0, pa1, pa2, pa3;
#define PK4(P, B_, OUT) do { unsigned a0 = cvtpk(P[B_ + 0], P[B_ + 1]), a1 = cvtpk(P[B_ + 2], P[B_ + 3]); \
        unsigned b0_ = cvtpk(P[B_ + 4], P[B_ + 5]), b1_ = cvtpk(P[B_ + 6], P[B_ + 7]); \
        auto r0 = __builtin_amdgcn_permlane32_swap(a0, b0_, false, false); auto r1 = __builtin_amdgcn_permlane32_swap(a1, b1_, false, false); \
        v4u w = {r0[0], r1[0], r0[1], r1[1]}; OUT = __builtin_bit_cast(bf16x8, w); } while (0)
            PK4(p0, 0, pa0); PK4(p0, 8, pa1); PK4(p1, 0, pa2); PK4(p1, 8, pa3);
#undef PK4
            const unsigned vb0 = (unsigned)(uintptr_t)(vbuf + cur * VBUF) + (unsigned)v_rd_base(lane);
#define TRRD(dst, off) asm volatile("ds_read_b64_tr_b16 %0, %1 offset:%2" : "=&v"(dst) : "v"(vb0), "i"(off) : "memory")
#define PV_RD(S, d0) do { constexpr int b_ = (d0) * 512; TRRD(S##l0, b_); TRRD(S##h0, b_ + 2048); TRRD(S##l1, b_ + 4096); TRRD(S##h1, b_ + 6144); TRRD(S##l2, b_ + 8192); TRRD(S##h2, b_ + 10240); TRRD(S##l3, b_ + 12288); TRRD(S##h3, b_ + 14336); } while (0)
#define PV_MM(S, d0) do { \
        o[d0] = __builtin_amdgcn_mfma_f32_32x32x16_bf16((bf16x8){S##l0[0], S##l0[1], S##l0[2], S##l0[3], S##h0[0], S##h0[1], S##h0[2], S##h0[3]}, pa0, o[d0], 0, 0, 0); \
        o[d0] = __builtin_amdgcn_mfma_f32_32x32x16_bf16((bf16x8){S##l1[0], S##l1[1], S##l1[2], S##l1[3], S##h1[0], S##h1[1], S##h1[2], S##h1[3]}, pa1, o[d0], 0, 0, 0); \
        o[d0] = __builtin_amdgcn_mfma_f32_32x32x16_bf16((bf16x8){S##l2[0], S##l2[1], S##l2[2], S##l2[3], S##h2[0], S##h2[1], S##h2[2], S##h2[3]}, pa2, o[d0], 0, 0, 0); \
        o[d0] = __builtin_amdgcn_mfma_f32_32x32x16_bf16((bf16x8){S##l3[0], S##l3[1], S##l3[2], S##l3[3], S##h3[0], S##h3[1], S##h3[2], S##h3[3]}, pa3, o[d0], 0, 0, 0); } while (0)
#define PV_WAIT(n) do { asm volatile("s_waitcnt lgkmcnt(" #n ")" ::: "memory"); SBAR(); } while (0)
            {
                s16x4 Al0, Al1, Al2, Al3, Ah0, Ah1, Ah2, Ah3, Bl0, Bl1, Bl2, Bl3, Bh0, Bh1, Bh2, Bh3;
                PV_RD(A, 0);
                PV_RD(B, 1); PV_WAIT(8); PV_MM(A, 0); SBAR();
                PV_RD(A, 2); PV_WAIT(8); PV_MM(B, 1); SBAR();
                PV_RD(B, 3); PV_WAIT(8); PV_MM(A, 2); SBAR();
                PV_WAIT(0); PV_MM(B, 3);
            }
#undef PV_RD
#undef PV_MM
#undef PV_WAIT
#undef TRRD
        }
        if (t + 1 < NT) ATT_WRITE(cur ^ 1);
        __syncthreads();
    }
#undef ATT_LOAD
#undef ATT_WRITE
#undef ATT_KNORM
    const float inv = 1.f / l_run;
    if constexpr (OUT8) {
        constexpr int OSTR = 128 + 16;
        LAS unsigned char* ost = lds + wid * (32 * OSTR);
#pragma unroll
        for (int d0 = 0; d0 < 4; ++d0)
#pragma unroll
            for (int g = 0; g < 4; ++g) {
                const float sc8 = inv * XO8_SCALE; unsigned a8 = 0;
                a8 = __builtin_amdgcn_cvt_pk_fp8_f32(fp8clamp(o[d0][4 * g] * sc8), fp8clamp(o[d0][4 * g + 1] * sc8), a8, false);
                a8 = __builtin_amdgcn_cvt_pk_fp8_f32(fp8clamp(o[d0][4 * g + 2] * sc8), fp8clamp(o[d0][4 * g + 3] * sc8), a8, true);
                *(LAS unsigned*)(ost + r32 * OSTR + 32 * d0 + 8 * g + 4 * hi) = a8;
            }
        unsigned char* obase8 = (unsigned char*)S.o + ((size_t)b * S.qrows + qlo) * S.po + h * S.ho;
#pragma unroll
        for (int j = 0; j < 4; ++j) { const int row = (lane >> 3) + 8 * j, ch = lane & 7;
            *(v4u*)(obase8 + (size_t)row * S.po + ch * 16) = *(const LAS v4u*)(ost + row * OSTR + ch * 16); }
    } else {
        constexpr int OSTR = 256 + 16;
        LAS unsigned char* ost = lds + wid * (32 * OSTR);
#pragma unroll
        for (int d0 = 0; d0 < 4; ++d0)
#pragma unroll
            for (int g = 0; g < 4; ++g) {
                typedef unsigned v2u_t __attribute__((ext_vector_type(2)));
                v2u_t w; w.x = cvtpk(o[d0][4 * g] * inv, o[d0][4 * g + 1] * inv); w.y = cvtpk(o[d0][4 * g + 2] * inv, o[d0][4 * g + 3] * inv);
                *(LAS v2u_t*)(ost + r32 * OSTR + (32 * d0 + 8 * g + 4 * hi) * 2) = w;
            }
        bf16* obase = S.o + ((size_t)b * S.qrows + qlo) * S.po + h * S.ho;
#pragma unroll
        for (int j = 0; j < 8; ++j) { const int row = (lane >> 4) + 4 * j, ch = lane & 15;
            *(v4u*)(obase + (size_t)row * S.po + ch * 8) = *(const LAS v4u*)(ost + row * OSTR + ch * 16); }
    }
    __syncthreads();
}

constexpr int LDS_BYTES = 147456;
constexpr int MISC_OFF = 131072 + 320;
constexpr int NPH_L = 11, NPHASE = 1 + 2 * NPH_L;

__device__ __forceinline__ AttnSpec spec_fox(unsigned char* ws) {
    bf16* PROJ = (bf16*)(ws + WS_PROJ); AttnSpec S;
    S.q0 = PROJ + PC_FQ; S.pq0 = NPROJ; S.hq0 = 128; S.q1 = (const bf16*)(ws + WS_FQA); S.pq1 = 0; S.hq1 = 0;
    S.k0 = PROJ + PC_FK; S.pk0 = NPROJ; S.hk0 = 128; S.k1 = (const bf16*)(ws + WS_FKA); S.pk1 = 64; S.hk1 = 16;
    S.v = PROJ + PC_FV; S.pv = NPROJ; S.hv = 128; S.o = (bf16*)(ws + WS_OMIX); S.po = DM; S.ho = 128; S.qrows = SEQ; S.kvrows = SEQ; return S;
}
__device__ __forceinline__ AttnSpec spec_moba(unsigned char* ws) {
    bf16* PROJ = (bf16*)(ws + WS_PROJ); AttnSpec S;
    S.q0 = PROJ + PC_BQ; S.pq0 = NPROJ; S.hq0 = 128; S.q1 = (const bf16*)(ws + WS_BQA); S.pq1 = 64; S.hq1 = 16;
    S.k0 = PROJ + PC_BK; S.pk0 = NPROJ; S.hk0 = 128; S.k1 = (const bf16*)(ws + WS_BKA); S.pk1 = 16; S.hk1 = 0;
    S.v = PROJ + PC_BV; S.pv = NPROJ; S.hv = 128; S.o = (bf16*)(ws + WS_OMIX) + 1536; S.po = DM; S.ho = 128; S.qrows = SEQ; S.kvrows = SEQ; return S;
}
__device__ __forceinline__ AttnSpec spec_mla(unsigned char* ws) {
    AttnSpec S; bf16* QM = (bf16*)(ws + WS_QM); bf16* KVM = (bf16*)(ws + WS_KVM);
    S.q0 = QM; S.pq0 = 768; S.hq0 = 192; S.q1 = QM; S.pq1 = 0; S.hq1 = 0;
    S.k0 = KVM; S.pk0 = 1024; S.hk0 = 256; S.k1 = (const bf16*)(ws + WS_KPE); S.pk1 = 64; S.hk1 = 0;
    S.v = KVM + 128; S.pv = 1024; S.hv = 256; S.o = (bf16*)(ws + WS_OMIX) + 512; S.po = DM; S.ho = 128; S.qrows = SEQ; S.kvrows = SEQ; return S;
}
__device__ __forceinline__ AttnSpec spec_cross(unsigned char* ws, int l) {
    AttnSpec S; bf16* XQ = (bf16*)(ws + WS_XQ); bf16* XKV = (bf16*)(ws + WS_XKV) + (size_t)l * MEMR * 1024;
    S.q0 = XQ; S.pq0 = 512; S.hq0 = 128; S.q1 = XQ; S.pq1 = 0; S.hq1 = 0;
    S.k0 = XKV; S.pk0 = 1024; S.hk0 = 128; S.k1 = XKV; S.pk1 = 0; S.hk1 = 0;
    S.v = XKV + 512; S.pv = 1024; S.hv = 128; S.o = (bf16*)(ws + WS_XO); S.po = 512; S.ho = 128; S.qrows = SEQ; S.kvrows = 256; return S;
}

__global__ void __launch_bounds__(NWAVES * 64, 2) mega(Params P) {
    extern __shared__ __attribute__((aligned(16))) unsigned char lds_raw[];
    const int wv0 = __builtin_amdgcn_readfirstlane((int)threadIdx.x >> 6);
    Frame F;
    F.lds = (LAS unsigned char*)lds_raw;
    F.tid = otid(wv0); F.lane = F.tid & 63; F.wave = wv0;
    F.G = gridDim.x; { const int bx = blockIdx.x; F.vcu = (F.G % 8 == 0) ? (bx % 8) * (F.G / 8) + bx / 8 : bx; }
    F.in = (KIN)__builtin_amdgcn_kernarg_segment_ptr(); F.out = P.out; F.ws = P.ws;
    volatile LAS unsigned* MISC = (volatile LAS unsigned*)(F.lds + MISC_OFF);
    for (int u = F.tid; u < (LDS_BYTES - 131072) / 4; u += NWAVES * 64) ((LAS unsigned*)(F.lds + 131072))[u] = 0u;
    __syncthreads();
    gu32* ctl = (gu32*)(P.ws + WS_CTL);
    const int lo = P.ph_lo, hi = P.ph_hi;
    XcdBarrier bar; bar.bar = (unsigned*)ctl + CW_BAR; bar.x = 0; bar.st = nullptr; bar.wv = wv0;
    if (hi - lo > 1) bar = xcd_barrier_post((unsigned*)ctl + CW_BAR, MISC + 8, wv0);
    const int grp = (int)blockIdx.x & 7, gs = F.G >> 3, gj = (int)blockIdx.x >> 3;
    GrpBarrier gb; gb.cnt = (unsigned*)ctl + CW_GB + 64 * grp; gb.tmo = (unsigned*)ctl + CW_BAR + XB_TMO; gb.target = 0u; gb.step = (unsigned)gs; gb.fast = 0; gb.wv = wv0;
    if (hi - lo > 1 && wv0 == 0 && olane() == 0) (void)__hip_atomic_fetch_or((unsigned*)ctl + CW_COLO + 64 * grp, 1u << xb_xcc_id(), RLX_AGENT);
#define IN(k) (lo <= (k) && (k) < hi)
#ifndef PH_ENABLE
#define PH_ENABLE 0xFFFFF
#endif
#define PHEN(k) ((PH_ENABLE >> (k)) & 1)
#define REFRESH() do { F.tid = otid(wv0); F.lane = F.tid & 63; F.wave = wv0; F.in = (KIN)(unsigned long long)uni_launder((const char*)(unsigned long long)__builtin_amdgcn_kernarg_segment_ptr()); } while (0)
#if defined(DIAG_X8_PASS)
#define DIAG_X8_PASS_ON 1
#else
#define DIAG_X8_PASS_ON 0
#endif
#ifndef MULTI_GEMM
#define MULTI_GEMM 1
#endif
#ifndef REP_PHASE
#define REP_PHASE -1
#endif
#define REPS(k) ((REP_PHASE) == (k) ? 2 : 1)
#ifdef PROBE_STAMP
    typedef unsigned long long su64;
    volatile LAS su64* stamp = (volatile LAS su64*)(F.lds + 131072 + 1024);
#define STAMP_AT(l_, k_, w_) do { if ((l_) * 16 + (k_) == (PROBE_STAMP) && blockIdx.x == 0 && wv0 == 0) { const su64 c_ = __builtin_readcyclecounter(), r_ = __builtin_amdgcn_s_memrealtime(); if (olane() == 0) { stamp[2 * (w_)] = c_; stamp[2 * (w_) + 1] = r_; } } } while (0)
#else
#define STAMP_AT(l_, k_, w_) do { } while (0)
#endif
#define REPBAR(k) do { if (IN(k)) xcd_barrier(bar); } while (0)
#define SEAM(k) do { if (IN(k) && IN((k) + 1)) { if ((k) == 0) { xcd_barrier(bar); const unsigned cm_ = xb_ld((unsigned*)ctl + CW_COLO + 64 * grp); gb.fast = (cm_ & (cm_ - 1u)) == 0u; } else grp_barrier(gb); } } while (0)
    unsigned char* ws = P.ws;
    bf16* XB = (bf16*)(ws + WS_XB); bf16* PROJ = (bf16*)(ws + WS_PROJ); bf16* OMIX = (bf16*)(ws + WS_OMIX);

    _Pragma("unroll 1") for (int rep = 0; rep < REPS(16); ++rep) { if (rep) REPBAR(0); if (PHEN(16) && IN(0)) { STAMP_AT(6, 4, 0); REFRESH(); p0_prologue(F); STAMP_AT(6, 4, 1); } }
    SEAM(0); STAMP_AT(6, 4, 2);
    for (int l = 0; l < 2; ++l) {
        const int pb = 1 + NPH_L * l;
#define PHASE_BEGIN(k) _Pragma("unroll 1") for (int rep = 0; rep < REPS(k); ++rep) { if (rep) REPBAR(pb + (k)); if (PHEN(k) && IN(pb + (k))) { STAMP_AT(l, k, 0);
#define PHASE_END(k) STAMP_AT(l, k, 1); } } SEAM(pb + (k)); STAMP_AT(l, k, 2);
        PHASE_BEGIN(0)
            pg8::Gemm g{XB, wptr(ws, l, WO_IN), M, NPROJ, DM}; pg8::StaticOrder S; S.init(M, NPROJ, F.G, (int)blockIdx.x);
            EpiScale E{PROJ, NPROJ, ss_ptr(ws, 3 * l + 0), 1.f / DM, 1.f, nullptr, (LAS float*)(F.lds + 131072 + 4096), PC_FK / 256, PC_BK / 256, F.in[6] + l * 128, F.in[18] + l * 128, PC_MCKV / 256, F.in[9] + l * 256, (bf16*)(ws + WS_CKVN), PC_MCQ / 256, (bf16*)(ws + WS_CQN), (u64*)(ws + WS_ACC + MiB + 768 * 1024) + (size_t)l * M, PC_FQ / 256, PC_BQ / 256, F.in[5] + l * 128, F.in[17] + l * 128, QS128};
            pg8::gemm_phase<EpiScale, pg8::StaticOrder, true, true>(F.lds, g, S, E, wv0);
        PHASE_END(0)
        PHASE_BEGIN(1)
            REFRESH(); prep_phase(F, l);
        PHASE_END(1)
        PHASE_BEGIN(2)
#if MULTI_GEMM
            { pg8::Gemm g0{(bf16*)(ws + WS_CQN), wptr(ws, l, WO_UQ), M, 768, 512}, g1{(bf16*)(ws + WS_CKVN), wptr(ws, l, WO_UKV), M, 1024, 256};
              pg8::ListOrder2G S; S.init(8 * grp, 8, 3, 8 * grp, 8, 4, gs, gj);
              EpiScale2 E{EpiScale{(bf16*)(ws + WS_QM), 768, (const u64*)(ws + WS_ACC + MiB + 768 * 1024) + (size_t)l * M, 1.f / 512.f, 1.f, nullptr, nullptr, 0, 0, nullptr, nullptr, 0, nullptr, nullptr, 0, nullptr, nullptr}, EpiScale{(bf16*)(ws + WS_KVM), 1024, nullptr, 0.f, 1.f, F.in[12] + l * 192, (LAS float*)(F.lds + 131072 + 4096), 0, 0, nullptr, nullptr, 0, nullptr, nullptr, 0, nullptr, nullptr}};
              pg8::gemm_phase<EpiScale2, pg8::ListOrder2G, true, true, false, true>(F.lds, g0, S, E, wv0, g1); }
#else
            { pg8::Gemm g{(bf16*)(ws + WS_CQN), wptr(ws, l, WO_UQ), M, 768, 512}; pg8::StaticOrder S; S.init(M, 768, F.G, (int)blockIdx.x);
              EpiScale E{(bf16*)(ws + WS_QM), 768, nullptr, 0.f, 1.f};
              pg8::gemm_phase<EpiScale, pg8::StaticOrder, true, true>(F.lds, g, S, E, wv0); }
            { pg8::Gemm g{(bf16*)(ws + WS_CKVN), wptr(ws, l, WO_UKV), M, 1024, 256}; pg8::StaticOrder S; S.init(M, 1024, F.G, (int)blockIdx.x);
              EpiScale E{(bf16*)(ws + WS_KVM), 1024, nullptr, 0.f, 1.f};
              pg8::gemm_phase<EpiScale, pg8::StaticOrder, true, true>(F.lds, g, S, E, wv0); }
#endif
            REFRESH(); foxbias_phase(F); REFRESH(); gating_phase(F, l, ctl + CW_Q + 64 * (32 * l + 24 + grp) + 4096 * rep, grp * 32, 32);
        PHASE_END(2)
        PHASE_BEGIN(3)
            LAS unsigned* slot = (LAS unsigned*)(F.lds + MISC_OFF + 64);
            REFRESH();
            {
                const AttnSpec SF = spec_fox(ws), SB = spec_moba(ws), SM = spec_mla(ws); const float* gq = F.in[11] + l * 192; const float* gk = F.in[12] + l * 192;
                const float* fbias = (const float*)(ws + WS_FBIAS);
                float fxB; { const float* g1 = F.in[5] + l * 128; const float* g2 = F.in[6] + l * 128; float a = fmaxf(fabsf(g1[F.lane]), fabsf(g1[F.lane + 64])), c = fmaxf(fabsf(g2[F.lane]), fabsf(g2[F.lane + 64]));
#pragma unroll
                    for (int o = 1; o < 64; o <<= 1) { a = fmaxf(a, __shfl_xor(a, o)); c = fmaxf(c, __shfl_xor(c, o)); }
                    fxB = 2.f * (128.f * QS128 * 1.01f) * a * c + 40.f; }
                gu32* ctr = ctl + CW_Q + 64 * (32 * l + grp) + 4096 * rep;
                int it = queue_next(ctr, slot, wv0);
                for (;;) { if (it >= 96) break;
                    unsigned nx_ = 0u; if (wv0 == 0 && olane() == 0) nx_ = __hip_atomic_fetch_add(ctr, 1u, __ATOMIC_RELAXED, __HIP_MEMORY_SCOPE_AGENT);
                    if (it < 64) { const int r = it & 7, qb = 7 - (it >> 3);
                        if (r < 4) attn_unit<12, 24, true, 2, false>(F.lds, SM, grp, r, qb, gq, gk, wv0, (const float*)(ws + WS_ROPE));
                        else attn_unit<9, 16, true, 0, false>(F.lds, SB, grp, r - 4, qb, nullptr, nullptr, wv0); }
                    else { const int j = it - 64, qb = 7 - (j >> 2), b = grp, hh = j & 3;
                        int tlo = 0;
                        if (qb > 0) { const float ref = fbias[((size_t)b * SEQ + qb * 256) * 4 + hh];
                            const bool skip = F.lane < 4 * qb && (ref - fbias[((size_t)b * SEQ + F.lane * 64 + 63) * 4 + hh]) >= fxB;
                            const unsigned long long mk = __ballot(skip); tlo = mk == ~0ull ? 64 : __builtin_ctzll(~mk); tlo = __builtin_amdgcn_readfirstlane(tlo < 4 * qb ? tlo : 4 * qb); }
                        attn_unit<9, 16, true, 0, false>(F.lds, SF, b, hh, qb, nullptr, nullptr, wv0, nullptr, tlo); }
                    if (wv0 == 0 && olane() == 0) *slot = nx_;
                    __syncthreads(); it = (int)*slot; } }
            STAMP_AT(l, 3, 3);
            REFRESH();
            { gu32* ctr = ctl + CW_Q + 64 * (32 * l + 16 + grp) + 4096 * rep;
              for (;;) { const int it = queue_next(ctr, slot, wv0); if (it >= 64) break; gmlp_unit(ws, F.in, F.lds, l, grp * 16 + (it >> 2), it & 3, wv0); } }
        PHASE_END(3)
        PHASE_BEGIN(4)
            REFRESH(); groupnorm_phase(F, l);
        PHASE_END(4)
        PHASE_BEGIN(5)
            pg8::Gemm g{OMIX, wptr(ws, l, WO_OUT), M, DM, DM}; pg8::StaticOrder S; S.init(M, DM, F.G, (int)blockIdx.x);
            EpiResid2 E{XB, ss_ptr(ws, 3 * l + 1), XATT_FP8 ? ws + WS_X8 : nullptr, nullptr, 1.f};
            pg8::gemm_phase<EpiResid2, pg8::StaticOrder, true, true>(F.lds, g, S, E, wv0);
        PHASE_END(5)
        PHASE_BEGIN(6)
#if MULTI_GEMM
            constexpr bool XF = XATT_FP8 != 0; constexpr float XOS = XF ? 1.f / (X8_SCALE * W8_SCALE) : 1.f;
            pg8::Gemm g0{XF ? (bf16*)(ws + WS_X8) : XB, wptr(ws, l, WO_XQ), M, 512, XF ? DM / 2 : DM}, g1{(bf16*)(ws + WS_MEMB), wptr(ws, l, WO_XKV), MEMR, 1024, XF ? DM / 2 : DM};
            pg8::ListOrder2G S; S.init(8 * grp, 8, 2, grp, 1, 4, gs, gj);
            LAS float* knp6 = (LAS float*)(F.lds + 131072 + 4096);
            EpiScale2 E{EpiScale{(bf16*)(ws + WS_XQ), 512, ss_ptr(ws, 3 * l + 1), 1.f / DM, XOS, nullptr, knp6, 0, 0, nullptr, nullptr, 0, nullptr, nullptr, 0, nullptr, nullptr, 0, 0, F.in[25] + l * 128, nullptr, QS128},
                        EpiScale{(bf16*)(ws + WS_XKV) + (size_t)l * MEMR * 1024, 1024, (const u64*)(ws + WS_MEMSS), 1.f / DM, XOS, nullptr, knp6, 0, 0, F.in[26] + l * 128, nullptr, 0, nullptr, nullptr, 0, nullptr, nullptr, 0, 0, nullptr, nullptr, 0.f}};
            pg8::gemm_phase<EpiScale2, pg8::ListOrder2G, true, true, XF, true>(F.lds, g0, S, E, wv0, g1);
#else
            { pg8::Gemm g{XB, wptr(ws, l, WO_XQ), M, 512, DM}; pg8::StaticOrder S; S.init(M, 512, F.G, (int)blockIdx.x);
              EpiScale E{(bf16*)(ws + WS_XQ), 512, ss_ptr(ws, 3 * l + 1), 1.f / DM, 1.f};
              pg8::gemm_phase<EpiScale, pg8::StaticOrder, true, true>(F.lds, g, S, E, wv0); }
            { pg8::Gemm g{(bf16*)(ws + WS_MEMB), wptr(ws, l, WO_XKV), MEMR, 1024, DM}; pg8::StaticOrder S; S.init(MEMR, 1024, F.G, 255 - (int)blockIdx.x);
              EpiScale E{(bf16*)(ws + WS_XKV) + (size_t)l * MEMR * 1024, 1024, (const u64*)(ws + WS_MEMSS), 1.f / DM, 1.f};
              pg8::gemm_phase<EpiScale, pg8::StaticOrder, true, true>(F.lds, g, S, E, wv0); }
#endif
        PHASE_END(6)
        PHASE_BEGIN(7)
            REFRESH(); const AttnSpec SX = spec_cross(ws, l); const float* qg = F.in[25] + l * 128; const float* kg = F.in[26] + l * 128;
            for (int it = F.vcu; it < 256; it += F.G) { attn_unit<8, 16, false, 0, false, XATT_FP8 != 0>(F.lds, SX, it >> 5, (it >> 3) & 3, it & 7, nullptr, nullptr, wv0); }
        PHASE_END(7)
        PHASE_BEGIN(8)
            constexpr bool XF = XATT_FP8 != 0;
            pg8::Gemm g{(bf16*)(ws + WS_XO), wptr(ws, l, WO_XO), M, DM, XF ? 256 : 512}; pg8::StaticOrder S; S.init(M, DM, F.G, (int)blockIdx.x);
            EpiResid2 E{XB, ss_ptr(ws, 3 * l + 2), (FFN_FP8 & 1) ? ws + WS_X8 : nullptr, nullptr, XF ? 1.f / (XO8_SCALE * W8_SCALE) : 1.f};
            pg8::gemm_phase<EpiResid2, pg8::StaticOrder, true, true, XF>(F.lds, g, S, E, wv0);
        PHASE_END(8)
        PHASE_BEGIN(9)
            constexpr bool G8F = (FFN_FP8 & 1) != 0, G9F = (FFN_FP8 & 2) != 0;
            pg8::Gemm g{G8F ? (bf16*)(ws + WS_X8) : XB, wptr(ws, l, WO_GU), M, 2 * DFF, G8F ? DM / 2 : DM}; pg8::StaticOrder S; S.init(M, 2 * DFF, F.G, (int)blockIdx.x);
            EpiSwiGLUx<G9F> E{(void*)PROJ, ss_ptr(ws, 3 * l + 2), G8F ? 1.f / (X8_SCALE * W8_SCALE) : 1.f};
            pg8::gemm_phase<EpiSwiGLUx<G9F>, pg8::StaticOrder, true, true, G8F>(F.lds, g, S, E, wv0);
        PHASE_END(9)
        PHASE_BEGIN(10)
            constexpr bool G9F = (FFN_FP8 & 2) != 0;
            pg8::Gemm g{PROJ, wptr(ws, l, WO_D), M, DM, G9F ? DFF / 2 : DFF}; pg8::StaticOrder S; S.init(M, DM, F.G, (int)blockIdx.x);
            EpiResid2 E{XB, ss_ptr(ws, 3 * l + 3), nullptr, l == 1 ? P.out : nullptr, G9F ? 1.f / (ACT8_SCALE * W8_SCALE) : 1.f};
            pg8::gemm_phase<EpiResid2, pg8::StaticOrder, true, true, G9F>(F.lds, g, S, E, wv0);
        PHASE_END(10)
#undef PHASE_BEGIN
#undef PHASE_END
    }
#ifdef PROBE_STAMP
    if (blockIdx.x == 0 && wv0 == 0) {
        __builtin_amdgcn_s_waitcnt(0);
        const su64 c0 = stamp[0], r0 = stamp[1], c1 = stamp[2], r1 = stamp[3], r2 = stamp[5];
        su64 V;
        if (PROBE_STAMP_MODE == 0) V = (su64)((float)(c1 - c0) * 100.f / (float)(r1 - r0) * 100.f);
        else if (PROBE_STAMP_MODE == 1) V = (r1 - r0) * 10;
        else if (PROBE_STAMP_MODE == 3) V = (stamp[7] - r0) * 10;
        else V = (r2 - r0) * 10;
        const su64 t0 = __builtin_amdgcn_s_memrealtime();
        while (__builtin_amdgcn_s_memrealtime() - t0 < V) __builtin_amdgcn_s_sleep(64);
    }
#endif
#undef IN
#undef SEAM
}

#ifndef N_LAUNCH_MODE
#define N_LAUNCH_MODE 0
#endif
extern "C" void kernel_launch(void* const* d_in, const int* in_sizes, int n_in, void* d_out, int out_size, void* d_ws, size_t ws_size, hipStream_t stream) {
    static int grid = 0;
    if (grid == 0) {
        if (n_in != 31 || out_size != M * DM || ws_size < WS_END) { fprintf(stderr, "kernel_launch: unexpected shapes (n_in %d out %d ws %zu)\n", n_in, out_size, ws_size); grid = -1; return; }
        int dev = 0, cus = 0, per_cu = 0;
        if (hipGetDevice(&dev) != hipSuccess || hipDeviceGetAttribute(&cus, hipDeviceAttributeMultiprocessorCount, dev) != hipSuccess) { grid = -1; return; }
        if (hipFuncSetAttribute((const void*)mega, hipFuncAttributeMaxDynamicSharedMemorySize, LDS_BYTES) != hipSuccess) { fprintf(stderr, "kernel_launch: hipFuncSetAttribute failed\n"); grid = -1; return; }
        if (hipOccupancyMaxActiveBlocksPerMultiprocessor(&per_cu, (const void*)mega, NWAVES * 64, LDS_BYTES) != hipSuccess || per_cu < 1) fprintf(stderr, "kernel_launch: occupancy query says %d\n", per_cu);
        (void)hipGetLastError();
        grid = cus - cus % 8;
        if (grid < 8) { grid = -1; return; }
    }
    if (grid < 0) return;
    (void)hipMemsetAsync((char*)d_ws + WS_ACC, 0, 2 * MiB, stream);
    Params p{};
    for (int i = 0; i < 31; ++i) p.in[i] = (const float*)d_in[i];
    p.out = (float*)d_out; p.ws = (unsigned char*)d_ws;
#if N_LAUNCH_MODE == 1
    p.ph_lo = 0; p.ph_hi = NPHASE;
    hipLaunchKernelGGL(mega, dim3(grid), dim3(NWAVES * 64), LDS_BYTES, stream, p);
#else
    for (int ph = 0; ph < NPHASE; ++ph) {
        p.ph_lo = ph; p.ph_hi = ph + 1;
        hipLaunchKernelGGL(mega, dim3(grid), dim3(NWAVES * 64), LDS_BYTES, stream, p);
    }
#endif
}
```
